# Optimizing an MI355X kernel written in HIP

```python
import jax, jax.numpy as jnp
from jax import lax
import numpy as np

D_MODEL = 2048
BATCH = 2
SEQ = 4096
DEPTH = 1

H_RET = 8
DK_RET = 128
DV_RET = 128
RET_CHUNK = 128
H_ATT = 8
H_KV = 2
D_HEAD = 128
H_IDX = 16
D_IDX = 64
MAX_TOPK = 256
Q_BLOCK = 128
D_FF = 5632
ROPE_THETA = 10000.0
NORM_EPS = 1e-6

RET_W = H_RET * DV_RET
ATT_W = H_ATT * D_HEAD
MIX_W = RET_W + ATT_W
IN_SIZES = (H_RET * DK_RET, H_RET * DK_RET, RET_W, RET_W, ATT_W, H_KV * D_HEAD, H_KV * D_HEAD, H_IDX * D_IDX, D_IDX, H_IDX)
IN_COLS = sum(IN_SIZES)

kernel_name = 'hybrid_retention_dsa_macaron'


def rmsnorm(x, g):
    xf = x.astype(jnp.float32)
    y = xf * lax.rsqrt(jnp.mean(xf * xf, axis=-1, keepdims=True) + NORM_EPS)
    return (y * g.astype(jnp.float32)).astype(x.dtype)


def rope(x, pos):
    d = x.shape[-1]
    inv = ROPE_THETA ** (-jnp.arange(0, d, 2, dtype=jnp.float32) / d)
    ang = pos.astype(jnp.float32)[..., None] * inv
    cos = jnp.cos(ang)[:, :, None, :]
    sin = jnp.sin(ang)[:, :, None, :]
    xf = x.astype(jnp.float32)
    x1, x2 = xf[..., : d // 2], xf[..., d // 2:]
    return jnp.concatenate([x1 * cos - x2 * sin, x2 * cos + x1 * sin], axis=-1).astype(x.dtype)


def swiglu(h, w_gate, w_up, w_down):
    return (jax.nn.silu(h @ w_gate) * (h @ w_up)) @ w_down


def retention(q, k, v):
    B, T, H, dk = q.shape
    dv = v.shape[-1]
    C = RET_CHUNK
    N = T // C
    lg = jnp.log1p(-jnp.exp2(-5.0 - jnp.arange(H, dtype=jnp.float32)))
    q = q.astype(jnp.float32).reshape(B, N, C, H, dk)
    k = (k.astype(jnp.float32) * dk ** -0.5).reshape(B, N, C, H, dk)
    v = v.astype(jnp.float32).reshape(B, N, C, H, dv)
    j = jnp.arange(C, dtype=jnp.float32)
    diff = j[:, None] - j[None, :]
    decay = jnp.where(diff[None] >= 0, jnp.exp(jnp.maximum(diff, 0.0)[None] * lg[:, None, None]), 0.0)
    s = jnp.einsum('bnihd,bnjhd->bnhij', q, k) * decay
    intra = jnp.einsum('bnhij,bnjhe->bnihe', s, v)
    k_dec = k * jnp.exp((C - 1 - j)[:, None] * lg[None, :])[:, :, None]
    kv = jnp.einsum('bnjhd,bnjhe->nbhde', k_dec, v)
    g_chunk = jnp.exp(C * lg)[None, :, None, None]

    def step(state, kv_n):
        return state * g_chunk + kv_n, state

    _, states = lax.scan(step, jnp.zeros((B, H, dk, dv), jnp.float32), kv)
    q_dec = q * jnp.exp((j + 1)[:, None] * lg[None, :])[:, :, None]
    cross = jnp.einsum('bnihd,nbhde->bnihe', q_dec, states)
    return (intra + cross).reshape(B, T, H, dv)


def sparse_attention(q, k, v, q_idx, k_idx, w_idx):
    B, T = q.shape[0], q.shape[1]
    top_k = min(MAX_TOPK, T // 4)
    nb = T // Q_BLOCK
    key_pos = jnp.arange(T)
    gather = jax.vmap(lambda a, i: a[i])

    def blocks(a):
        return jnp.moveaxis(a.reshape((B, nb, Q_BLOCK) + a.shape[2:]), 1, 0)

    def attend(args):
        qb, qib, wb, t0 = args
        t = t0 + jnp.arange(Q_BLOCK)
        rel = jax.nn.relu(jnp.einsum('bqhd,bsd->bqhs', qib, k_idx))
        score = jnp.einsum('bqhs,bqh->bqs', rel, wb).astype(jnp.float32)
        causal = key_pos[None, :] <= t[:, None]
        score = jnp.where(causal[None], score, -jnp.inf)
        _, idx = lax.top_k(score, top_k)
        valid = idx <= t[None, :, None]
        kg = gather(k, idx)
        vg = gather(v, idx)
        logits = jnp.einsum('bqgnd,bqkgd->bqgnk', qb, kg).astype(jnp.float32) * D_HEAD ** -0.5
        logits = jnp.where(valid[:, :, None, None, :], logits, -jnp.inf)
        p = jax.nn.softmax(logits, axis=-1).astype(vg.dtype)
        return jnp.einsum('bqgnk,bqkgd->bqgnd', p, vg)

    out = lax.map(attend, (blocks(q), blocks(q_idx), blocks(w_idx), jnp.arange(nb) * Q_BLOCK))
    return jnp.moveaxis(out, 0, 1).reshape(B, T, H_ATT * D_HEAD)


def setup_inputs(seed: int = 0) -> dict:
    key = jax.random.key(seed)
    ks = jax.random.split(key, 16)

    def dense(k, shape, fan_in):
        return jax.random.normal(k, shape, jnp.float32) * fan_in ** -0.5

    def gain(k, shape):
        return 1.0 + 0.02 * jax.random.normal(k, shape, jnp.float32)

    return {
        'x': jax.random.normal(ks[0], (BATCH, SEQ, D_MODEL), jnp.float32),
        'positions': jnp.broadcast_to(jnp.arange(SEQ, dtype=jnp.int32), (BATCH, SEQ)),
        'ffn1_norm': gain(ks[1], (DEPTH, D_MODEL)),
        'ffn1_w_gate': dense(ks[2], (DEPTH, D_MODEL, D_FF), D_MODEL),
        'ffn1_w_up': dense(ks[3], (DEPTH, D_MODEL, D_FF), D_MODEL),
        'ffn1_w_down': dense(ks[4], (DEPTH, D_FF, D_MODEL), D_FF),
        'mix_norm': gain(ks[5], (DEPTH, D_MODEL)),
        'w_in': dense(ks[6], (DEPTH, D_MODEL, IN_COLS), D_MODEL),
        'ret_norm': gain(ks[7], (DEPTH, RET_W)),
        'w_out': dense(ks[8], (DEPTH, MIX_W, D_MODEL), MIX_W),
        'ffn2_norm': gain(ks[9], (DEPTH, D_MODEL)),
        'ffn2_w_gate': dense(ks[10], (DEPTH, D_MODEL, D_FF), D_MODEL),
        'ffn2_w_up': dense(ks[11], (DEPTH, D_MODEL, D_FF), D_MODEL),
        'ffn2_w_down': dense(ks[12], (DEPTH, D_FF, D_MODEL), D_FF),
        'final_norm': gain(ks[13], (D_MODEL,)),
    }


def reference(x, positions, ffn1_norm, ffn1_w_gate, ffn1_w_up, ffn1_w_down, mix_norm, w_in, ret_norm, w_out, ffn2_norm, ffn2_w_gate, ffn2_w_up, ffn2_w_down, final_norm):
    B, T, _ = x.shape
    splits = np.cumsum(IN_SIZES)[:-1].tolist()
    for l in range(DEPTH):
        x = x + 0.5 * swiglu(rmsnorm(x, ffn1_norm[l]), ffn1_w_gate[l], ffn1_w_up[l], ffn1_w_down[l])
        h = rmsnorm(x, mix_norm[l])
        proj = h @ w_in[l]
        rq, rk, rv, rg, aq, ak, av, iq, ik, iw = jnp.split(proj, splits, axis=-1)
        rq = rope(rq.reshape(B, T, H_RET, DK_RET), positions)
        rk = rope(rk.reshape(B, T, H_RET, DK_RET), positions)
        ro = retention(rq, rk, rv.reshape(B, T, H_RET, DV_RET))
        mu = jnp.mean(ro, axis=-1, keepdims=True)
        var = jnp.mean(jnp.square(ro - mu), axis=-1, keepdims=True)
        ro = (ro - mu) * lax.rsqrt(var + NORM_EPS) * ret_norm[l].astype(jnp.float32).reshape(H_RET, DV_RET)
        ro = ro.reshape(B, T, RET_W).astype(x.dtype) * jax.nn.silu(rg)
        aq = rope(aq.reshape(B, T, H_ATT, D_HEAD), positions).reshape(B, T, H_KV, H_ATT // H_KV, D_HEAD)
        ak = rope(ak.reshape(B, T, H_KV, D_HEAD), positions)
        av = av.reshape(B, T, H_KV, D_HEAD)
        iq = rope(iq.reshape(B, T, H_IDX, D_IDX), positions) * D_IDX ** -0.5
        ik = rope(ik.reshape(B, T, 1, D_IDX), positions)[:, :, 0]
        iw = iw * H_IDX ** -0.5
        ao = sparse_attention(aq, ak, av, iq, ik, iw)
        x = x + jnp.concatenate([ro, ao], axis=-1) @ w_out[l]
        x = x + 0.5 * swiglu(rmsnorm(x, ffn2_norm[l]), ffn2_w_gate[l], ffn2_w_up[l], ffn2_w_down[l])
    return rmsnorm(x, final_norm)
```

```cpp
#include <hip/hip_runtime.h>
#include <cstdio>
#include <cstdint>

#ifndef MK_PER_PHASE
#define MK_PER_PHASE 0
#endif

namespace pg8 {
#define PG8_LAS __attribute__((address_space(3)))
typedef unsigned short bf16_t;
typedef short bf16x8 __attribute__((ext_vector_type(8)));
typedef float f32x4 __attribute__((ext_vector_type(4)));
typedef unsigned u32x4 __attribute__((ext_vector_type(4)));
constexpr int BM = 256, BK = 64, HALF = 128, HTB = HALF * BK * 2, STAGE_BYTES = 8 * HTB, NXCD = 8, WGM = 8;

__host__ __device__ __forceinline__ int lds_byte(int r, int c) { const int st = (r >> 4) * 2 + (c >> 5), rr = r & 15, cc = c & 31, ob = rr * 64 + cc * 2; return st * 1024 + (ob ^ (((ob >> 9) & 1) << 5)); }
__host__ __device__ __forceinline__ void stage_rc(int b, int& R, int& C) { const int st = b / 1024, sb = b % 1024, swz = sb ^ (((sb >> 9) & 1) << 5); R = (st >> 1) * 16 + swz / 64; C = (st & 1) * 32 + (swz % 64) / 2; }
__host__ __device__ __forceinline__ int perm32(int rho) { const int n = rho >> 4, i = rho & 15; return 8 * (i >> 2) + 4 * n + (i & 3); }

struct Unit { int pm, pn; };
struct Gemm { const bf16_t* A; const bf16_t* Bt; int M, N, K; };

struct StaticOrder {
    int nM, nN, nwg, G, c;
    __host__ __device__ void init(int M, int N, int G_, int c_) { nM = M / BM; nN = N / BM; nwg = nM * nN; G = G_; c = c_; }
    __host__ __device__ bool next(int i, Unit& u) const {
        const long L = (long)i * G + c; if (L >= nwg) return false;
        int wgid = (int)L; { const int q = nwg / NXCD, r = nwg % NXCD, xcd = wgid % NXCD, off = wgid / NXCD; wgid = (xcd < r ? xcd * (q + 1) : r * (q + 1) + (xcd - r) * q) + off; }
        const int nig = WGM * nN, gid = wgid / nig, fm = gid * WGM, gsz = (nM - fm) < WGM ? (nM - fm) : WGM;
        u.pm = fm + ((wgid % nig) % gsz); u.pn = (wgid % nig) / gsz; return true;
    }
    __device__ __forceinline__ void a_ready(const Unit&) const {}
    __device__ __forceinline__ void done(const Unit&) const {}
};

template <class Epi, class Sched, bool ALIGN_EPI = false, bool SP2 = false>
__device__ __forceinline__ void gemm_phase(PG8_LAS unsigned char* lds, const Gemm g, const Sched& S, const Epi& E) {
    const int tid = threadIdx.x, wid = __builtin_amdgcn_readfirstlane(tid >> 6), lane = tid & 63, wr = wid >> 2, wc = wid & 3, fr = lane & 15, fq = lane >> 4;
    const int K = g.K, nt = K / BK;
    unsigned voffA[2], voffB[2];
#pragma unroll
    for (int i = 0; i < 2; ++i) { int R, C; stage_rc(tid * 16 + i * 8192, R, C); const int Rb = Epi::PERM ? ((R & ~31) + perm32(R & 31)) : R;
        voffA[i] = (unsigned)(R * K + C) * 2u; voffB[i] = (unsigned)(Rb * K + C) * 2u; }
    const size_t kstep = (size_t)(BK * 2);
    const size_t hstep = (size_t)HALF * K * 2;
    const size_t tstep = 2 * hstep;
    const unsigned ldsw = (unsigned)wid * 1024u;
    const int aoff = lds_byte(wr * 64 + fr, fq * 8), boff = lds_byte(wc * 32 + fr, fq * 8);
#define PG8_SA(b, h) (((b) * 2 + (h)) * HTB)
#define PG8_SB(b, h) ((4 + (b) * 2 + (h)) * HTB)
#define PG8_STAGE(bufoff, gbase, voff) do { _Pragma("unroll") for (int _i = 0; _i < 2; ++_i) \
        __builtin_amdgcn_global_load_lds((const unsigned*)((const char*)(gbase) + (voff)[_i]), (PG8_LAS unsigned*)(lds + (bufoff) + ldsw + _i * 8192), 16, 0, 0); } while (0)
#define PG8_LDA(dst, b, h) do { _Pragma("unroll") for (int m = 0; m < 4; ++m) _Pragma("unroll") for (int k = 0; k < 2; ++k) dst[m][k] = *(const PG8_LAS bf16x8*)(lds + PG8_SA(b, h) + aoff + m * 2048 + k * 1024); } while (0)
#define PG8_LDB(dst, b, h) do { _Pragma("unroll") for (int n = 0; n < 2; ++n) _Pragma("unroll") for (int k = 0; k < 2; ++k) dst[n][k] = *(const PG8_LAS bf16x8*)(lds + PG8_SB(b, h) + boff + n * 2048 + k * 1024); } while (0)
#define PG8_MMA(ai, bj, At, Bt) do { __builtin_amdgcn_s_setprio(1); _Pragma("unroll") for (int m = 0; m < 4; ++m) _Pragma("unroll") for (int n = 0; n < 2; ++n) _Pragma("unroll") for (int k = 0; k < 2; ++k) \
        acc[ai][bj][m][n] = __builtin_amdgcn_mfma_f32_16x16x32_bf16(Bt[n][k], At[m][k], acc[ai][bj][m][n], 0, 0, 0); __builtin_amdgcn_s_setprio(0); } while (0)
#define PG8_WAIT_V(n) asm volatile("s_waitcnt vmcnt(" #n ")" ::: "memory")
#define PG8_WAIT_L(n) asm volatile("s_waitcnt lgkmcnt(" #n ")" ::: "memory")
#define PG8_BAR __builtin_amdgcn_s_barrier()
#define PG8_SCHED __builtin_amdgcn_sched_barrier(0)
    Unit cur, nxt; int ui = 0;
    if (!S.next(0, cur)) return;
    f32x4 acc[2][2][4][2];
#pragma unroll
    for (int a = 0; a < 2; ++a)
#pragma unroll
        for (int b = 0; b < 2; ++b)
#pragma unroll
            for (int m = 0; m < 4; ++m)
#pragma unroll
                for (int n = 0; n < 2; ++n) acc[a][b][m][n] = (f32x4){0.f, 0.f, 0.f, 0.f};
    bf16x8 At[4][2], B0[2][2], B1[2][2];
    const char* cA = (const char*)g.A + (size_t)cur.pm * tstep; const char* cB = (const char*)g.Bt + (size_t)cur.pn * tstep;
    S.a_ready(cur);
    if constexpr (SP2) {
        PG8_STAGE(PG8_SB(0, 0), cB, voffB); PG8_STAGE(PG8_SB(0, 1), cB + hstep, voffB); PG8_STAGE(PG8_SA(0, 0), cA, voffA); PG8_STAGE(PG8_SA(0, 1), cA + hstep, voffA);
        if (wr == 1) PG8_BAR;
        PG8_WAIT_V(2); PG8_BAR;
        PG8_STAGE(PG8_SB(1, 0), cB + kstep, voffB); PG8_STAGE(PG8_SA(1, 0), cA + kstep, voffA); PG8_STAGE(PG8_SB(1, 1), cB + hstep + kstep, voffB);
        PG8_WAIT_V(6); PG8_BAR;
    } else {
        PG8_STAGE(PG8_SB(0, 0), cB, voffB); PG8_STAGE(PG8_SA(0, 0), cA, voffA); PG8_STAGE(PG8_SB(0, 1), cB + hstep, voffB); PG8_STAGE(PG8_SA(0, 1), cA + hstep, voffA);
        if (wr == 1) PG8_BAR;
        PG8_WAIT_V(4); PG8_BAR;
        PG8_STAGE(PG8_SB(1, 0), cB + kstep, voffB); PG8_STAGE(PG8_SA(1, 0), cA + kstep, voffA); PG8_STAGE(PG8_SB(1, 1), cB + hstep + kstep, voffB);
        PG8_WAIT_V(6); PG8_BAR;
    }
    for (;;) {
        const bool has_next = S.next(ui + 1, nxt);
        const char* nA = has_next ? (const char*)g.A + (size_t)nxt.pm * tstep : cA; const char* nB = has_next ? (const char*)g.Bt + (size_t)nxt.pn * tstep : cB;
        for (int t = 0; t < nt; t += 2) {
            const bool last = (t == nt - 2);
            const char* a1 = cA + (size_t)(t + 1) * kstep;
            const char* a2 = last ? nA : cA + (size_t)(t + 2) * kstep; const char* b2 = last ? nB : cB + (size_t)(t + 2) * kstep;
            const char* a3 = a2 + kstep; const char* b3 = b2 + kstep;
            if (last && has_next) S.a_ready(nxt);
            if constexpr (SP2) {
            PG8_LDB(B0, 0, 0); PG8_LDB(B1, 0, 1); PG8_SCHED; PG8_LDA(At, 0, 0); PG8_STAGE(PG8_SA(1, 1), a1 + hstep, voffA);
            PG8_WAIT_V(8); PG8_WAIT_L(0); PG8_BAR; PG8_MMA(0, 0, At, B0); PG8_MMA(0, 1, At, B1); PG8_BAR; PG8_SCHED;
            PG8_LDA(At, 0, 1); PG8_STAGE(PG8_SB(0, 0), b2, voffB); PG8_STAGE(PG8_SB(0, 1), b2 + hstep, voffB); PG8_STAGE(PG8_SA(0, 0), a2, voffA);
            PG8_WAIT_V(8); PG8_WAIT_L(0); PG8_BAR; PG8_MMA(1, 0, At, B0); PG8_MMA(1, 1, At, B1); PG8_BAR; PG8_SCHED;
            PG8_LDB(B0, 1, 0); PG8_LDB(B1, 1, 1); PG8_SCHED; PG8_LDA(At, 1, 0); PG8_STAGE(PG8_SA(0, 1), a2 + hstep, voffA);
            PG8_WAIT_V(8); PG8_WAIT_L(0); PG8_BAR; PG8_MMA(0, 0, At, B0); PG8_MMA(0, 1, At, B1); PG8_BAR; PG8_SCHED;
            PG8_LDA(At, 1, 1); PG8_STAGE(PG8_SB(1, 0), b3, voffB); PG8_STAGE(PG8_SB(1, 1), b3 + hstep, voffB); PG8_STAGE(PG8_SA(1, 0), a3, voffA);
            PG8_WAIT_V(8); PG8_WAIT_L(0); PG8_BAR; PG8_MMA(1, 0, At, B0); PG8_MMA(1, 1, At, B1); PG8_BAR; PG8_SCHED;
            } else {
            PG8_LDB(B0, 0, 0); PG8_SCHED; PG8_LDA(At, 0, 0); PG8_STAGE(PG8_SA(1, 1), a1 + hstep, voffA);
            PG8_WAIT_L(8); PG8_BAR; PG8_WAIT_L(0); PG8_MMA(0, 0, At, B0); PG8_BAR; PG8_SCHED;
            PG8_LDB(B1, 0, 1); PG8_STAGE(PG8_SB(0, 0), b2, voffB);
            PG8_BAR; PG8_WAIT_L(0); PG8_MMA(0, 1, At, B1); PG8_BAR;
            PG8_LDA(At, 0, 1); PG8_STAGE(PG8_SA(0, 0), a2, voffA);
            PG8_BAR; PG8_WAIT_L(0); PG8_MMA(1, 0, At, B0); PG8_BAR; PG8_SCHED;
            PG8_STAGE(PG8_SB(0, 1), b2 + hstep, voffB);
            PG8_WAIT_V(6); PG8_BAR; PG8_MMA(1, 1, At, B1); PG8_BAR;
            PG8_LDB(B0, 1, 0); PG8_SCHED; PG8_LDA(At, 1, 0); PG8_STAGE(PG8_SA(0, 1), a2 + hstep, voffA);
            PG8_WAIT_L(8); PG8_BAR; PG8_WAIT_L(0); PG8_MMA(0, 0, At, B0); PG8_BAR; PG8_SCHED;
            PG8_LDB(B1, 1, 1); PG8_STAGE(PG8_SB(1, 0), b3, voffB);
            PG8_BAR; PG8_WAIT_L(0); PG8_MMA(0, 1, At, B1); PG8_BAR;
            PG8_LDA(At, 1, 1); PG8_STAGE(PG8_SA(1, 0), a3, voffA);
            PG8_BAR; PG8_WAIT_L(0); PG8_MMA(1, 0, At, B0); PG8_BAR; PG8_SCHED;
            PG8_STAGE(PG8_SB(1, 1), b3 + hstep, voffB);
            PG8_WAIT_V(6); PG8_BAR; PG8_MMA(1, 1, At, B1); PG8_BAR;
            }
        }
        if constexpr (ALIGN_EPI) { if (wr == 0) PG8_BAR; }
        E(acc, cur, ui, wr, wc, fr, fq); S.done(cur);
        if (!has_next) break;
#pragma unroll
        for (int a = 0; a < 2; ++a)
#pragma unroll
            for (int b = 0; b < 2; ++b)
#pragma unroll
                for (int m = 0; m < 4; ++m)
#pragma unroll
                    for (int n = 0; n < 2; ++n) acc[a][b][m][n] = (f32x4){0.f, 0.f, 0.f, 0.f};
        cur = nxt; cA = nA; cB = nB; ++ui;
        if constexpr (ALIGN_EPI) { if (wr == 1) PG8_BAR; }
    }
    PG8_WAIT_V(0);
    if constexpr (!ALIGN_EPI) { if (wr == 0) PG8_BAR; }
    PG8_BAR;
#undef PG8_SA
#undef PG8_SB
#undef PG8_STAGE
#undef PG8_LDA
#undef PG8_LDB
#undef PG8_MMA
#undef PG8_WAIT_V
#undef PG8_WAIT_L
#undef PG8_BAR
#undef PG8_SCHED
}
}

constexpr int NWAVES = 8;
constexpr int BATCH = 2, T = 4096, D = 2048, M = BATCH * T;
constexpr int HRET = 8, HKV = 2, FF = 5632;
constexpr int NPB = 5632;
constexpr int NIDXP = 1280;
constexpr int NIN = 6736, NINP = 6912;
constexpr int C_RQ = 0, C_RK = 1024, C_RV = 2048, C_RG = 3072, C_AQ = 4096, C_AK = 5120, C_AV = 5376;
constexpr float NORM_EPS = 1e-6f;

constexpr size_t MiB = 1u << 20;
constexpr size_t WS_CTL = 0, CTL_ZERO_BYTES = 65536;
constexpr size_t WS_TAB = 1 * MiB;
constexpr size_t WS_WGU = 5 * MiB;
constexpr size_t WS_WD = 49 * MiB;
constexpr size_t WS_WIN = 71 * MiB;
constexpr size_t WS_WOUT = 98 * MiB;
constexpr size_t WS_A = 106 * MiB;
constexpr size_t WS_PROJ = 138 * MiB;
constexpr size_t WS_PIDX = 226 * MiB;
constexpr size_t WS_RKT = 266 * MiB;
constexpr size_t WS_RVT = 282 * MiB;
constexpr size_t WS_AVT = 298 * MiB;
constexpr size_t WS_IQ = 302 * MiB;
constexpr size_t WS_IK = 318 * MiB;
constexpr size_t WS_IW = 319 * MiB;
constexpr size_t WS_KV = 320 * MiB;
constexpr size_t WS_ST = 352 * MiB;
constexpr size_t WS_MASK = 368 * MiB;
constexpr size_t WS_SSQ = 372 * MiB;
constexpr size_t WS_END = 373 * MiB;
constexpr int CW_BAR = 4096;

constexpr int RING_BYTES = 131072;
constexpr int LDS_BYTES = 147456;
constexpr int LDSCTL_OFF = LDS_BYTES - 512, MISC_OFF = LDSCTL_OFF + 320;

#define GAS __attribute__((address_space(1)))
#define LAS __attribute__((address_space(3)))
typedef unsigned short bf16;
typedef _Float16 f16;
typedef _Float16 half8 __attribute__((ext_vector_type(8)));
typedef unsigned v4u __attribute__((ext_vector_type(4)));
typedef unsigned v2u __attribute__((ext_vector_type(2)));
typedef float f32x2 __attribute__((ext_vector_type(2)));
typedef float f32x4 __attribute__((ext_vector_type(4)));
typedef float f32x16 __attribute__((ext_vector_type(16)));
typedef short bf16x8 __attribute__((ext_vector_type(8)));
typedef __bf16 bf16x2_t __attribute__((ext_vector_type(2)));
typedef GAS unsigned gu32;
#define LDS_WAIT() asm volatile("s_waitcnt lgkmcnt(0)" ::: "memory")
__device__ __forceinline__ unsigned pk2(float lo, float hi) { f32x2 v = {lo, hi}; bf16x2_t b = __builtin_convertvector(v, bf16x2_t); return __builtin_bit_cast(unsigned, b); }
__device__ __forceinline__ float bflo(unsigned w) { return __uint_as_float(w << 16); }
__device__ __forceinline__ float bfhi(unsigned w) { return __uint_as_float(w & 0xffff0000u); }
__device__ __forceinline__ float silu_f(float g) { return g * __builtin_amdgcn_rcpf(1.f + __builtin_amdgcn_exp2f(-1.4426950408889634f * g)); }

#define XB_TMO      128
#define XB_XCNT(j)  (256  + 64 * (j))
#define XB_XSUB(j)  (1280 + 64 * (j))
#define XB_XGEN(j)  (2304 + 64 * (j))
#define XB_TOP      3328
#define XB_TOPGEN   3392
#define XCD_BAR_WORDS 3456
#define XB_SPIN_CAP (1u << 22)
__device__ __forceinline__ unsigned xb_ld(unsigned* p)              { return __hip_atomic_load(p, __ATOMIC_RELAXED, __HIP_MEMORY_SCOPE_AGENT); }
__device__ __forceinline__ unsigned xb_add(unsigned* p, unsigned v) { return __hip_atomic_fetch_add(p, v, __ATOMIC_RELAXED, __HIP_MEMORY_SCOPE_AGENT); }
__device__ __forceinline__ unsigned xb_xcc_id() { return (unsigned)__builtin_amdgcn_s_getreg((3 << 11) | 20) & 0xFu; }
#define XB_SPIN(cond, bar) do { unsigned _sp = 0; while (cond) { __builtin_amdgcn_s_sleep(1); \
    if ((++_sp & 255u) == 0u) { if (xb_ld(&(bar)[XB_TMO])) break; if (_sp > XB_SPIN_CAP) { atomicAdd(&(bar)[XB_TMO], 1u); break; } } } } while (0)
struct XcdBarrier { unsigned* bar; unsigned x; volatile LAS unsigned* st; };
__device__ __forceinline__ XcdBarrier xcd_barrier_post(unsigned* bar, volatile LAS unsigned* st) {
    XcdBarrier b; b.bar = bar; b.x = xb_xcc_id(); b.st = st;
    if (threadIdx.x == 0) (void)xb_add(&bar[XB_XCNT(b.x)], 1u);
    return b;
}
__device__ __forceinline__ void xcd_barrier_complete(unsigned* bar, unsigned x, unsigned& nloc, unsigned& nx) {
    const unsigned G = gridDim.x * gridDim.y * gridDim.z;
    unsigned sum, cnt, mine, sp = 0u;
    for (;;) {
        sum = 0u; cnt = 0u; mine = 0u;
#pragma unroll
        for (unsigned j = 0; j < 16; ++j) { const unsigned c = xb_ld(&bar[XB_XCNT(j)]); sum += c; cnt += (c > 0u) ? 1u : 0u; mine = (j == x) ? c : mine; }
        if (sum == G) break;
        __builtin_amdgcn_s_sleep(1);
        if ((++sp & 255u) == 0u) { if (xb_ld(&bar[XB_TMO])) break; if (sp > XB_SPIN_CAP) { atomicAdd(&bar[XB_TMO], 1u); break; } }
    }
    nloc = mine > 0u ? mine : 1u; nx = cnt > 0u ? cnt : 1u;
}
__device__ __forceinline__ void xcd_barrier(const XcdBarrier& b) {
    asm volatile("s_waitcnt vmcnt(0)" ::: "memory");
    __syncthreads();
    if (threadIdx.x == 0) {
        unsigned* bar = b.bar;
        __builtin_amdgcn_s_waitcnt(0);
        unsigned nloc = b.st[0], nx = b.st[1];
        if (nloc == 0u) { xcd_barrier_complete(bar, b.x, nloc, nx); b.st[0] = nloc; b.st[1] = nx; }
        const unsigned old = xb_add(&bar[XB_XSUB(b.x)], 1u);
        const unsigned gen = old / nloc;
        if (old + 1u == (gen + 1u) * nloc) {
            __builtin_amdgcn_fence(__ATOMIC_RELEASE, "agent");
            asm volatile("s_waitcnt vmcnt(0)" ::: "memory");
            const unsigned og = xb_add(&bar[XB_TOP], 1u);
            const unsigned tg = og / nx;
            if (og + 1u == (tg + 1u) * nx) xb_add(&bar[XB_TOPGEN], 1u);
            else XB_SPIN(xb_ld(&bar[XB_TOPGEN]) == tg, bar);
            __builtin_amdgcn_fence(__ATOMIC_ACQUIRE, "agent");
            xb_add(&bar[XB_XGEN(b.x)], 1u);
            asm volatile("s_waitcnt vmcnt(0)" ::: "memory");
        } else {
            XB_SPIN(xb_ld(&bar[XB_XGEN(b.x)]) == gen, bar);
            __builtin_amdgcn_fence(__ATOMIC_ACQUIRE, "agent");
            asm volatile("s_waitcnt vmcnt(0)" ::: "memory");
        }
    }
    __syncthreads();
}

struct Frame {
    LAS unsigned char* lds;
    int tid, lane, wave;
    int bid, G;
    const float* x; const int* pos;
    const float *n1, *wg1, *wu1, *wd1, *nmix, *win, *nret, *wout, *n2, *wg2, *wu2, *wd2, *nfin;
    float* X;
    float2* TAB; bf16 *WGU, *WD, *WIN, *WOUT, *A, *PROJ; float* PIDX; bf16 *RKT, *RVT, *AVT; f16 *IQ, *IK; float* IW; float* KV; bf16* ST; unsigned* MASK; float* SSQ; bf16* C;
};

__device__ __forceinline__ float wave_sum(float v) {
#pragma unroll
    for (int o = 1; o < 64; o <<= 1) v += __shfl_xor(v, o);
    return v;
}

constexpr int RS_OFF = RING_BYTES, RS_MAXU = 6;
__device__ __forceinline__ void load_rstd_panels(Frame& F, const pg8::StaticOrder& S, const float* ssq) {
    LAS float* rs = (LAS float*)(F.lds + RS_OFF);
    const int r = F.tid >> 1, hf = F.tid & 1;
    f32x4 p[RS_MAXU][4]; bool ok[RS_MAXU];
#pragma unroll
    for (int i = 0; i < RS_MAXU; ++i) { pg8::Unit u; ok[i] = S.next(i, u);
        if (ok[i]) { const f32x4* q = (const f32x4*)(ssq + (size_t)(u.pm * 256 + r) * 32 + 16 * hf);
#pragma unroll
            for (int k = 0; k < 4; ++k) p[i][k] = q[k]; } }
#pragma unroll
    for (int i = 0; i < RS_MAXU; ++i) if (ok[i]) {
        const f32x4 s4 = (p[i][0] + p[i][1]) + (p[i][2] + p[i][3]);
        float s = (s4.x + s4.y) + (s4.z + s4.w);
        s += __shfl_xor(s, 1);
        if (hf == 0) rs[i * 256 + r] = 1.0f / sqrtf(s * (1.f / D) + NORM_EPS);
    }
    __syncthreads();
}
struct EpiSwiGLU {
    static constexpr bool PERM = true;
    bf16* H; const LAS float* rs;
    __device__ __forceinline__ void operator()(const f32x4 (&acc)[2][2][4][2], const pg8::Unit& u, int ui, int wr, int wc, int fr, int fq) const {
        const int row0 = u.pm * 256 + wr * 64 + fr, col0 = u.pn * 128 + wc * 32 + 8 * fq;
#pragma unroll
        for (int ai = 0; ai < 2; ++ai)
#pragma unroll
            for (int m = 0; m < 4; ++m) {
                const int row = row0 + ai * 128 + m * 16;
                const float r = rs[ui * 256 + ai * 128 + wr * 64 + m * 16 + fr];
                bf16* rowp = H + (size_t)row * FF + col0;
                const f32x4 g0 = acc[ai][0][m][0] * r, g1 = acc[ai][0][m][1] * r, u0 = acc[ai][1][m][0] * r, u1 = acc[ai][1][m][1] * r;
                v4u w;
                w.x = pk2(silu_f(g0[0]) * u0[0], silu_f(g0[1]) * u0[1]); w.y = pk2(silu_f(g0[2]) * u0[2], silu_f(g0[3]) * u0[3]);
                w.z = pk2(silu_f(g1[0]) * u1[0], silu_f(g1[1]) * u1[1]); w.w = pk2(silu_f(g1[2]) * u1[2], silu_f(g1[3]) * u1[3]);
                *(v4u*)rowp = w;
            }
    }
};
struct EpiResid {
    static constexpr bool PERM = true;
    const float* base; float* out; float alpha; bf16* An; const float* gn; float* ssq;
    __device__ __forceinline__ void operator()(const f32x4 (&acc)[2][2][4][2], const pg8::Unit& u, int ui, int wr, int wc, int fr, int fq) const {
        const int row0 = u.pm * 256 + wr * 64 + fr, col0 = u.pn * 256 + wc * 32 + 8 * fq;
        f32x4 gv[2][2];
        if (An) {
#pragma unroll
            for (int bj = 0; bj < 2; ++bj)
#pragma unroll
                for (int n = 0; n < 2; ++n) gv[bj][n] = *(const f32x4*)(gn + col0 + bj * 128 + 4 * n);
        }
#pragma unroll
        for (int ai = 0; ai < 2; ++ai)
#pragma unroll
            for (int m = 0; m < 4; ++m) {
                const int row = row0 + ai * 128 + m * 16;
                const size_t off = (size_t)row * D + col0;
                float sq = 0.f;
#pragma unroll
                for (int bj = 0; bj < 2; ++bj) {
                    const f32x4 v0 = *(const f32x4*)(base + off + bj * 128) + acc[ai][bj][m][0] * alpha;
                    const f32x4 v1 = *(const f32x4*)(base + off + bj * 128 + 4) + acc[ai][bj][m][1] * alpha;
                    *(f32x4*)(out + off + bj * 128) = v0; *(f32x4*)(out + off + bj * 128 + 4) = v1;
                    sq += (v0.x * v0.x + v0.y * v0.y) + (v0.z * v0.z + v0.w * v0.w) + (v1.x * v1.x + v1.y * v1.y) + (v1.z * v1.z + v1.w * v1.w);
                    if (An) { const f32x4 a0 = v0 * gv[bj][0], a1 = v1 * gv[bj][1];
                        v4u w; w.x = pk2(a0.x, a0.y); w.y = pk2(a0.z, a0.w); w.z = pk2(a1.x, a1.y); w.w = pk2(a1.z, a1.w);
                        *(v4u*)(An + off + bj * 128) = w; }
                }
                sq += __shfl_xor(sq, 16); sq += __shfl_xor(sq, 32);
                if (fq == 0) ssq[(size_t)row * 32 + u.pn * 4 + wc] = sq;
            }
    }
};
struct EpiProj {
    static constexpr bool PERM = true;
    bf16* PROJ; float* PIDX; const LAS float* rs;
    __device__ __forceinline__ void operator()(const f32x4 (&acc)[2][2][4][2], const pg8::Unit& u, int ui, int wr, int wc, int fr, int fq) const {
        const int row0 = u.pm * 256 + wr * 64 + fr;
        if (u.pn < 22) {
            const int col0 = u.pn * 256 + wc * 32 + 8 * fq;
#pragma unroll
            for (int ai = 0; ai < 2; ++ai)
#pragma unroll
                for (int m = 0; m < 4; ++m) {
                    const int row = row0 + ai * 128 + m * 16;
                    const float r = rs[ui * 256 + ai * 128 + wr * 64 + m * 16 + fr];
                    bf16* rowp = PROJ + (size_t)row * NPB + col0;
#pragma unroll
                    for (int bj = 0; bj < 2; ++bj) {
                        const f32x4 v0 = acc[ai][bj][m][0] * r, v1 = acc[ai][bj][m][1] * r;
                        v4u w; w.x = pk2(v0[0], v0[1]); w.y = pk2(v0[2], v0[3]); w.z = pk2(v1[0], v1[1]); w.w = pk2(v1[2], v1[3]);
                        *(v4u*)(rowp + bj * 128) = w;
                    }
                }
        } else {
            const int col0 = (u.pn - 22) * 256 + wc * 32 + 8 * fq;
#pragma unroll
            for (int ai = 0; ai < 2; ++ai)
#pragma unroll
                for (int m = 0; m < 4; ++m) {
                    const int row = row0 + ai * 128 + m * 16;
                    const float r = rs[ui * 256 + ai * 128 + wr * 64 + m * 16 + fr];
                    float* rowp = PIDX + (size_t)row * NIDXP + col0;
#pragma unroll
                    for (int bj = 0; bj < 2; ++bj) {
                        *(f32x4*)(rowp + bj * 128) = acc[ai][bj][m][0] * r;
                        *(f32x4*)(rowp + bj * 128 + 4) = acc[ai][bj][m][1] * r;
                    }
                }
        }
    }
};

struct CvItem { const float* W; bf16* WT; int K, N, k0, n0, gu, up; };
constexpr int CV_G = (D / 64) * (FF / 256), CV_D = (FF / 64) * (D / 256), CV_I = (D / 64) * ((NIN + 255) / 256), CV_O = (D / 64) * (D / 256);
constexpr int CV_TILE = 64 * 257 * 4;
template <int JOB> __device__ __forceinline__ constexpr int cv_total() { return JOB == 0 ? 2 * CV_G : JOB == 1 ? CV_D + CV_I + CV_O : 2 * CV_G + CV_D; }
template <int JOB> __device__ __forceinline__ void cv_decode(const Frame& F, int it, CvItem& x) {
    x.gu = 0; x.up = 0;
    if (JOB == 0 || JOB == 2) {
        const float* wg = JOB == 0 ? F.wg1 : F.wg2; const float* wu = JOB == 0 ? F.wu1 : F.wu2;
        if (it < 2 * CV_G) { const int up = it >= CV_G, r = up ? it - CV_G : it, kb = r / (FF / 256), nb = r % (FF / 256);
            x.W = up ? wu : wg; x.WT = F.WGU; x.K = D; x.N = FF; x.k0 = 64 * kb; x.n0 = 256 * nb; x.gu = 1; x.up = up; return; }
        it -= 2 * CV_G;
        { const int kb = it / (D / 256), nb = it % (D / 256); x.W = F.wd2; x.WT = F.WD; x.K = FF; x.N = D; x.k0 = 64 * kb; x.n0 = 256 * nb; }
    } else {
        if (it < CV_D) { const int kb = it / (D / 256), nb = it % (D / 256); x.W = F.wd1; x.WT = F.WD; x.K = FF; x.N = D; x.k0 = 64 * kb; x.n0 = 256 * nb; return; }
        it -= CV_D;
        constexpr int NBI = (NIN + 255) / 256;
        if (it < CV_I) { const int kb = it / NBI, nb = it % NBI; x.W = F.win; x.WT = F.WIN; x.K = D; x.N = NIN; x.k0 = 64 * kb; x.n0 = 256 * nb; return; }
        it -= CV_I;
        { const int kb = it / (D / 256), nb = it % (D / 256); x.W = F.wout; x.WT = F.WOUT; x.K = D; x.N = D; x.k0 = 64 * kb; x.n0 = 256 * nb; }
    }
}
__device__ __forceinline__ void cv_load(const CvItem& x, f32x4 (&v)[8], int wave, int lane) {
    const bool okc = (x.n0 + 4 * lane) < x.N;
    const float* p = x.W + (size_t)(x.k0 + 8 * wave) * x.N + x.n0 + 4 * lane;
#pragma unroll
    for (int i = 0; i < 8; ++i) v[i] = okc ? *(const f32x4*)(p + (size_t)i * x.N) : (f32x4){0.f, 0.f, 0.f, 0.f};
}
template <int JOB> __device__ __forceinline__ void convert_job(Frame& F, int w, int nw) {
    const int lane = F.lane, wave = F.wave, c = lane & 7, nn = lane >> 3;
    constexpr int total = cv_total<JOB>();
    CvItem x0, x1, x2; f32x4 v0[8], v1[8], v2[8];
    if (w < total) { cv_decode<JOB>(F, w, x0); cv_load(x0, v0, wave, lane); }
    if (w + nw < total) { cv_decode<JOB>(F, w + nw, x1); cv_load(x1, v1, wave, lane); }
    int par = 0;
    for (int it = w; it < total; it += nw) {
        LAS float* tile = (LAS float*)(F.lds + par * CV_TILE);
#pragma unroll
        for (int i = 0; i < 8; ++i) { LAS float* s = tile + (8 * wave + i) * 257 + 4 * lane; s[0] = v0[i].x; s[1] = v0[i].y; s[2] = v0[i].z; s[3] = v0[i].w; }
        if (it + 2 * nw < total) { cv_decode<JOB>(F, it + 2 * nw, x2); cv_load(x2, v2, wave, lane); }
        __syncthreads();
#pragma unroll
        for (int q = 0; q < 4; ++q) {
            const int n = 32 * wave + nn + 8 * q, ncol = x0.n0 + n;
            const LAS float* s = tile + (8 * c) * 257 + n;
            v4u o; o.x = pk2(s[0 * 257], s[1 * 257]); o.y = pk2(s[2 * 257], s[3 * 257]); o.z = pk2(s[4 * 257], s[5 * 257]); o.w = pk2(s[6 * 257], s[7 * 257]);
            const int drow = x0.gu ? (((ncol >> 7) << 8) + (ncol & 127) + (x0.up ? 128 : 0)) : ncol;
            if (ncol < x0.N) *(v4u*)(x0.WT + (size_t)drow * x0.K + x0.k0 + 8 * c) = o;
        }
        x0 = x1; x1 = x2;
#pragma unroll
        for (int i = 0; i < 8; ++i) { v0[i] = v1[i]; v1[i] = v2[i]; }
        par ^= 1;
    }
    __syncthreads();
    if (JOB == 1) {
        const int nz = (NINP - NIN) * D / 8;
        v4u* z = (v4u*)(F.WIN + (size_t)NIN * D);
        for (int i = w * 512 + F.tid; i < nz; i += nw * 512) z[i] = (v4u){0u, 0u, 0u, 0u};
    }
}
__device__ __forceinline__ void prep_rows(Frame& F, const float* src, const float* g, bf16* dst) {
    const int gw = F.bid * NWAVES + F.wave, NGW = F.G * NWAVES, lane = F.lane;
    for (int m = gw; m < M; m += NGW) {
        const f32x4* xr = (const f32x4*)(src + (size_t)m * D) + lane; const f32x4* gr = (const f32x4*)g + lane;
        f32x4 v[8]; float s = 0.f;
#pragma unroll
        for (int j = 0; j < 8; ++j) { v[j] = xr[64 * j]; s += (v[j].x * v[j].x + v[j].y * v[j].y) + (v[j].z * v[j].z + v[j].w * v[j].w); }
        s = wave_sum(s);
        v2u* o8 = (v2u*)(dst + (size_t)m * D) + lane;
#pragma unroll
        for (int j = 0; j < 8; ++j) { const f32x4 gg = gr[64 * j]; v2u w; w.x = pk2(v[j].x * gg.x, v[j].y * gg.y); w.y = pk2(v[j].z * gg.z, v[j].w * gg.w); o8[64 * j] = w; }
        if (lane < 32) F.SSQ[(size_t)m * 32 + lane] = (lane == 0) ? s : 0.f;
    }
}
__device__ __forceinline__ void rms_final(Frame& F) {
    const int gw = F.bid * NWAVES + F.wave, NGW = F.G * NWAVES;
    for (int m = gw; m < M; m += NGW) {
        f32x4* xr = (f32x4*)(F.X + (size_t)m * D) + F.lane; const f32x4* gr = (const f32x4*)F.nfin + F.lane;
        const float s = wave_sum(F.lane < 32 ? F.SSQ[(size_t)m * 32 + F.lane] : 0.f);
        const float rstd = 1.0f / sqrtf(s * (1.f / D) + NORM_EPS);
#pragma unroll
        for (int j = 0; j < 8; ++j) { const f32x4 gg = gr[64 * j]; xr[64 * j] = xr[64 * j] * rstd * gg; }
    }
}
__device__ __forceinline__ void rope_table(Frame& F) {
    const int gt = F.bid * (NWAVES * 64) + F.tid, NT = F.G * NWAVES * 64;
    for (int e = gt; e < M * 64; e += NT) {
        const int m = e >> 6, i = e & 63;
        double inv = 1.0; const double rr = 8.65964323360065346691e-01;
        for (int k = 0; k < i; ++k) inv *= rr;
        const float invf = (float)inv;
        const float angf = (float)F.pos[m] * invf;
        const double ang = (double)angf;
        const double kq = __builtin_rint(ang * 0.63661977236758134308);
        double y = __builtin_fma(-kq, 1.57079632679489655800e+00, ang);
        y = __builtin_fma(-kq, 6.12323399573676603587e-17, y);
        const double y2 = y * y;
        double sn = 1.0 / 6227020800.0; sn = sn * y2 - 1.0 / 39916800.0; sn = sn * y2 + 1.0 / 362880.0; sn = sn * y2 - 1.0 / 5040.0; sn = sn * y2 + 1.0 / 120.0; sn = sn * y2 - 1.0 / 6.0; sn = sn * y2 * y + y;
        double cs = 1.0 / 479001600.0; cs = cs * y2 - 1.0 / 3628800.0; cs = cs * y2 + 1.0 / 40320.0; cs = cs * y2 - 1.0 / 720.0; cs = cs * y2 + 1.0 / 24.0; cs = cs * y2 - 0.5; cs = cs * y2 + 1.0;
        const int q = ((int)kq) & 3;
        const double c = (q == 0) ? cs : (q == 1) ? -sn : (q == 2) ? -cs : sn;
        const double s = (q == 0) ? sn : (q == 1) ? cs : (q == 2) ? -sn : -cs;
        F.TAB[e] = make_float2((float)c, (float)s);
    }
}
__device__ __forceinline__ float lg2_gamma(int h) {
    const double x = __builtin_amdgcn_exp2f((float)(-5 - h));
    double s = 1.0 / 8.0; s = s * x + 1.0 / 7.0; s = s * x + 1.0 / 6.0; s = s * x + 0.2; s = s * x + 0.25; s = s * x + 1.0 / 3.0; s = s * x + 0.5; s = s * x + 1.0; s = -s * x;
    return (float)(s * 1.44269504088896338700);
}

constexpr int PT_IMG = 32 * 132 * 4;
__device__ __forceinline__ void post_tile(Frame& F, int tt) {
    const int tid = F.tid;
    const int m0 = tt * 32, b = m0 / T, tp0 = m0 % T;
    const int ltok = tid >> 4, lc8 = (tid & 15) * 8;
    bf16* gp0 = F.PROJ + (size_t)(m0 + ltok) * NPB + lc8;
    v4u cur = *(const v4u*)gp0, nxt = cur;
    for (int s = 0; s < 44; ++s) {
        LAS float* L = (LAS float*)(F.lds + (s & 1) * PT_IMG);
        const int col = s * 128;
        const int typ = (s < 8) ? 0 : (s < 16) ? 1 : (s < 24) ? 2 : (s < 32) ? 3 : (s < 40) ? 4 : (s < 42) ? 5 : 6;
        const int h = (s < 40) ? (s & 7) : (s & 1);
        bf16* gp = gp0 + col;
        if (s + 1 < 44) nxt = *(const v4u*)(gp + 128);
        { const v4u w = cur; LAS float* lp = L + ltok * 132 + lc8;
          if (typ == 3) { lp[0] = silu_f(bflo(w.x)); lp[1] = silu_f(bfhi(w.x)); lp[2] = silu_f(bflo(w.y)); lp[3] = silu_f(bfhi(w.y)); lp[4] = silu_f(bflo(w.z)); lp[5] = silu_f(bfhi(w.z)); lp[6] = silu_f(bflo(w.w)); lp[7] = silu_f(bfhi(w.w)); }
          else { lp[0] = bflo(w.x); lp[1] = bfhi(w.x); lp[2] = bflo(w.y); lp[3] = bfhi(w.y); lp[4] = bflo(w.z); lp[5] = bfhi(w.z); lp[6] = bflo(w.w); lp[7] = bfhi(w.w); } }
        if (typ == 0 || typ == 1 || typ == 4 || typ == 5) {
            __syncthreads();
            const float lg = lg2_gamma(h);
#pragma unroll
            for (int k = 0; k < 4; ++k) {
                const int p = tid + 512 * k, tok = p >> 6, i = p & 63;
                const float a = L[tok * 132 + i], bb = L[tok * 132 + i + 64];
                const float2 cs = F.TAB[(size_t)(m0 + tok) * 64 + i];
                const int pc = (tp0 + tok) & 127;
                float sc = 1.f;
                if (typ == 0) sc = __builtin_amdgcn_exp2f(lg * (float)(pc + 1));
                else if (typ == 1) sc = 0.08838834764831845f * __builtin_amdgcn_exp2f(-lg * (float)(pc + 1));
                else if (typ == 4) sc = 0.08838834764831845f * 1.4426950408889634f;
                L[tok * 132 + i] = (a * cs.x - bb * cs.y) * sc;
                L[tok * 132 + i + 64] = (bb * cs.x + a * cs.y) * sc;
            }
        }
        __syncthreads();
        if (typ != 2 && typ != 6) {
            const LAS float* lp = L + ltok * 132 + lc8;
            v4u w; w.x = pk2(lp[0], lp[1]); w.y = pk2(lp[2], lp[3]); w.z = pk2(lp[4], lp[5]); w.w = pk2(lp[6], lp[7]);
            *(v4u*)gp = w;
        }
        if (typ == 1 || typ == 2 || typ == 6) {
            const int d = tid >> 2, t8 = (tid & 3) * 8;
            bf16* tb = (typ == 1) ? F.RKT + ((size_t)(b * 8 + h) * 128 + d) * T : (typ == 2) ? F.RVT + ((size_t)(b * 8 + h) * 128 + d) * T : F.AVT + ((size_t)(b * 2 + h) * 128 + d) * T;
            const LAS float* lp = L + t8 * 132 + d;
            v4u w; w.x = pk2(lp[0], lp[132]); w.y = pk2(lp[264], lp[396]); w.z = pk2(lp[528], lp[660]); w.w = pk2(lp[792], lp[924]);
            *(v4u*)(tb + tp0 + t8) = w;
        }
        cur = nxt;
    }
    const float* ip0 = F.PIDX + (size_t)(m0 + ltok) * NIDXP + lc8;
    f32x4 ca = *(const f32x4*)ip0, cb = *(const f32x4*)(ip0 + 4), na = ca, nb = cb;
    for (int s = 0; s < 8; ++s) {
        LAS float* L = (LAS float*)(F.lds + (s & 1) * PT_IMG);
        if (s + 1 < 8) { na = *(const f32x4*)(ip0 + (s + 1) * 128); nb = *(const f32x4*)(ip0 + (s + 1) * 128 + 4); }
        else { const int tok = tid >> 4, c4 = (tid & 15) * 4; na = *(const f32x4*)(F.PIDX + (size_t)(m0 + tok) * NIDXP + 1024 + c4); }
        { LAS float* lp = L + ltok * 132 + lc8; lp[0] = ca.x; lp[1] = ca.y; lp[2] = ca.z; lp[3] = ca.w; lp[4] = cb.x; lp[5] = cb.y; lp[6] = cb.z; lp[7] = cb.w; }
        __syncthreads();
#pragma unroll
        for (int k = 0; k < 4; ++k) {
            const int p = tid + 512 * k, tok = p >> 6, hh = (p >> 5) & 1, i = p & 31;
            const float a = L[tok * 132 + 64 * hh + i], bb = L[tok * 132 + 64 * hh + i + 32];
            const float2 cs = F.TAB[(size_t)(m0 + tok) * 64 + 2 * i];
            L[tok * 132 + 64 * hh + i] = (a * cs.x - bb * cs.y) * 0.125f;
            L[tok * 132 + 64 * hh + i + 32] = (bb * cs.x + a * cs.y) * 0.125f;
        }
        __syncthreads();
        { const LAS float* lp = L + ltok * 132 + lc8; half8 hv;
#pragma unroll
          for (int k = 0; k < 8; ++k) hv[k] = (f16)lp[k];
          *(half8*)(F.IQ + (size_t)(m0 + ltok) * 1024 + s * 128 + lc8) = hv; }
        ca = na; cb = nb;
    }
    {
        LAS float* L = (LAS float*)F.lds;
        const int tok = tid >> 4, c4 = (tid & 15) * 4;
        LAS float* lp = L + tok * 132 + c4; lp[0] = ca.x; lp[1] = ca.y; lp[2] = ca.z; lp[3] = ca.w;
        __syncthreads();
#pragma unroll
        for (int k = 0; k < 2; ++k) {
            const int p = tid + 512 * k, tk = p >> 5, i = p & 31;
            const float x1 = L[tk * 132 + i], x2 = L[tk * 132 + i + 32];
            const float2 cs = F.TAB[(size_t)(m0 + tk) * 64 + 2 * i];
            F.IK[(size_t)(m0 + tk) * 64 + i] = (f16)(x1 * cs.x - x2 * cs.y);
            F.IK[(size_t)(m0 + tk) * 64 + i + 32] = (f16)(x2 * cs.x + x1 * cs.y);
        }
        const int hh = tid & 15;
        F.IW[(size_t)(m0 + tok) * 16 + hh] = F.PIDX[(size_t)(m0 + tok) * NIDXP + 1088 + hh] * 0.25f;
        __syncthreads();
    }
}

#define MFMA32(a, b, c) __builtin_amdgcn_mfma_f32_32x32x16_bf16((a), (b), (c), 0, 0, 0)
#define MFMA16(a, b, c) __builtin_amdgcn_mfma_f32_16x16x32_bf16((a), (b), (c), 0, 0, 0)
__device__ __forceinline__ f32x16 zero16() { f32x16 z;
#pragma unroll
    for (int i = 0; i < 16; ++i) z[i] = 0.f; return z; }
__device__ __forceinline__ void ret_kv_unit(Frame& F, int unit, int w4, int lane) {
    const int bh = unit >> 5, n = unit & 31, t0 = n * 128, r = lane & 31, hi = lane >> 5;
    f32x16 acc[4];
#pragma unroll
    for (int k = 0; k < 4; ++k) acc[k] = zero16();
    const bf16* vp = F.RVT + ((size_t)bh * 128 + 32 * w4 + r) * T + t0 + 8 * hi;
    const bf16* kp = F.RKT + ((size_t)bh * 128 + r) * T + t0 + 8 * hi;
#pragma unroll
    for (int s = 0; s < 8; ++s) {
        const bf16x8 bfr = *(const bf16x8*)(vp + 16 * s);
#pragma unroll
        for (int blk = 0; blk < 4; ++blk) { const bf16x8 af = *(const bf16x8*)(kp + (size_t)blk * 32 * T + 16 * s); acc[blk] = MFMA32(af, bfr, acc[blk]); }
    }
    float* kvp = F.KV + ((size_t)unit * 128 + 32 * w4 + r) * 128;
#pragma unroll
    for (int blk = 0; blk < 4; ++blk)
#pragma unroll
        for (int g = 0; g < 4; ++g) *(f32x4*)(kvp + 32 * blk + 8 * g + 4 * hi) = (f32x4){acc[blk][4 * g], acc[blk][4 * g + 1], acc[blk][4 * g + 2], acc[blk][4 * g + 3]};
}
__device__ __forceinline__ void ret_scan(Frame& F) {
    const int gt = F.bid * (NWAVES * 64) + F.tid, NT = F.G * NWAVES * 64;
    for (int idx = gt; idx < 16 * 4096; idx += NT) {
        const int bh = idx >> 12, rem = idx & 4095, h = bh & 7;
        const float gC = __builtin_amdgcn_exp2f(128.f * lg2_gamma(h));
        f32x4 S = {0.f, 0.f, 0.f, 0.f};
        for (int n = 0; n < 32; ++n) {
            const size_t off = ((size_t)(bh * 32 + n) * 16384) + (size_t)rem * 4;
            v2u w; w.x = pk2(S.x, S.y); w.y = pk2(S.z, S.w);
            *(v2u*)(F.ST + off) = w;
            const f32x4 kv = *(const f32x4*)(F.KV + off);
            S = (S + kv) * gC;
        }
    }
}
__device__ __forceinline__ void ret_out_unit(Frame& F, int unit, int I, int lane) {
    const int bh = unit >> 5, n = unit & 31, b = bh >> 3, h = bh & 7, t0 = n * 128, r = lane & 31, hi = lane >> 5;
    const size_t tokI = (size_t)b * T + t0 + 32 * I + r;
    bf16x8 qf[8];
    { const bf16* qp = F.PROJ + tokI * NPB + C_RQ + h * 128 + 8 * hi;
#pragma unroll
      for (int s = 0; s < 8; ++s) qf[s] = *(const bf16x8*)(qp + 16 * s); }
    f32x16 out[4];
#pragma unroll
    for (int k = 0; k < 4; ++k) out[k] = zero16();
    { const bf16* sp = F.ST + ((size_t)unit * 128 + r) * 128 + 8 * hi;
#pragma unroll
      for (int blk = 0; blk < 4; ++blk)
#pragma unroll
          for (int s = 0; s < 8; ++s) { const bf16x8 af = *(const bf16x8*)(sp + (size_t)blk * 32 * 128 + 16 * s); out[blk] = MFMA32(af, qf[s], out[blk]); } }
    for (int J = 0; J <= I; ++J) {
        const bf16* kp = F.PROJ + ((size_t)b * T + t0 + 32 * J + r) * NPB + C_RK + h * 128 + 8 * hi;
        f32x16 X = zero16();
#pragma unroll
        for (int s = 0; s < 8; ++s) { const bf16x8 kf = *(const bf16x8*)(kp + 16 * s); X = MFMA32(kf, qf[s], X); }
        if (J == I) {
#pragma unroll
            for (int g = 0; g < 16; ++g) { const int jrow = (g & 3) + 8 * (g >> 2) + 4 * hi; if (jrow > r) X[g] = 0.f; }
        }
#pragma unroll
        for (int s2 = 0; s2 < 2; ++s2) {
            v4u xp; xp.x = pk2(X[8 * s2], X[8 * s2 + 1]); xp.y = pk2(X[8 * s2 + 2], X[8 * s2 + 3]); xp.z = pk2(X[8 * s2 + 4], X[8 * s2 + 5]); xp.w = pk2(X[8 * s2 + 6], X[8 * s2 + 7]);
            const bf16x8 xb = __builtin_bit_cast(bf16x8, xp);
#pragma unroll
            for (int blk = 0; blk < 4; ++blk) {
                const bf16* vp = F.RVT + ((size_t)bh * 128 + 32 * blk + r) * T + t0 + 32 * J + 16 * s2 + 4 * hi;
                const v2u lo = *(const v2u*)vp, hi2 = *(const v2u*)(vp + 8);
                v4u av; av.x = lo.x; av.y = lo.y; av.z = hi2.x; av.w = hi2.y;
                out[blk] = MFMA32(__builtin_bit_cast(bf16x8, av), xb, out[blk]);
            }
        }
    }
    float s1 = 0.f;
#pragma unroll
    for (int blk = 0; blk < 4; ++blk)
#pragma unroll
        for (int g = 0; g < 16; ++g) s1 += out[blk][g];
    s1 += __shfl_xor(s1, 32);
    const float mu = s1 * (1.f / 128.f);
    float s2 = 0.f;
#pragma unroll
    for (int blk = 0; blk < 4; ++blk)
#pragma unroll
        for (int g = 0; g < 16; ++g) { const float dlt = out[blk][g] - mu; s2 += dlt * dlt; }
    s2 += __shfl_xor(s2, 32);
    const float rstd = 1.0f / sqrtf(s2 * (1.f / 128.f) + NORM_EPS);
    const bf16* gp = F.PROJ + tokI * NPB + C_RG + h * 128;
    bf16* op = F.C + tokI * D + h * 128;
    const float* nw = F.nret + h * 128;
#pragma unroll
    for (int blk = 0; blk < 4; ++blk)
#pragma unroll
        for (int g = 0; g < 4; ++g) {
            const int e = 32 * blk + 8 * g + 4 * hi;
            const v2u gg = *(const v2u*)(gp + e); const f32x4 w4 = *(const f32x4*)(nw + e);
            const float y0 = (out[blk][4 * g] - mu) * rstd * w4.x * bflo(gg.x), y1 = (out[blk][4 * g + 1] - mu) * rstd * w4.y * bfhi(gg.x);
            const float y2 = (out[blk][4 * g + 2] - mu) * rstd * w4.z * bflo(gg.y), y3 = (out[blk][4 * g + 3] - mu) * rstd * w4.w * bfhi(gg.y);
            v2u o; o.x = pk2(y0, y1); o.y = pk2(y2, y3);
            *(v2u*)(op + e) = o;
        }
}

__device__ __forceinline__ unsigned fkey(float f) { unsigned b = __float_as_uint(f); if (b == 0x80000000u) b = 0u; return (b & 0x80000000u) ? ~b : (b | 0x80000000u); }
__device__ __forceinline__ int row16_sum_i(int c) {
    c += __builtin_amdgcn_update_dpp(0, c, 0xB1, 0xF, 0xF, true);
    c += __builtin_amdgcn_update_dpp(0, c, 0x4E, 0xF, 0xF, true);
    c += __builtin_amdgcn_update_dpp(0, c, 0x141, 0xF, 0xF, true);
    c += __builtin_amdgcn_update_dpp(0, c, 0x140, 0xF, 0xF, true);
    return c;
}
__device__ __forceinline__ int half_sum(int c) {
    c = row16_sum_i(c);
    auto rr = __builtin_amdgcn_permlane16_swap((unsigned)c, (unsigned)c, false, false);
    return (int)rr[0] + (int)rr[1];
}
__device__ __forceinline__ float xor16_max(float m) { auto rr = __builtin_amdgcn_permlane16_swap(__float_as_uint(m), __float_as_uint(m), false, false); return __builtin_fmaxf(__uint_as_float(rr[0]), __uint_as_float(rr[1])); }
__device__ __forceinline__ float xor32_max(float m) { auto rr = __builtin_amdgcn_permlane32_swap(__float_as_uint(m), __float_as_uint(m), false, false); return __builtin_fmaxf(__uint_as_float(rr[0]), __uint_as_float(rr[1])); }
__device__ __forceinline__ float xor16_sum(float m) { auto rr = __builtin_amdgcn_permlane16_swap(__float_as_uint(m), __float_as_uint(m), false, false); return __uint_as_float(rr[0]) + __uint_as_float(rr[1]); }
__device__ __forceinline__ float xor32_sum(float m) { auto rr = __builtin_amdgcn_permlane32_swap(__float_as_uint(m), __float_as_uint(m), false, false); return __uint_as_float(rr[0]) + __uint_as_float(rr[1]); }
#define CNT4(c, u0, u1, u2, u3, cand) do { unsigned long long _t0, _t1, _t2, _t3; \
    asm volatile("v_cmp_ge_u32_e64 %1, %5, %9\n\tv_cmp_ge_u32_e64 %2, %6, %9\n\tv_cmp_ge_u32_e64 %3, %7, %9\n\tv_cmp_ge_u32_e64 %4, %8, %9\n\t" \
                 "v_addc_co_u32_e64 %0, vcc, 0, %0, %1\n\tv_addc_co_u32_e64 %0, vcc, 0, %0, %2\n\tv_addc_co_u32_e64 %0, vcc, 0, %0, %3\n\tv_addc_co_u32_e64 %0, vcc, 0, %0, %4" \
                 : "+v"(c), "=&s"(_t0), "=&s"(_t1), "=&s"(_t2), "=&s"(_t3) : "v"(u0), "v"(u1), "v"(u2), "v"(u3), "v"(cand) : "vcc"); } while (0)
constexpr int IX_KOFF = 32768, IX_KPITCH = 144, IX_KBUF = 256 * IX_KPITCH;
__device__ __forceinline__ void idx_unit(Frame& F, int b, int qb, int wave, int lane) {
    const int q0 = qb * 16, hi = lane >> 5, r = lane & 31, tid = F.tid;
    const int myq = q0 + 2 * wave + hi;
    const int arow_q = (r >> 2) & 1, arow_h = (r & 3) | ((r >> 3) << 2);
    half8 a[4];
    { const f16* ap = F.IQ + ((size_t)b * T + q0 + 2 * wave + arow_q) * 1024 + arow_h * 64 + 8 * hi;
#pragma unroll
      for (int s = 0; s < 4; ++s) a[s] = *(const half8*)(ap + 16 * s); }
    float wv[16];
    { const f32x4* wp = (const f32x4*)(F.IW + ((size_t)b * T + myq) * 16);
#pragma unroll
      for (int k = 0; k < 4; ++k) { const f32x4 t = wp[k]; wv[4 * k] = t.x; wv[4 * k + 1] = t.y; wv[4 * k + 2] = t.z; wv[4 * k + 3] = t.w; } }
    LAS unsigned* sl = (LAS unsigned*)(F.lds + wave * 4096) + lane;
    unsigned u[128];
    const int last = (q0 + 15) >> 5, nstage = (last >> 3) + 1;
    const f16* sg = F.IK + ((size_t)b * T + (tid >> 1)) * 64 + 32 * (tid & 1);
    const int sst = IX_KOFF + (tid >> 1) * IX_KPITCH + 64 * (tid & 1);
    v4u sr[4];
#pragma unroll
    for (int j = 0; j < 4; ++j) sr[j] = *(const v4u*)(sg + 8 * j);
#pragma unroll
    for (int j = 0; j < 4; ++j) *(LAS v4u*)(F.lds + sst + 16 * j) = sr[j];
    __syncthreads();
    const int kread = IX_KOFF + r * IX_KPITCH + 16 * hi;
#pragma unroll
    for (int c = 0; c < 8; ++c) {
        if (16 * c <= last) {
#pragma unroll 1
            for (int st = 0; st < 2; ++st) {
                const int sidx = 2 * c + st;
                if (sidx < nstage) {
                    const bool more = (sidx + 1) < nstage;
                    if (more) {
#pragma unroll
                        for (int j = 0; j < 4; ++j) sr[j] = *(const v4u*)(sg + (size_t)(sidx + 1) * 256 * 64 + 8 * j);
                    }
                    const int kb = kread + (sidx & 1) * IX_KBUF;
#pragma unroll 1
                    for (int ii = 0; ii < 8; ++ii) {
                        const int i = 8 * sidx + ii;
                        half8 bfr[4];
#pragma unroll
                        for (int s = 0; s < 4; ++s) bfr[s] = *(const LAS half8*)(F.lds + kb + ii * 32 * IX_KPITCH + 32 * s);
                        f32x16 acc = zero16();
#pragma unroll
                        for (int s = 0; s < 4; ++s) acc = __builtin_amdgcn_mfma_f32_32x32x16_f16(a[s], bfr[s], acc, 0, 0, 0);
                        float sc = 0.f;
#pragma unroll
                        for (int hh = 0; hh < 16; ++hh) sc = __builtin_fmaf(wv[hh], __builtin_amdgcn_fmed3f(acc[hh], 0.f, INFINITY), sc);
                        const int key = 32 * i + r;
                        sl[(8 * st + ii) * 64] = (key <= myq) ? fkey(sc) : 0u;
                    }
                    if (more) {
#pragma unroll
                        for (int j = 0; j < 4; ++j) *(LAS v4u*)(F.lds + sst + ((sidx + 1) & 1) * IX_KBUF + 16 * j) = sr[j];
                    }
                    __syncthreads();
                } else {
#pragma unroll 1
                    for (int ii = 0; ii < 8; ++ii) sl[(8 * st + ii) * 64] = 0u;
                }
            }
#pragma unroll
            for (int ii = 0; ii < 16; ++ii) u[16 * c + ii] = sl[ii * 64];
        } else {
#pragma unroll
            for (int ii = 0; ii < 16; ++ii) u[16 * c + ii] = 0u;
        }
    }
    unsigned Tk = 0u; bool done = false;
#pragma unroll 1
    for (int bit = 31; bit >= 0; --bit) {
        const unsigned cand = Tk | (1u << bit);
        int c = 0;
#pragma unroll
        for (int g = 0; g < 8; ++g) {
            if (16 * g <= last) {
#pragma unroll
                for (int i = 0; i < 16; i += 4) CNT4(c, u[16 * g + i], u[16 * g + i + 1], u[16 * g + i + 2], u[16 * g + i + 3], cand);
            }
        }
        asm volatile("s_nop 2" : "+v"(c));
        c = half_sum(c);
        if (!done && c >= 256) { Tk = cand; done = (c == 256); }
        if (__all(done)) break;
    }
    int cgt = 0, ceq = 0;
#pragma unroll
    for (int i = 0; i < 128; ++i) { cgt += (u[i] > Tk) ? 1 : 0; ceq += (u[i] == Tk) ? 1 : 0; }
    cgt = half_sum(cgt); ceq = half_sum(ceq);
    int Jthr = (Tk == 0u) ? -1 : 4095;
    const int need = 256 - cgt;
    const bool trim = (Tk != 0u) && (ceq > need);
    if (__any(trim)) {
        int J = 0;
#pragma unroll 1
        for (int bit = 11; bit >= 0; --bit) {
            const int cand = J | (1 << bit);
            unsigned Tk1 = Tk; asm volatile("" : "+v"(Tk1));
            const int cr = cand - r;
            int c = 0;
#pragma unroll
            for (int i = 0; i < 128; ++i) c += ((u[i] == Tk1) && (32 * i < cr)) ? 1 : 0;
            c = half_sum(c);
            if (c < need) J = cand;
        }
        if (trim) Jthr = J;
    }
    const int jt = Jthr - r;
    unsigned Tk2 = Tk; asm volatile("" : "+v"(Tk2));
    unsigned mlo0 = 0u, mhi0 = 0u, mlo1 = 0u, mhi1 = 0u;
#pragma unroll
    for (int g = 0; g < 8; ++g) {
        if (16 * g <= last) {
#pragma unroll
            for (int ii = 0; ii < 16; ++ii) {
                const int i = 16 * g + ii;
                const bool sel = (u[i] > Tk2) || ((u[i] == Tk2) && (32 * i <= jt));
                const unsigned long long bal = __ballot(sel);
                const unsigned lo = (unsigned)bal, hi_ = (unsigned)(bal >> 32);
                int lv = lane; asm volatile("" : "+v"(lv));
                const bool me = (lv == (i & 63));
                if (i < 64) { mlo0 = me ? lo : mlo0; mhi0 = me ? hi_ : mhi0; }
                else { mlo1 = me ? lo : mlo1; mhi1 = me ? hi_ : mhi1; }
            }
        }
    }
    unsigned* mp = F.MASK + ((size_t)b * T + q0 + 2 * wave) * 128;
    mp[lane] = mlo0; mp[64 + lane] = mlo1; mp[128 + lane] = mhi0; mp[192 + lane] = mhi1;
}

constexpr int AT_PITCH = 272, AT_KBYTES = 128 * AT_PITCH, AT_BUF = 2 * AT_KBYTES;
__device__ __forceinline__ void attn_unit(Frame& F, int b, int kvh, int qb) {
    const int tid = F.tid, lane = F.lane, wave = F.wave, fr = lane & 15, fq = lane >> 4;
    const int q = qb * 32 + 4 * wave + (fr >> 2), head = 4 * kvh + (fr & 3);
    const size_t tok = (size_t)b * T + q;
    bf16x8 qf[4];
    { const bf16* qp = F.PROJ + tok * NPB + C_AQ + head * 128 + 8 * fq;
#pragma unroll
      for (int s = 0; s < 4; ++s) qf[s] = *(const bf16x8*)(qp + 32 * s); }
    const v4u* mrow = (const v4u*)(F.MASK + tok * 128);
    f32x4 O[8];
#pragma unroll
    for (int k = 0; k < 8; ++k) O[k] = (f32x4){0.f, 0.f, 0.f, 0.f};
    float mrun = -INFINITY, lsum = 0.f;
    const int nt2 = (qb + 2) >> 1, nst = (nt2 + 1) >> 1;
    const int srow = tid >> 2, spart = (tid & 3) * 32;
    const bf16* kg = F.PROJ + ((size_t)b * T + srow) * NPB + C_AK + kvh * 128 + spart;
    const bf16* vg = F.AVT + ((size_t)(b * 2 + kvh) * 128 + srow) * T + spart;
    LAS unsigned char* lds = F.lds;
    const int kst = srow * AT_PITCH + spart * 2, vst = AT_KBYTES + kst;
    v4u kr[4], vr[4];
#pragma unroll
    for (int j = 0; j < 4; ++j) { kr[j] = *(const v4u*)(kg + 8 * j); vr[j] = *(const v4u*)(vg + 8 * j); }
#define AT_VWRITE(base) do { _Pragma("unroll") for (int j = 0; j < 4; ++j) { const int po = (16 * (j & 1) + 4 * (j >> 1)) * 2; \
        *(LAS v2u*)(lds + (base) + vst + po) = (v2u){vr[j].x, vr[j].y}; *(LAS v2u*)(lds + (base) + vst + po + 16) = (v2u){vr[j].z, vr[j].w}; } } while (0)
#pragma unroll
    for (int j = 0; j < 4; ++j) *(LAS v4u*)(lds + kst + 16 * j) = kr[j];
    AT_VWRITE(0);
    v4u W4 = mrow[0], W4n = W4;
    __syncthreads();
    for (int st = 0; st < nst; ++st) {
        const int bo = (st & 1) * AT_BUF;
        const bool more = (st + 1 < nst);
        if (more) {
#pragma unroll
            for (int j = 0; j < 4; ++j) { kr[j] = *(const v4u*)(kg + (size_t)(st + 1) * 128 * NPB + 8 * j); vr[j] = *(const v4u*)(vg + (st + 1) * 128 + 8 * j); }
            W4n = mrow[st + 1];
        }
#pragma unroll
        for (int sub = 0; sub < 2; ++sub) {
            if (2 * st + sub < nt2) {
                f32x4 sg[4];
#pragma unroll
                for (int g = 0; g < 4; ++g) sg[g] = (f32x4){0.f, 0.f, 0.f, 0.f};
#pragma unroll
                for (int s = 0; s < 4; ++s)
#pragma unroll
                    for (int g = 0; g < 4; ++g) { const bf16x8 kf = *(const LAS bf16x8*)(lds + bo + (64 * sub + 16 * g + fr) * AT_PITCH + (32 * s + 8 * fq) * 2); sg[g] = MFMA16(kf, qf[s], sg[g]); }
                const unsigned Wa = W4[2 * sub] >> (4 * fq), Wb = W4[2 * sub + 1] >> (4 * fq);
                float mx = -INFINITY;
#pragma unroll
                for (int g = 0; g < 4; ++g)
#pragma unroll
                    for (int j = 0; j < 4; ++j) { const bool v = (((g < 2) ? Wa : Wb) >> (16 * (g & 1) + j)) & 1u; sg[g][j] = v ? sg[g][j] : -INFINITY; mx = __builtin_fmaxf(mx, sg[g][j]); }
                mx = xor16_max(mx); mx = xor32_max(mx);
                const float mnew = __builtin_fmaxf(mrun, mx);
                const float muse = (mnew == -INFINITY) ? 0.f : mnew;
                const float alpha = __builtin_amdgcn_exp2f(mrun - muse);
                const bool resc = __any(mnew != mrun);
                mrun = mnew;
                float p[16]; float ps = 0.f;
#pragma unroll
                for (int g = 0; g < 4; ++g)
#pragma unroll
                    for (int j = 0; j < 4; ++j) { p[4 * g + j] = __builtin_amdgcn_exp2f(sg[g][j] - muse); ps += p[4 * g + j]; }
                lsum = lsum * alpha + ps;
                v4u pp0, pp1; pp0.x = pk2(p[0], p[1]); pp0.y = pk2(p[2], p[3]); pp0.z = pk2(p[4], p[5]); pp0.w = pk2(p[6], p[7]);
                pp1.x = pk2(p[8], p[9]); pp1.y = pk2(p[10], p[11]); pp1.z = pk2(p[12], p[13]); pp1.w = pk2(p[14], p[15]);
                const bf16x8 pb0 = __builtin_bit_cast(bf16x8, pp0), pb1 = __builtin_bit_cast(bf16x8, pp1);
                if (resc) {
#pragma unroll
                    for (int blk = 0; blk < 8; ++blk) O[blk] = O[blk] * alpha;
                }
#pragma unroll
                for (int blk = 0; blk < 8; ++blk) {
                    const LAS unsigned char* vp = lds + bo + AT_KBYTES + (16 * blk + fr) * AT_PITCH + (64 * sub + 8 * fq) * 2;
                    const bf16x8 av0 = *(const LAS bf16x8*)vp, av1 = *(const LAS bf16x8*)(vp + 64);
                    O[blk] = MFMA16(av0, pb0, O[blk]);
                    O[blk] = MFMA16(av1, pb1, O[blk]);
                }
            }
        }
        if (more) { const int bn = ((st + 1) & 1) * AT_BUF;
#pragma unroll
            for (int j = 0; j < 4; ++j) *(LAS v4u*)(lds + bn + kst + 16 * j) = kr[j];
            AT_VWRITE(bn); }
        __syncthreads();
        W4 = W4n;
    }
#undef AT_VWRITE
    lsum = xor16_sum(lsum); lsum = xor32_sum(lsum);
    const float inv = 1.0f / lsum;
    bf16* op = F.C + tok * D + 1024 + head * 128 + 4 * fq;
#pragma unroll
    for (int blk = 0; blk < 8; ++blk) { v2u o; o.x = pk2(O[blk][0] * inv, O[blk][1] * inv); o.y = pk2(O[blk][2] * inv, O[blk][3] * inv); *(v2u*)(op + 16 * blk) = o; }
}

struct Args { const void* in[15]; float* out; unsigned char* ws; int ph_lo, ph_hi; };
constexpr int NPHASE = 12;
__global__ void __launch_bounds__(NWAVES * 64, 2) mk_fwd(Args args) {
    extern __shared__ __attribute__((aligned(16))) unsigned char lds[];
    Frame F;
    F.lds = (LAS unsigned char*)lds;
    F.tid = threadIdx.x; F.lane = F.tid & 63; F.wave = __builtin_amdgcn_readfirstlane(F.tid >> 6);
    F.G = gridDim.x; F.bid = blockIdx.x;
    unsigned char* ws = args.ws;
    F.x = (const float*)args.in[0]; F.pos = (const int*)args.in[1];
    F.n1 = (const float*)args.in[2]; F.wg1 = (const float*)args.in[3]; F.wu1 = (const float*)args.in[4]; F.wd1 = (const float*)args.in[5];
    F.nmix = (const float*)args.in[6]; F.win = (const float*)args.in[7]; F.nret = (const float*)args.in[8]; F.wout = (const float*)args.in[9];
    F.n2 = (const float*)args.in[10]; F.wg2 = (const float*)args.in[11]; F.wu2 = (const float*)args.in[12]; F.wd2 = (const float*)args.in[13]; F.nfin = (const float*)args.in[14];
    F.X = args.out;
    F.TAB = (float2*)(ws + WS_TAB); F.WGU = (bf16*)(ws + WS_WGU); F.WD = (bf16*)(ws + WS_WD); F.WIN = (bf16*)(ws + WS_WIN); F.WOUT = (bf16*)(ws + WS_WOUT);
    F.A = (bf16*)(ws + WS_A); F.PROJ = (bf16*)(ws + WS_PROJ); F.PIDX = (float*)(ws + WS_PIDX); F.RKT = (bf16*)(ws + WS_RKT); F.RVT = (bf16*)(ws + WS_RVT); F.AVT = (bf16*)(ws + WS_AVT);
    F.IQ = (f16*)(ws + WS_IQ); F.IK = (f16*)(ws + WS_IK); F.IW = (float*)(ws + WS_IW); F.KV = (float*)(ws + WS_KV); F.ST = (bf16*)(ws + WS_ST); F.MASK = (unsigned*)(ws + WS_MASK); F.SSQ = (float*)(ws + WS_SSQ); F.C = (bf16*)(ws + WS_PIDX);
    volatile LAS unsigned* MISC = (volatile LAS unsigned*)(F.lds + MISC_OFF);
    for (int u = F.tid; u < (LDS_BYTES - LDSCTL_OFF) / 4; u += NWAVES * 64) ((LAS unsigned*)(F.lds + LDSCTL_OFF))[u] = 0u;
    __syncthreads();
    const int lo = args.ph_lo, hi = args.ph_hi;
    XcdBarrier bar; bar.bar = (unsigned*)(ws + WS_CTL) + CW_BAR; bar.x = 0; bar.st = nullptr;
    if (hi - lo > 1) bar = xcd_barrier_post((unsigned*)(ws + WS_CTL) + CW_BAR, MISC + 8);
#ifndef MK_PHMASK
#define MK_PHMASK 0xFFFF
#endif
#define IN(k) (((MK_PHMASK >> (k)) & 1) && lo <= (k) && (k) < hi)
#define SEAM(k) do { if (IN(k) && IN((k) + 1)) xcd_barrier(bar); } while (0)
    bf16* H = F.PROJ;

#ifndef MK_REPEAT
#define MK_REPEAT 0
#endif
#define PHASE(k, ...) do { if (IN(k)) { __VA_ARGS__ if ((MK_REPEAT >> (k)) & 1) { xcd_barrier(bar); __VA_ARGS__ } } SEAM(k); } while (0)
    const int gwv = F.bid * NWAVES + F.wave, ngw = F.G * NWAVES;
    PHASE(0, { convert_job<0>(F, F.bid, F.G); rope_table(F); prep_rows(F, F.x, F.n1, F.A); });
    PHASE(1, { pg8::Gemm g{F.A, F.WGU, M, 2 * FF, D}; pg8::StaticOrder S; S.init(M, 2 * FF, F.G, F.bid); load_rstd_panels(F, S, F.SSQ); EpiSwiGLU E{H, (const LAS float*)(F.lds + RS_OFF)};
        pg8::gemm_phase<EpiSwiGLU, pg8::StaticOrder, true, true>(F.lds, g, S, E);
        { const int nfull = (M / 256) * (2 * FF / 256) % F.G; if (nfull > 0 && F.bid >= nfull) { convert_job<1>(F, F.bid - nfull, F.G - nfull); }
          else if (nfull == 0) { convert_job<1>(F, F.bid, F.G); } } });
    PHASE(2, { pg8::Gemm g{H, F.WD, M, D, FF}; pg8::StaticOrder S; S.init(M, D, F.G, F.bid); EpiResid E{F.x, F.X, 0.5f, F.A, F.nmix, F.SSQ};
        pg8::gemm_phase<EpiResid, pg8::StaticOrder, true, true>(F.lds, g, S, E); });
    PHASE(3, { pg8::Gemm g{F.A, F.WIN, M, NINP, D}; pg8::StaticOrder S; S.init(M, NINP, F.G, F.bid); load_rstd_panels(F, S, F.SSQ); EpiProj E{F.PROJ, F.PIDX, (const LAS float*)(F.lds + RS_OFF)};
        pg8::gemm_phase<EpiProj, pg8::StaticOrder, true, true>(F.lds, g, S, E);
        { const int nfull = (M / 256) * (NINP / 256) % F.G; if (nfull > 0 && F.bid >= nfull) { convert_job<2>(F, F.bid - nfull, F.G - nfull); }
          else if (nfull == 0) { convert_job<2>(F, F.bid, F.G); } } });
    PHASE(4, { for (int tt = F.bid; tt < M / 32; tt += F.G) post_tile(F, tt); });
    PHASE(5, {
        for (int u2 = F.bid; u2 < 256; u2 += F.G) ret_kv_unit(F, 2 * u2 + (F.wave >> 2), F.wave & 3, F.lane);
        for (int c = F.bid; c < 256; c += F.G) {
            _Pragma("unroll 1") for (int k = 0; k < 2; ++k) { const int b = c & 1, i = c >> 1; idx_unit(F, b, k ? 255 - i : i, F.wave, F.lane); } }
    });
    PHASE(6, { ret_scan(F); });
    PHASE(7, {
        for (int u2 = F.bid; u2 < 256; u2 += F.G) ret_out_unit(F, 2 * u2 + (F.wave >> 2), F.wave & 3, F.lane);
        for (int p = F.bid; p < 256; p += F.G) { const int b = p >> 7, kvh = (p >> 6) & 1, i = p & 63;
            _Pragma("unroll 1") for (int k = 0; k < 2; ++k) attn_unit(F, b, kvh, k ? 127 - i : i); }
    });
    PHASE(8, { pg8::Gemm g{F.C, F.WOUT, M, D, D}; pg8::StaticOrder S; S.init(M, D, F.G, F.bid); EpiResid E{F.X, F.X, 1.0f, F.A, F.n2, F.SSQ};
        pg8::gemm_phase<EpiResid, pg8::StaticOrder, true, true>(F.lds, g, S, E); });
    PHASE(9, { pg8::Gemm g{F.A, F.WGU, M, 2 * FF, D}; pg8::StaticOrder S; S.init(M, 2 * FF, F.G, F.bid); load_rstd_panels(F, S, F.SSQ); EpiSwiGLU E{H, (const LAS float*)(F.lds + RS_OFF)};
        pg8::gemm_phase<EpiSwiGLU, pg8::StaticOrder, true, true>(F.lds, g, S, E); });
    PHASE(10, { pg8::Gemm g{H, F.WD, M, D, FF}; pg8::StaticOrder S; S.init(M, D, F.G, F.bid); EpiResid E{F.X, F.X, 0.5f, nullptr, nullptr, F.SSQ};
        pg8::gemm_phase<EpiResid, pg8::StaticOrder, true, true>(F.lds, g, S, E); });
    PHASE(11, { rms_final(F); });
#undef PHASE
#undef IN
#undef SEAM
}

extern "C" void kernel_launch(void* const* d_in, const int* in_sizes, int n_in, void* d_out, int out_size, void* d_ws, size_t ws_size, hipStream_t stream) {
    static int grid = 0;
    if (grid == 0) {
        if (n_in != 15 || in_sizes[0] != M * D || out_size != M * D || ws_size < WS_END) { fprintf(stderr, "kernel_launch: unexpected shapes (n_in %d, in0 %d, out %d, ws %zu < %zu)\n", n_in, n_in > 0 ? in_sizes[0] : -1, out_size, ws_size, (size_t)WS_END); grid = -1; return; }
        int dev = 0, cus = 0;
        if (hipGetDevice(&dev) != hipSuccess || hipDeviceGetAttribute(&cus, hipDeviceAttributeMultiprocessorCount, dev) != hipSuccess) { grid = -1; return; }
        if (hipFuncSetAttribute((const void*)mk_fwd, hipFuncAttributeMaxDynamicSharedMemorySize, LDS_BYTES) != hipSuccess) { fprintf(stderr, "kernel_launch: hipFuncSetAttribute failed\n"); grid = -1; return; }
        int per_cu = 0;
        if (hipOccupancyMaxActiveBlocksPerMultiprocessor(&per_cu, (const void*)mk_fwd, NWAVES * 64, LDS_BYTES) != hipSuccess || per_cu < 1) fprintf(stderr, "kernel_launch: occupancy query reports %d\n", per_cu);
        (void)hipGetLastError();
        grid = cus;
    }
    if (grid < 0) return;
    (void)hipMemsetAsync((char*)d_ws + WS_CTL, 0, CTL_ZERO_BYTES, stream);
    Args a{};
    for (int i = 0; i < 15; ++i) a.in[i] = d_in[i];
    a.out = (float*)d_out; a.ws = (unsigned char*)d_ws;
#if MK_PER_PHASE
    for (int p = 0; p < NPHASE; ++p) { a.ph_lo = p; a.ph_hi = p + 1; hipLaunchKernelGGL(mk_fwd, dim3(grid), dim3(NWAVES * 64), LDS_BYTES, stream, a); }
#else
    a.ph_lo = 0; a.ph_hi = NPHASE;
    hipLaunchKernelGGL(mk_fwd, dim3(grid), dim3(NWAVES * 64), LDS_BYTES, stream, a);
#endif
}
```

```cpp
#include <hip/hip_runtime.h>
#include <cstdio>
#include <cstdint>

#ifndef MK_PER_PHASE
#define MK_PER_PHASE 0
#endif

#ifndef MK_ABL
#define MK_ABL 0
#endif
#ifndef MK_TA
#define MK_TA -1
#endif
#ifndef MK_TB
#define MK_TB -1
#endif
#define MK_STAMP(ldsbase, n) do { if (((n) == MK_TA || (n) == MK_TB) && blockIdx.x == 0 && threadIdx.x == 0) { \
    *(volatile __attribute__((address_space(3))) unsigned long long*)((ldsbase) + 147200 + ((n) == MK_TB ? 16 : 8)) = __builtin_amdgcn_s_memrealtime(); } } while (0)
namespace pg8 {
#define PG8_LAS __attribute__((address_space(3)))
typedef unsigned short bf16_t;
typedef short bf16x8 __attribute__((ext_vector_type(8)));
typedef float f32x4 __attribute__((ext_vector_type(4)));
typedef unsigned u32x4 __attribute__((ext_vector_type(4)));
constexpr int BM = 256, BK = 64, HALF = 128, HTB = HALF * BK * 2, STAGE_BYTES = 8 * HTB, NXCD = 8, WGM = 8;

__host__ __device__ __forceinline__ int lds_byte(int r, int c) { const int st = (r >> 4) * 2 + (c >> 5), rr = r & 15, cc = c & 31, ob = rr * 64 + cc * 2; return st * 1024 + (ob ^ (((ob >> 9) & 1) << 5)); }
__host__ __device__ __forceinline__ void stage_rc(int b, int& R, int& C) { const int st = b / 1024, sb = b % 1024, swz = sb ^ (((sb >> 9) & 1) << 5); R = (st >> 1) * 16 + swz / 64; C = (st & 1) * 32 + (swz % 64) / 2; }
__host__ __device__ __forceinline__ int perm32(int rho) { const int n = rho >> 4, i = rho & 15; return 8 * (i >> 2) + 4 * n + (i & 3); }

struct Unit { int pm, pn; };
struct Gemm { const bf16_t* A; const bf16_t* Bt; int M, N, K; };

struct StaticOrder {
    int nM, nN, nwg, G, c;
    __host__ __device__ void init(int M, int N, int G_, int c_) { nM = M / BM; nN = N / BM; nwg = nM * nN; G = G_; c = c_; }
    __host__ __device__ bool next(int i, Unit& u) const {
        const long L = (long)i * G + c; if (L >= nwg) return false;
        int wgid = (int)L; { const int q = nwg / NXCD, r = nwg % NXCD, xcd = wgid % NXCD, off = wgid / NXCD; wgid = (xcd < r ? xcd * (q + 1) : r * (q + 1) + (xcd - r) * q) + off; }
        const int nig = WGM * nN, gid = wgid / nig, fm = gid * WGM, gsz = (nM - fm) < WGM ? (nM - fm) : WGM;
        u.pm = fm + ((wgid % nig) % gsz); u.pn = (wgid % nig) / gsz; return true;
    }
    __device__ __forceinline__ void a_ready(const Unit&) const {}
    __device__ __forceinline__ void done(const Unit&) const {}
};

template <class Epi, class Sched, bool ALIGN_EPI = false, bool SP2 = false>
__device__ __forceinline__ void gemm_phase(PG8_LAS unsigned char* lds, const Gemm g, const Sched& S, const Epi& E, const int tid, const int sb = -100) {
    const int wid = __builtin_amdgcn_readfirstlane(tid >> 6), lane = tid & 63, wr = wid >> 2, wc = wid & 3, fr = lane & 15, fq = lane >> 4;
    const int K = g.K, nt = K / BK;
    unsigned voffA[2], voffB[2];
#pragma unroll
    for (int i = 0; i < 2; ++i) { int R, C; stage_rc(tid * 16 + i * 8192, R, C); const int Rb = Epi::PERM ? ((R & ~31) + perm32(R & 31)) : R;
        voffA[i] = (unsigned)(R * K + C) * 2u; voffB[i] = (unsigned)(Rb * K + C) * 2u; }
    const size_t kstep = (size_t)(BK * 2);
    const size_t hstep = (size_t)HALF * K * 2;
    const size_t tstep = 2 * hstep;
    const unsigned ldsw = (unsigned)wid * 1024u;
    const int aoff = lds_byte(wr * 64 + fr, fq * 8), boff = lds_byte(wc * 32 + fr, fq * 8);
#define PG8_SA(b, h) (((b) * 2 + (h)) * HTB)
#define PG8_SB(b, h) ((4 + (b) * 2 + (h)) * HTB)
#define PG8_STAGE(bufoff, gbase, voff) do { _Pragma("unroll") for (int _i = 0; _i < 2; ++_i) \
        __builtin_amdgcn_global_load_lds((const unsigned*)((const char*)(gbase) + (voff)[_i]), (PG8_LAS unsigned*)(lds + (bufoff) + ldsw + _i * 8192), 16, 0, 0); } while (0)
#define PG8_LDA(dst, b, h) do { _Pragma("unroll") for (int m = 0; m < 4; ++m) _Pragma("unroll") for (int k = 0; k < 2; ++k) dst[m][k] = *(const PG8_LAS bf16x8*)(lds + PG8_SA(b, h) + aoff + m * 2048 + k * 1024); } while (0)
#define PG8_LDB(dst, b, h) do { _Pragma("unroll") for (int n = 0; n < 2; ++n) _Pragma("unroll") for (int k = 0; k < 2; ++k) dst[n][k] = *(const PG8_LAS bf16x8*)(lds + PG8_SB(b, h) + boff + n * 2048 + k * 1024); } while (0)
#define PG8_MMA(ai, bj, At, Bt) do { __builtin_amdgcn_s_setprio(1); _Pragma("unroll") for (int m = 0; m < 4; ++m) _Pragma("unroll") for (int n = 0; n < 2; ++n) _Pragma("unroll") for (int k = 0; k < 2; ++k) \
        acc[ai][bj][m][n] = __builtin_amdgcn_mfma_f32_16x16x32_bf16(Bt[n][k], At[m][k], acc[ai][bj][m][n], 0, 0, 0); __builtin_amdgcn_s_setprio(0); } while (0)
#define PG8_WAIT_V(n) asm volatile("s_waitcnt vmcnt(" #n ")" ::: "memory")
#define PG8_WAIT_L(n) asm volatile("s_waitcnt lgkmcnt(" #n ")" ::: "memory")
#define PG8_BAR __builtin_amdgcn_s_barrier()
#define PG8_SCHED __builtin_amdgcn_sched_barrier(0)
    Unit cur, nxt; int ui = 0;
    if (!S.next(0, cur)) return;
    f32x4 acc[2][2][4][2];
#pragma unroll
    for (int a = 0; a < 2; ++a)
#pragma unroll
        for (int b = 0; b < 2; ++b)
#pragma unroll
            for (int m = 0; m < 4; ++m)
#pragma unroll
                for (int n = 0; n < 2; ++n) acc[a][b][m][n] = (f32x4){0.f, 0.f, 0.f, 0.f};
    bf16x8 At[4][2], B0[2][2], B1[2][2];
    const char* cA = (const char*)g.A + (size_t)cur.pm * tstep; const char* cB = (const char*)g.Bt + (size_t)cur.pn * tstep;
    S.a_ready(cur);
    if constexpr (SP2) {
        PG8_STAGE(PG8_SB(0, 0), cB, voffB); PG8_STAGE(PG8_SB(0, 1), cB + hstep, voffB); PG8_STAGE(PG8_SA(0, 0), cA, voffA); PG8_STAGE(PG8_SA(0, 1), cA + hstep, voffA);
        if (wr == 1) PG8_BAR;
        PG8_WAIT_V(2); PG8_BAR;
        PG8_STAGE(PG8_SB(1, 0), cB + kstep, voffB); PG8_STAGE(PG8_SA(1, 0), cA + kstep, voffA); PG8_STAGE(PG8_SB(1, 1), cB + hstep + kstep, voffB);
        PG8_WAIT_V(6); PG8_BAR;
    } else {
        PG8_STAGE(PG8_SB(0, 0), cB, voffB); PG8_STAGE(PG8_SA(0, 0), cA, voffA); PG8_STAGE(PG8_SB(0, 1), cB + hstep, voffB); PG8_STAGE(PG8_SA(0, 1), cA + hstep, voffA);
        if (wr == 1) PG8_BAR;
        PG8_WAIT_V(4); PG8_BAR;
        PG8_STAGE(PG8_SB(1, 0), cB + kstep, voffB); PG8_STAGE(PG8_SA(1, 0), cA + kstep, voffA); PG8_STAGE(PG8_SB(1, 1), cB + hstep + kstep, voffB);
        PG8_WAIT_V(6); PG8_BAR;
    }
    MK_STAMP(lds, sb + 0);
    for (;;) {
        const bool has_next = S.next(ui + 1, nxt);
        const char* nA = has_next ? (const char*)g.A + (size_t)nxt.pm * tstep : cA; const char* nB = has_next ? (const char*)g.Bt + (size_t)nxt.pn * tstep : cB;
        for (int t = 0; t < nt; t += 2) {
            const bool last = (t == nt - 2);
            const char* a1 = cA + (size_t)(t + 1) * kstep;
            const char* a2 = last ? nA : cA + (size_t)(t + 2) * kstep; const char* b2 = last ? nB : cB + (size_t)(t + 2) * kstep;
            const char* a3 = a2 + kstep; const char* b3 = b2 + kstep;
            if (last && has_next) S.a_ready(nxt);
            if constexpr (SP2) {
            PG8_LDB(B0, 0, 0); PG8_LDB(B1, 0, 1); PG8_SCHED; PG8_LDA(At, 0, 0); PG8_STAGE(PG8_SA(1, 1), a1 + hstep, voffA);
            PG8_WAIT_V(8); PG8_WAIT_L(0); PG8_BAR; PG8_MMA(0, 0, At, B0); PG8_MMA(0, 1, At, B1); PG8_BAR; PG8_SCHED;
            PG8_LDA(At, 0, 1); PG8_STAGE(PG8_SB(0, 0), b2, voffB); PG8_STAGE(PG8_SB(0, 1), b2 + hstep, voffB); PG8_STAGE(PG8_SA(0, 0), a2, voffA);
            PG8_WAIT_V(8); PG8_WAIT_L(0); PG8_BAR; PG8_MMA(1, 0, At, B0); PG8_MMA(1, 1, At, B1); PG8_BAR; PG8_SCHED;
            PG8_LDB(B0, 1, 0); PG8_LDB(B1, 1, 1); PG8_SCHED; PG8_LDA(At, 1, 0); PG8_STAGE(PG8_SA(0, 1), a2 + hstep, voffA);
            PG8_WAIT_V(8); PG8_WAIT_L(0); PG8_BAR; PG8_MMA(0, 0, At, B0); PG8_MMA(0, 1, At, B1); PG8_BAR; PG8_SCHED;
            PG8_LDA(At, 1, 1); PG8_STAGE(PG8_SB(1, 0), b3, voffB); PG8_STAGE(PG8_SB(1, 1), b3 + hstep, voffB); PG8_STAGE(PG8_SA(1, 0), a3, voffA);
            PG8_WAIT_V(8); PG8_WAIT_L(0); PG8_BAR; PG8_MMA(1, 0, At, B0); PG8_MMA(1, 1, At, B1); PG8_BAR; PG8_SCHED;
            } else {
            PG8_LDB(B0, 0, 0); PG8_SCHED; PG8_LDA(At, 0, 0); PG8_STAGE(PG8_SA(1, 1), a1 + hstep, voffA);
            PG8_WAIT_L(8); PG8_BAR; PG8_WAIT_L(0); PG8_MMA(0, 0, At, B0); PG8_BAR; PG8_SCHED;
            PG8_LDB(B1, 0, 1); PG8_STAGE(PG8_SB(0, 0), b2, voffB);
            PG8_BAR; PG8_WAIT_L(0); PG8_MMA(0, 1, At, B1); PG8_BAR;
            PG8_LDA(At, 0, 1); PG8_STAGE(PG8_SA(0, 0), a2, voffA);
            PG8_BAR; PG8_WAIT_L(0); PG8_MMA(1, 0, At, B0); PG8_BAR; PG8_SCHED;
            PG8_STAGE(PG8_SB(0, 1), b2 + hstep, voffB);
            PG8_WAIT_V(6); PG8_BAR; PG8_MMA(1, 1, At, B1); PG8_BAR;
            PG8_LDB(B0, 1, 0); PG8_SCHED; PG8_LDA(At, 1, 0); PG8_STAGE(PG8_SA(0, 1), a2 + hstep, voffA);
            PG8_WAIT_L(8); PG8_BAR; PG8_WAIT_L(0); PG8_MMA(0, 0, At, B0); PG8_BAR; PG8_SCHED;
            PG8_LDB(B1, 1, 1); PG8_STAGE(PG8_SB(1, 0), b3, voffB);
            PG8_BAR; PG8_WAIT_L(0); PG8_MMA(0, 1, At, B1); PG8_BAR;
            PG8_LDA(At, 1, 1); PG8_STAGE(PG8_SA(1, 0), a3, voffA);
            PG8_BAR; PG8_WAIT_L(0); PG8_MMA(1, 0, At, B0); PG8_BAR; PG8_SCHED;
            PG8_STAGE(PG8_SB(1, 1), b3 + hstep, voffB);
            PG8_WAIT_V(6); PG8_BAR; PG8_MMA(1, 1, At, B1); PG8_BAR;
            }
        }
        if constexpr (ALIGN_EPI) { if (wr == 0) PG8_BAR; }
        if (ui == 0) MK_STAMP(lds, sb + 1);
        E(acc, cur, ui, wr, wc, fr, fq); S.done(cur);
        if (ui == 0) MK_STAMP(lds, sb + 2);
        if (!has_next) break;
#pragma unroll
        for (int a = 0; a < 2; ++a)
#pragma unroll
            for (int b = 0; b < 2; ++b)
#pragma unroll
                for (int m = 0; m < 4; ++m)
#pragma unroll
                    for (int n = 0; n < 2; ++n) acc[a][b][m][n] = (f32x4){0.f, 0.f, 0.f, 0.f};
        cur = nxt; cA = nA; cB = nB; ++ui;
        if constexpr (ALIGN_EPI) { if (wr == 1) PG8_BAR; }
    }
    MK_STAMP(lds, sb + 3);
    PG8_WAIT_V(0);
    if constexpr (!ALIGN_EPI) { if (wr == 0) PG8_BAR; }
    PG8_BAR;
    MK_STAMP(lds, sb + 4);
#undef PG8_SA
#undef PG8_SB
#undef PG8_STAGE
#undef PG8_LDA
#undef PG8_LDB
#undef PG8_MMA
#undef PG8_WAIT_V
#undef PG8_WAIT_L
#undef PG8_BAR
#undef PG8_SCHED
}
}

constexpr int NWAVES = 8;
constexpr int BATCH = 2, T = 4096, D = 2048, M = BATCH * T;
constexpr int HRET = 8, HKV = 2, FF = 5632;
constexpr int NPB = 5632;
constexpr int NIDXP = 1280;
constexpr int NIN = 6736, NINP = 6912;
constexpr int C_RQ = 0, C_RK = 1024, C_RV = 2048, C_RG = 3072, C_AQ = 4096, C_AK = 5120, C_AV = 5376;
constexpr float NORM_EPS = 1e-6f;

constexpr size_t MiB = 1u << 20;
constexpr size_t WS_CTL = 0, CTL_ZERO_BYTES = 65536;
constexpr size_t WS_TAB = 1 * MiB;
constexpr size_t WS_WGU = 5 * MiB;
constexpr size_t WS_WD = 49 * MiB;
constexpr size_t WS_WIN = 71 * MiB;
constexpr size_t WS_WOUT = 98 * MiB;
constexpr size_t WS_A = 106 * MiB;
constexpr size_t WS_PROJ = 138 * MiB;
constexpr size_t WS_PIDX = 226 * MiB;
constexpr size_t WS_RKT = 266 * MiB;
constexpr size_t WS_RVT = 282 * MiB;
constexpr size_t WS_AVT = 298 * MiB;
constexpr size_t WS_IQ = 302 * MiB;
constexpr size_t WS_IK = 318 * MiB;
constexpr size_t WS_IW = 319 * MiB;
constexpr size_t WS_KV = 320 * MiB;
constexpr size_t WS_ST = 352 * MiB;
constexpr size_t WS_MASK = 368 * MiB;
constexpr size_t WS_SSQ = 372 * MiB;
constexpr size_t WS_TAB2 = 373 * MiB;
constexpr size_t WS_END = 375 * MiB;
constexpr int CW_BAR = 4096;

constexpr int RING_BYTES = 131072;
constexpr int LDS_BYTES = 147456;
constexpr int LDSCTL_OFF = LDS_BYTES - 512, MISC_OFF = LDSCTL_OFF + 320;

#define GAS __attribute__((address_space(1)))
#define LAS __attribute__((address_space(3)))
typedef unsigned short bf16;
typedef _Float16 f16;
typedef _Float16 half8 __attribute__((ext_vector_type(8)));
typedef unsigned v4u __attribute__((ext_vector_type(4)));
typedef unsigned v2u __attribute__((ext_vector_type(2)));
typedef float f32x2 __attribute__((ext_vector_type(2)));
typedef float f32x4 __attribute__((ext_vector_type(4)));
typedef float f32x16 __attribute__((ext_vector_type(16)));
typedef short bf16x8 __attribute__((ext_vector_type(8)));
typedef __bf16 bf16x2_t __attribute__((ext_vector_type(2)));
typedef GAS unsigned gu32;
#define LDS_WAIT() asm volatile("s_waitcnt lgkmcnt(0)" ::: "memory")
__device__ __forceinline__ unsigned pk2(float lo, float hi) { f32x2 v = {lo, hi}; bf16x2_t b = __builtin_convertvector(v, bf16x2_t); return __builtin_bit_cast(unsigned, b); }
__device__ __forceinline__ float bflo(unsigned w) { return __uint_as_float(w << 16); }
__device__ __forceinline__ float bfhi(unsigned w) { return __uint_as_float(w & 0xffff0000u); }
__device__ __forceinline__ float silu_f(float g) { return g * __builtin_amdgcn_rcpf(1.f + __builtin_amdgcn_exp2f(-1.4426950408889634f * g)); }

#define XB_TMO      128
#define XB_XCNT(j)  (256  + 64 * (j))
#define XB_XSUB(j)  (1280 + 64 * (j))
#define XB_XGEN(j)  (2304 + 64 * (j))
#define XB_TOP      3328
#define XB_TOPGEN   3392
#define XCD_BAR_WORDS 3456
#define XB_SPIN_CAP (1u << 22)
__device__ __forceinline__ unsigned xb_ld(unsigned* p)              { return __hip_atomic_load(p, __ATOMIC_RELAXED, __HIP_MEMORY_SCOPE_AGENT); }
__device__ __forceinline__ unsigned xb_add(unsigned* p, unsigned v) { return __hip_atomic_fetch_add(p, v, __ATOMIC_RELAXED, __HIP_MEMORY_SCOPE_AGENT); }
__device__ __forceinline__ unsigned xb_xcc_id() { return (unsigned)__builtin_amdgcn_s_getreg((3 << 11) | 20) & 0xFu; }
#define XB_SPIN(cond, bar) do { unsigned _sp = 0; while (cond) { __builtin_amdgcn_s_sleep(1); \
    if ((++_sp & 255u) == 0u) { if (xb_ld(&(bar)[XB_TMO])) break; if (_sp > XB_SPIN_CAP) { atomicAdd(&(bar)[XB_TMO], 1u); break; } } } } while (0)
struct XcdBarrier { unsigned* bar; unsigned x; volatile LAS unsigned* st; };
__device__ __forceinline__ XcdBarrier xcd_barrier_post(unsigned* bar, volatile LAS unsigned* st) {
    XcdBarrier b; b.bar = bar; b.x = xb_xcc_id(); b.st = st;
    if (threadIdx.x == 0) (void)xb_add(&bar[XB_XCNT(b.x)], 1u);
    return b;
}
__device__ __forceinline__ void xcd_barrier_complete(unsigned* bar, unsigned x, unsigned& nloc, unsigned& nx) {
    const unsigned G = gridDim.x * gridDim.y * gridDim.z;
    unsigned sum, cnt, mine, sp = 0u;
    for (;;) {
        sum = 0u; cnt = 0u; mine = 0u;
#pragma unroll
        for (unsigned j = 0; j < 16; ++j) { const unsigned c = xb_ld(&bar[XB_XCNT(j)]); sum += c; cnt += (c > 0u) ? 1u : 0u; mine = (j == x) ? c : mine; }
        if (sum == G) break;
        __builtin_amdgcn_s_sleep(1);
        if ((++sp & 255u) == 0u) { if (xb_ld(&bar[XB_TMO])) break; if (sp > XB_SPIN_CAP) { atomicAdd(&bar[XB_TMO], 1u); break; } }
    }
    nloc = mine > 0u ? mine : 1u; nx = cnt > 0u ? cnt : 1u;
}
__device__ __forceinline__ void xcd_barrier(const XcdBarrier& b) {
    asm volatile("s_waitcnt vmcnt(0)" ::: "memory");
    __syncthreads();
    if (threadIdx.x == 0) {
        unsigned* bar = b.bar;
        __builtin_amdgcn_s_waitcnt(0);
        unsigned nloc = b.st[0], nx = b.st[1];
        if (nloc == 0u) { xcd_barrier_complete(bar, b.x, nloc, nx); b.st[0] = nloc; b.st[1] = nx; }
        const unsigned old = xb_add(&bar[XB_XSUB(b.x)], 1u);
        const unsigned gen = old / nloc;
        if (old + 1u == (gen + 1u) * nloc) {
            __builtin_amdgcn_fence(__ATOMIC_RELEASE, "agent");
            asm volatile("s_waitcnt vmcnt(0)" ::: "memory");
            const unsigned og = xb_add(&bar[XB_TOP], 1u);
            const unsigned tg = og / nx;
            if (og + 1u == (tg + 1u) * nx) xb_add(&bar[XB_TOPGEN], 1u);
            else XB_SPIN(xb_ld(&bar[XB_TOPGEN]) == tg, bar);
            __builtin_amdgcn_fence(__ATOMIC_ACQUIRE, "agent");
            xb_add(&bar[XB_XGEN(b.x)], 1u);
            asm volatile("s_waitcnt vmcnt(0)" ::: "memory");
        } else {
            XB_SPIN(xb_ld(&bar[XB_XGEN(b.x)]) == gen, bar);
            __builtin_amdgcn_fence(__ATOMIC_ACQUIRE, "agent");
            asm volatile("s_waitcnt vmcnt(0)" ::: "memory");
        }
    }
    __syncthreads();
}

struct Frame {
    LAS unsigned char* lds;
    int tid, lane, wave;
    int bid, G;
    const float* x; const int* pos;
    const float *n1, *wg1, *wu1, *wd1, *nmix, *win, *nret, *wout, *n2, *wg2, *wu2, *wd2, *nfin;
    float* X;
    unsigned char* ws;
};

__device__ __forceinline__ float wave_sum(float v) {
#pragma unroll
    for (int o = 1; o < 64; o <<= 1) v += __shfl_xor(v, o);
    return v;
}

__device__ __forceinline__ float xor16_sum(float m);
__device__ __forceinline__ float xor32_sum(float m);
constexpr int RS_OFF = RING_BYTES, RS_MAXU = 6;
__device__ __forceinline__ void load_rstd_panels(Frame& F, const pg8::StaticOrder& S, const float* ssq) {
    LAS float* rs = (LAS float*)(F.lds + RS_OFF);
    const int r = F.tid >> 1, hf = F.tid & 1;
    f32x4 p[RS_MAXU][4]; bool ok[RS_MAXU];
#pragma unroll
    for (int i = 0; i < RS_MAXU; ++i) { pg8::Unit u; ok[i] = S.next(i, u);
        if (ok[i]) { const f32x4* q = (const f32x4*)(ssq + (size_t)(u.pm * 256 + r) * 32 + 16 * hf);
#pragma unroll
            for (int k = 0; k < 4; ++k) p[i][k] = q[k]; } }
#pragma unroll
    for (int i = 0; i < RS_MAXU; ++i) if (ok[i]) {
        const f32x4 s4 = (p[i][0] + p[i][1]) + (p[i][2] + p[i][3]);
        float s = (s4.x + s4.y) + (s4.z + s4.w);
        s += __shfl_xor(s, 1);
        if (hf == 0) rs[i * 256 + r] = 1.0f / sqrtf(s * (1.f / D) + NORM_EPS);
    }
    __syncthreads();
}
struct EpiSwiGLU {
    static constexpr bool PERM = true;
    bf16* H; const LAS float* rs;
    __device__ __forceinline__ void operator()(const f32x4 (&acc)[2][2][4][2], const pg8::Unit& u, int ui, int wr, int wc, int fr, int fq) const {
        const int row0 = u.pm * 256 + wr * 64 + fr, col0 = u.pn * 128 + wc * 32 + 8 * fq;
#pragma unroll
        for (int ai = 0; ai < 2; ++ai)
#pragma unroll
            for (int m = 0; m < 4; ++m) {
                const int row = row0 + ai * 128 + m * 16;
                const float r = rs[ui * 256 + ai * 128 + wr * 64 + m * 16 + fr];
                bf16* rowp = H + (size_t)row * FF + col0;
                const f32x4 g0 = acc[ai][0][m][0] * r, g1 = acc[ai][0][m][1] * r, u0 = acc[ai][1][m][0] * r, u1 = acc[ai][1][m][1] * r;
                v4u w;
                w.x = pk2(silu_f(g0[0]) * u0[0], silu_f(g0[1]) * u0[1]); w.y = pk2(silu_f(g0[2]) * u0[2], silu_f(g0[3]) * u0[3]);
                w.z = pk2(silu_f(g1[0]) * u1[0], silu_f(g1[1]) * u1[1]); w.w = pk2(silu_f(g1[2]) * u1[2], silu_f(g1[3]) * u1[3]);
                *(v4u*)rowp = w;
            }
    }
};
template <bool BASEF> struct EpiResid {
    static constexpr bool PERM = true;
    const float* basef; bf16* Ab; float alpha; float* ssq;
    __device__ __forceinline__ void operator()(const f32x4 (&acc)[2][2][4][2], const pg8::Unit& u, int ui, int wr, int wc, int fr, int fq) const {
        const int row0 = u.pm * 256 + wr * 64 + fr, col0 = u.pn * 256 + wc * 32 + 8 * fq;
#pragma unroll
        for (int ai = 0; ai < 2; ++ai) {
            f32x4 bf0[4][2], bf1[4][2]; v4u bw[4][2];
#pragma unroll
            for (int m = 0; m < 4; ++m)
#pragma unroll
                for (int bj = 0; bj < 2; ++bj) {
                    const size_t off = (size_t)(row0 + ai * 128 + m * 16) * D + col0 + bj * 128;
                    if constexpr (BASEF) { bf0[m][bj] = __builtin_nontemporal_load((const f32x4*)(basef + off)); bf1[m][bj] = __builtin_nontemporal_load((const f32x4*)(basef + off + 4)); }
                    else bw[m][bj] = *(const v4u*)(Ab + off);
                }
            asm volatile("" ::: "memory");
#pragma unroll
            for (int m = 0; m < 4; ++m) {
                const int row = row0 + ai * 128 + m * 16;
                float sq = 0.f;
#pragma unroll
                for (int bj = 0; bj < 2; ++bj) {
                    const size_t off = (size_t)row * D + col0 + bj * 128;
                    f32x4 b0, b1;
                    if constexpr (BASEF) { b0 = bf0[m][bj]; b1 = bf1[m][bj]; }
                    else { const v4u w = bw[m][bj]; b0 = (f32x4){bflo(w.x), bfhi(w.x), bflo(w.y), bfhi(w.y)}; b1 = (f32x4){bflo(w.z), bfhi(w.z), bflo(w.w), bfhi(w.w)}; }
                    const f32x4 v0 = b0 + acc[ai][bj][m][0] * alpha, v1 = b1 + acc[ai][bj][m][1] * alpha;
                    sq += (v0.x * v0.x + v0.y * v0.y) + (v0.z * v0.z + v0.w * v0.w) + (v1.x * v1.x + v1.y * v1.y) + (v1.z * v1.z + v1.w * v1.w);
                    v4u w; w.x = pk2(v0.x, v0.y); w.y = pk2(v0.z, v0.w); w.z = pk2(v1.x, v1.y); w.w = pk2(v1.z, v1.w);
                    *(v4u*)(Ab + off) = w;
                }
                sq = xor16_sum(sq); sq = xor32_sum(sq);
                if (fq == 0) ssq[(size_t)row * 32 + u.pn * 4 + wc] = sq;
            }
        }
    }
};
__device__ __forceinline__ float lg2_gamma(int h);
typedef _Float16 half4 __attribute__((ext_vector_type(4)));
struct EpiProj {
    static constexpr bool PERM = true;
    unsigned char* ws; const LAS float* rs;
    __device__ __forceinline__ void operator()(const f32x4 (&acc)[2][2][4][2], const pg8::Unit& u, int ui, int wr, int wc, int fr, int fq) const {
        const int row0 = u.pm * 256 + wr * 64 + fr, t = u.pn;
        bf16* PROJ = (bf16*)(ws + WS_PROJ);
        if (t < 8 || (t >= 16 && t <= 20)) {
            const int typ = t < 4 ? 0 : t < 8 ? 1 : t < 20 ? 2 : 3;
            const int tb = typ == 0 ? 0 : typ == 1 ? 4 : typ == 2 ? 16 : 20, cb = typ == 0 ? C_RQ : typ == 1 ? C_RK : typ == 2 ? C_AQ : C_AK;
            const int hd = 2 * (t - tb) + (wc >> 1), i0 = 32 * (wc & 1) + 8 * fq;
            const float lg = lg2_gamma(hd);
            const float2* TAB = (const float2*)(ws + WS_TAB);
#pragma unroll
            for (int ai = 0; ai < 2; ++ai)
#pragma unroll
                for (int m = 0; m < 4; ++m) {
                    const int row = row0 + ai * 128 + m * 16;
                    const float r = rs[ui * 256 + ai * 128 + wr * 64 + m * 16 + fr];
                    const f32x4* tp = (const f32x4*)(TAB + (size_t)row * 64 + i0);
                    const f32x4 c01 = tp[0], c23 = tp[1], c45 = tp[2], c67 = tp[3];
                    const float pcf = (float)((row & 127) + 1);
                    const float sc = r * (typ == 0 ? __builtin_amdgcn_exp2f(lg * pcf) : typ == 1 ? 0.08838834764831845f * __builtin_amdgcn_exp2f(-lg * pcf) : typ == 2 ? 0.08838834764831845f * 1.4426950408889634f : 1.f);
                    const f32x4 a0 = acc[ai][0][m][0], a1 = acc[ai][0][m][1], b0 = acc[ai][1][m][0], b1 = acc[ai][1][m][1];
                    v4u o1, o2;
                    o1.x = pk2((a0.x * c01.x - b0.x * c01.y) * sc, (a0.y * c01.z - b0.y * c01.w) * sc); o1.y = pk2((a0.z * c23.x - b0.z * c23.y) * sc, (a0.w * c23.z - b0.w * c23.w) * sc);
                    o1.z = pk2((a1.x * c45.x - b1.x * c45.y) * sc, (a1.y * c45.z - b1.y * c45.w) * sc); o1.w = pk2((a1.z * c67.x - b1.z * c67.y) * sc, (a1.w * c67.z - b1.w * c67.w) * sc);
                    o2.x = pk2((b0.x * c01.x + a0.x * c01.y) * sc, (b0.y * c01.z + a0.y * c01.w) * sc); o2.y = pk2((b0.z * c23.x + a0.z * c23.y) * sc, (b0.w * c23.z + a0.w * c23.w) * sc);
                    o2.z = pk2((b1.x * c45.x + a1.x * c45.y) * sc, (b1.y * c45.z + a1.y * c45.w) * sc); o2.w = pk2((b1.z * c67.x + a1.z * c67.y) * sc, (b1.w * c67.z + a1.w * c67.w) * sc);
                    bf16* rowp = PROJ + (size_t)row * NPB + cb + hd * 128 + i0;
                    *(v4u*)rowp = o1; *(v4u*)(rowp + 64) = o2;
                }
        } else if (t < 22) {
            const bool gate = (t >= 12 && t < 16);
            const int col0 = t * 256 + wc * 32 + 8 * fq;
#pragma unroll
            for (int ai = 0; ai < 2; ++ai)
#pragma unroll
                for (int m = 0; m < 4; ++m) {
                    const int row = row0 + ai * 128 + m * 16;
                    const float r = rs[ui * 256 + ai * 128 + wr * 64 + m * 16 + fr];
                    bf16* rowp = PROJ + (size_t)row * NPB + col0;
#pragma unroll
                    for (int bj = 0; bj < 2; ++bj) {
                        f32x4 v0 = acc[ai][bj][m][0] * r, v1 = acc[ai][bj][m][1] * r;
                        if (gate) { v0 = (f32x4){silu_f(v0.x), silu_f(v0.y), silu_f(v0.z), silu_f(v0.w)}; v1 = (f32x4){silu_f(v1.x), silu_f(v1.y), silu_f(v1.z), silu_f(v1.w)}; }
                        v4u w; w.x = pk2(v0[0], v0[1]); w.y = pk2(v0[2], v0[3]); w.z = pk2(v1[0], v1[1]); w.w = pk2(v1[2], v1[3]);
                        *(v4u*)(rowp + bj * 128) = w;
                    }
                }
        } else if (t < 26 || wc == 0) {
            const bool isq = t < 26;
            const int hd = 4 * (t - 22) + wc, i0 = 8 * fq;
            const float2* TAB2 = (const float2*)(ws + WS_TAB2);
            f16* OUT = isq ? (f16*)(ws + WS_IQ) : (f16*)(ws + WS_IK);
            const int ld = isq ? 1024 : 64, cb = isq ? hd * 64 : 0;
            const float s8 = isq ? 0.125f : 1.f;
#pragma unroll
            for (int ai = 0; ai < 2; ++ai)
#pragma unroll
                for (int m = 0; m < 4; ++m) {
                    const int row = row0 + ai * 128 + m * 16;
                    const float sc = rs[ui * 256 + ai * 128 + wr * 64 + m * 16 + fr] * s8;
                    const f32x4* tp = (const f32x4*)(TAB2 + (size_t)row * 32 + i0);
                    const f32x4 c01 = tp[0], c23 = tp[1], c45 = tp[2], c67 = tp[3];
                    const f32x4 a0 = acc[ai][0][m][0], a1 = acc[ai][0][m][1], b0 = acc[ai][1][m][0], b1 = acc[ai][1][m][1];
                    half8 h1, h2;
                    h1[0] = (f16)((a0.x * c01.x - b0.x * c01.y) * sc); h1[1] = (f16)((a0.y * c01.z - b0.y * c01.w) * sc); h1[2] = (f16)((a0.z * c23.x - b0.z * c23.y) * sc); h1[3] = (f16)((a0.w * c23.z - b0.w * c23.w) * sc);
                    h1[4] = (f16)((a1.x * c45.x - b1.x * c45.y) * sc); h1[5] = (f16)((a1.y * c45.z - b1.y * c45.w) * sc); h1[6] = (f16)((a1.z * c67.x - b1.z * c67.y) * sc); h1[7] = (f16)((a1.w * c67.z - b1.w * c67.w) * sc);
                    h2[0] = (f16)((b0.x * c01.x + a0.x * c01.y) * sc); h2[1] = (f16)((b0.y * c01.z + a0.y * c01.w) * sc); h2[2] = (f16)((b0.z * c23.x + a0.z * c23.y) * sc); h2[3] = (f16)((b0.w * c23.z + a0.w * c23.w) * sc);
                    h2[4] = (f16)((b1.x * c45.x + a1.x * c45.y) * sc); h2[5] = (f16)((b1.y * c45.z + a1.y * c45.w) * sc); h2[6] = (f16)((b1.z * c67.x + a1.z * c67.y) * sc); h2[7] = (f16)((b1.w * c67.z + a1.w * c67.w) * sc);
                    f16* rowp = OUT + (size_t)row * ld + cb + i0;
                    *(half8*)rowp = h1; *(half8*)(rowp + 32) = h2;
                }
        } else if (wc == 1 && fq < 2) {
#pragma unroll
            for (int ai = 0; ai < 2; ++ai)
#pragma unroll
                for (int m = 0; m < 4; ++m) {
                    const int row = row0 + ai * 128 + m * 16;
                    const float sc = rs[ui * 256 + ai * 128 + wr * 64 + m * 16 + fr] * 0.25f;
                    float* rowp = (float*)(ws + WS_IW) + (size_t)row * 16 + 8 * fq;
                    *(f32x4*)rowp = acc[ai][0][m][0] * sc; *(f32x4*)(rowp + 4) = acc[ai][0][m][1] * sc;
                }
        }
    }
};

__device__ __forceinline__ int win_row(int n) {
    if (n < 2048 || (n >= 4096 && n < 5376)) { const int base = n < 1024 ? 0 : n < 2048 ? 1024 : n < 5120 ? 4096 : 5120; const int rel = n - base, head = rel >> 7, half = (rel >> 6) & 1, i = rel & 63;
        return base + 256 * (head >> 1) + 128 * half + 64 * (head & 1) + i; }
    if (n < 5632) return n;
    if (n < 6656) { const int rel = n - 5632, head = rel >> 6, half = (rel >> 5) & 1, i = rel & 31; return 5632 + 256 * (head >> 2) + 128 * half + 32 * (head & 3) + i; }
    if (n < 6720) { const int rel = n - 6656; return 6656 + 128 * (rel >> 5) + (rel & 31); }
    return 6656 + 32 + (n - 6720);
}
struct CvItem { const float* W; const float* g; bf16* WT; int K, N, k0, n0, gu, up; };
constexpr int CV_G = (D / 64) * (FF / 256), CV_D = (FF / 64) * (D / 256), CV_I = (D / 64) * ((NIN + 255) / 256), CV_O = (D / 64) * (D / 256);
constexpr int CV_TILE = 64 * 257 * 4;
template <int JOB> __device__ __forceinline__ constexpr int cv_total() { return JOB == 0 ? 2 * CV_G : JOB == 1 ? CV_D + CV_I : JOB == 2 ? 2 * CV_G + CV_O : CV_D; }
template <int JOB> __device__ __forceinline__ void cv_decode(const Frame& F, int it, CvItem& x) {
    x.gu = 0; x.up = 0; x.g = nullptr;
    if (JOB == 0 || JOB == 2) {
        const float* wg = JOB == 0 ? F.wg1 : F.wg2; const float* wu = JOB == 0 ? F.wu1 : F.wu2;
        if (it < 2 * CV_G) { const int up = it >= CV_G, r = up ? it - CV_G : it, kb = r / (FF / 256), nb = r % (FF / 256);
            x.W = up ? wu : wg; x.g = JOB == 0 ? F.n1 : F.n2; x.WT = ((bf16*)(F.ws + WS_WGU)); x.K = D; x.N = FF; x.k0 = 64 * kb; x.n0 = 256 * nb; x.gu = 1; x.up = up; return; }
        it -= 2 * CV_G;
        { const int kb = it / (D / 256), nb = it % (D / 256); x.W = F.wout; x.WT = ((bf16*)(F.ws + WS_WOUT)); x.K = D; x.N = D; x.k0 = 64 * kb; x.n0 = 256 * nb; }
    } else {
        if (it < CV_D) { const int kb = it / (D / 256), nb = it % (D / 256); x.W = JOB == 1 ? F.wd1 : F.wd2; x.WT = ((bf16*)(F.ws + WS_WD)); x.K = FF; x.N = D; x.k0 = 64 * kb; x.n0 = 256 * nb; return; }
        it -= CV_D;
        constexpr int NBI = (NIN + 255) / 256;
        { const int kb = it / NBI, nb = it % NBI; x.W = F.win; x.g = F.nmix; x.WT = ((bf16*)(F.ws + WS_WIN)); x.K = D; x.N = NIN; x.k0 = 64 * kb; x.n0 = 256 * nb; x.gu = 2; }
    }
}
__device__ __forceinline__ void cv_load(const CvItem& x, f32x4 (&v)[8], int wave, int lane) {
    const bool okc = (x.n0 + 4 * lane) < x.N;
    const float* p = x.W + (size_t)(x.k0 + 8 * wave) * x.N + x.n0 + 4 * lane;
#pragma unroll
    for (int i = 0; i < 8; ++i) v[i] = okc ? __builtin_nontemporal_load((const f32x4*)(p + (size_t)i * x.N)) : (f32x4){0.f, 0.f, 0.f, 0.f};
}
__device__ __forceinline__ void cv_gain(const CvItem& x, f32x4 (&gq)[2], int wave) {
    if (x.g) { const f32x4* q = (const f32x4*)(x.g + x.k0 + 8 * wave); gq[0] = q[0]; gq[1] = q[1]; }
    else { gq[0] = (f32x4){1.f, 1.f, 1.f, 1.f}; gq[1] = gq[0]; }
}
template <int JOB> __device__ __forceinline__ void convert_job(Frame& F, int w, int nw) {
    const int lane = F.lane, wave = F.wave, c = lane & 7, nn = lane >> 3;
    constexpr int total = cv_total<JOB>();
    CvItem x0, x1, x2; f32x4 v0[8], v1[8], v2[8], g0[2], g1[2], g2[2];
    if (w < total) { cv_decode<JOB>(F, w, x0); cv_load(x0, v0, wave, lane); cv_gain(x0, g0, wave); }
    if (w + nw < total) { cv_decode<JOB>(F, w + nw, x1); cv_load(x1, v1, wave, lane); cv_gain(x1, g1, wave); }
    int par = 0;
    for (int it = w; it < total; it += nw) {
        LAS float* tile = (LAS float*)(F.lds + par * CV_TILE);
#pragma unroll
        for (int i = 0; i < 8; ++i) { LAS float* s = tile + (8 * wave + i) * 257 + 4 * lane; const float gs = g0[i >> 2][i & 3]; s[0] = v0[i].x * gs; s[1] = v0[i].y * gs; s[2] = v0[i].z * gs; s[3] = v0[i].w * gs; }
        if (it + 2 * nw < total) { cv_decode<JOB>(F, it + 2 * nw, x2); cv_load(x2, v2, wave, lane); cv_gain(x2, g2, wave); }
        __syncthreads();
#pragma unroll
        for (int q = 0; q < 4; ++q) {
            const int n = 32 * wave + nn + 8 * q, ncol = x0.n0 + n;
            const LAS float* s = tile + (8 * c) * 257 + n;
            v4u o; o.x = pk2(s[0 * 257], s[1 * 257]); o.y = pk2(s[2 * 257], s[3 * 257]); o.z = pk2(s[4 * 257], s[5 * 257]); o.w = pk2(s[6 * 257], s[7 * 257]);
            const int drow = x0.gu == 1 ? (((ncol >> 7) << 8) + (ncol & 127) + (x0.up ? 128 : 0)) : x0.gu == 2 ? win_row(ncol) : ncol;
            if (ncol < x0.N) __builtin_nontemporal_store(o, (v4u*)(x0.WT + (size_t)drow * x0.K + x0.k0 + 8 * c));
        }
        x0 = x1; x1 = x2;
#pragma unroll
        for (int i = 0; i < 8; ++i) { v0[i] = v1[i]; v1[i] = v2[i]; }
        g0[0] = g1[0]; g0[1] = g1[1]; g1[0] = g2[0]; g1[1] = g2[1];
        par ^= 1;
    }
    __syncthreads();
    if (JOB == 1) {
        v4u* z0 = (v4u*)(((bf16*)(F.ws + WS_WIN)) + (size_t)6704 * D); v4u* z1 = (v4u*)(((bf16*)(F.ws + WS_WIN)) + (size_t)6816 * D);
        for (int i = w * 512 + F.tid; i < 80 * D / 8; i += nw * 512) z0[i] = (v4u){0u, 0u, 0u, 0u};
        for (int i = w * 512 + F.tid; i < 96 * D / 8; i += nw * 512) z1[i] = (v4u){0u, 0u, 0u, 0u};
    }
}
__device__ __forceinline__ void prep_rows(Frame& F, const float* src, bf16* dst) {
    const int gw = F.bid * NWAVES + F.wave, NGW = F.G * NWAVES, lane = F.lane;
    f32x4 v[8], vn[8];
    if (gw < M) {
#pragma unroll
        for (int j = 0; j < 8; ++j) v[j] = __builtin_nontemporal_load((const f32x4*)(src + (size_t)gw * D) + lane + 64 * j);
    }
    for (int m = gw; m < M; m += NGW) {
        if (m + NGW < M) {
#pragma unroll
            for (int j = 0; j < 8; ++j) vn[j] = __builtin_nontemporal_load((const f32x4*)(src + (size_t)(m + NGW) * D) + lane + 64 * j);
        }
        float s = 0.f;
#pragma unroll
        for (int j = 0; j < 8; ++j) s += (v[j].x * v[j].x + v[j].y * v[j].y) + (v[j].z * v[j].z + v[j].w * v[j].w);
        s = wave_sum(s);
        v2u* o8 = (v2u*)(dst + (size_t)m * D) + lane;
#pragma unroll
        for (int j = 0; j < 8; ++j) { v2u w; w.x = pk2(v[j].x, v[j].y); w.y = pk2(v[j].z, v[j].w); o8[64 * j] = w; }
        if (lane < 32) ((float*)(F.ws + WS_SSQ))[(size_t)m * 32 + lane] = (lane == 0) ? s : 0.f;
#pragma unroll
        for (int j = 0; j < 8; ++j) v[j] = vn[j];
    }
}
__device__ __forceinline__ void rms_final(Frame& F) {
    const int gw = F.bid * NWAVES + F.wave, NGW = F.G * NWAVES, lane = F.lane;
    const f32x4* gr = (const f32x4*)F.nfin + lane;
    f32x4 gg[8];
#pragma unroll
    for (int j = 0; j < 8; ++j) gg[j] = gr[64 * j];
    v2u w[8], wn[8]; float sp = 0.f, spn = 0.f;
    if (gw < M) {
#pragma unroll
        for (int j = 0; j < 8; ++j) w[j] = ((const v2u*)(((bf16*)(F.ws + WS_A)) + (size_t)gw * D) + lane)[64 * j];
        sp = lane < 32 ? ((float*)(F.ws + WS_SSQ))[(size_t)gw * 32 + lane] : 0.f;
    }
    for (int m = gw; m < M; m += NGW) {
        if (m + NGW < M) {
#pragma unroll
            for (int j = 0; j < 8; ++j) wn[j] = ((const v2u*)(((bf16*)(F.ws + WS_A)) + (size_t)(m + NGW) * D) + lane)[64 * j];
            spn = lane < 32 ? ((float*)(F.ws + WS_SSQ))[(size_t)(m + NGW) * 32 + lane] : 0.f;
        }
        const float s = wave_sum(sp);
        const float rstd = 1.0f / sqrtf(s * (1.f / D) + NORM_EPS);
        f32x4* xr = (f32x4*)(F.X + (size_t)m * D) + lane;
#pragma unroll
        for (int j = 0; j < 8; ++j) __builtin_nontemporal_store((f32x4){bflo(w[j].x), bfhi(w[j].x), bflo(w[j].y), bfhi(w[j].y)} * rstd * gg[j], xr + 64 * j);
#pragma unroll
        for (int j = 0; j < 8; ++j) w[j] = wn[j];
        sp = spn;
    }
}
__device__ __forceinline__ void rope_table(Frame& F) {
    const int gt = F.bid * (NWAVES * 64) + F.tid, NT = F.G * NWAVES * 64;
    for (int e = gt; e < M * 64; e += NT) {
        const int m = e >> 6, i = e & 63;
        double inv = 1.0; const double rr = 8.65964323360065346691e-01;
        for (int k = 0; k < i; ++k) inv *= rr;
        const float invf = (float)inv;
        const float angf = (float)F.pos[m] * invf;
        const double ang = (double)angf;
        const double kq = __builtin_rint(ang * 0.63661977236758134308);
        double y = __builtin_fma(-kq, 1.57079632679489655800e+00, ang);
        y = __builtin_fma(-kq, 6.12323399573676603587e-17, y);
        const double y2 = y * y;
        double sn = 1.0 / 6227020800.0; sn = sn * y2 - 1.0 / 39916800.0; sn = sn * y2 + 1.0 / 362880.0; sn = sn * y2 - 1.0 / 5040.0; sn = sn * y2 + 1.0 / 120.0; sn = sn * y2 - 1.0 / 6.0; sn = sn * y2 * y + y;
        double cs = 1.0 / 479001600.0; cs = cs * y2 - 1.0 / 3628800.0; cs = cs * y2 + 1.0 / 40320.0; cs = cs * y2 - 1.0 / 720.0; cs = cs * y2 + 1.0 / 24.0; cs = cs * y2 - 0.5; cs = cs * y2 + 1.0;
        const int q = ((int)kq) & 3;
        const double c = (q == 0) ? cs : (q == 1) ? -sn : (q == 2) ? -cs : sn;
        const double s = (q == 0) ? sn : (q == 1) ? cs : (q == 2) ? -sn : -cs;
        ((float2*)(F.ws + WS_TAB))[e] = make_float2((float)c, (float)s);
        if ((i & 1) == 0) ((float2*)(F.ws + WS_TAB2))[(size_t)m * 32 + (i >> 1)] = make_float2((float)c, (float)s);
    }
}
__device__ __forceinline__ float lg2_gamma(int h) {
    const double x = __builtin_amdgcn_exp2f((float)(-5 - h));
    double s = 1.0 / 8.0; s = s * x + 1.0 / 7.0; s = s * x + 1.0 / 6.0; s = s * x + 0.2; s = s * x + 0.25; s = s * x + 1.0 / 3.0; s = s * x + 0.5; s = s * x + 1.0; s = -s * x;
    return (float)(s * 1.44269504088896338700);
}

constexpr int PT_IMG = 32 * 132 * 4;
__device__ __forceinline__ void post_tile(Frame& F, int tt) {
    const int tid = F.tid;
    const int m0 = tt * 32, b = m0 / T, tp0 = m0 % T;
    const int ltok = tid >> 4, lc8 = (tid & 15) * 8;
    const bf16* gp0 = ((bf16*)(F.ws + WS_PROJ)) + (size_t)(m0 + ltok) * NPB + lc8;
    v4u cur = *(const v4u*)(gp0 + C_RK), nxt = cur;
    for (int s = 0; s < 18; ++s) {
        LAS float* L = (LAS float*)(F.lds + (s & 1) * PT_IMG);
        const int typ = s < 8 ? 1 : s < 16 ? 2 : 6, h = s < 16 ? (s & 7) : (s & 1);
        if (s + 1 < 18) { const int sn = s + 1; nxt = *(const v4u*)(gp0 + (sn < 8 ? C_RK + sn * 128 : sn < 16 ? C_RV + (sn - 8) * 128 : C_AV + (sn - 16) * 128)); }
        { const v4u w = cur; LAS float* lp = L + ltok * 132 + lc8;
          lp[0] = bflo(w.x); lp[1] = bfhi(w.x); lp[2] = bflo(w.y); lp[3] = bfhi(w.y); lp[4] = bflo(w.z); lp[5] = bfhi(w.z); lp[6] = bflo(w.w); lp[7] = bfhi(w.w); }
        __syncthreads();
        {
            const int d = tid >> 2, t8 = (tid & 3) * 8;
            bf16* tb = (typ == 1) ? ((bf16*)(F.ws + WS_RKT)) + ((size_t)(b * 8 + h) * 128 + d) * T : (typ == 2) ? ((bf16*)(F.ws + WS_RVT)) + ((size_t)(b * 8 + h) * 128 + d) * T : ((bf16*)(F.ws + WS_AVT)) + ((size_t)(b * 2 + h) * 128 + d) * T;
            const LAS float* lp = L + t8 * 132 + d;
            v4u w; w.x = pk2(lp[0], lp[132]); w.y = pk2(lp[264], lp[396]); w.z = pk2(lp[528], lp[660]); w.w = pk2(lp[792], lp[924]);
            if (typ != 6) *(v4u*)(tb + tp0 + t8) = w;
            else {
                const int p0 = 8 * ((t8 >> 2) & 3) + 4 * (t8 >> 4);
                *(v2u*)(tb + tp0 + p0) = (v2u){w.x, w.y}; *(v2u*)(tb + tp0 + p0 + 8) = (v2u){w.z, w.w};
            }
        }
        cur = nxt;
    }
    __syncthreads();
}

#define MFMA32(a, b, c) __builtin_amdgcn_mfma_f32_32x32x16_bf16((a), (b), (c), 0, 0, 0)
#define MFMA16(a, b, c) __builtin_amdgcn_mfma_f32_16x16x32_bf16((a), (b), (c), 0, 0, 0)
__device__ __forceinline__ f32x16 zero16() { f32x16 z;
#pragma unroll
    for (int i = 0; i < 16; ++i) z[i] = 0.f; return z; }
__device__ __forceinline__ void ret_kv_unit(Frame& F, int unit, int w4, int lane) {
    const int bh = unit >> 5, n = unit & 31, t0 = n * 128, r = lane & 31, hi = lane >> 5;
    f32x16 acc[4];
#pragma unroll
    for (int k = 0; k < 4; ++k) acc[k] = zero16();
    const bf16* vp = ((bf16*)(F.ws + WS_RVT)) + ((size_t)bh * 128 + 32 * w4 + r) * T + t0 + 8 * hi;
    const bf16* kp = ((bf16*)(F.ws + WS_RKT)) + ((size_t)bh * 128 + r) * T + t0 + 8 * hi;
#pragma unroll
    for (int s = 0; s < 8; ++s) {
        const bf16x8 bfr = *(const bf16x8*)(vp + 16 * s);
#pragma unroll
        for (int blk = 0; blk < 4; ++blk) { const bf16x8 af = *(const bf16x8*)(kp + (size_t)blk * 32 * T + 16 * s); acc[blk] = MFMA32(af, bfr, acc[blk]); }
    }
    float* kvp = ((float*)(F.ws + WS_KV)) + ((size_t)unit * 128 + 32 * w4 + r) * 128;
#pragma unroll
    for (int blk = 0; blk < 4; ++blk)
#pragma unroll
        for (int g = 0; g < 4; ++g) *(f32x4*)(kvp + 32 * blk + 8 * g + 4 * hi) = (f32x4){acc[blk][4 * g], acc[blk][4 * g + 1], acc[blk][4 * g + 2], acc[blk][4 * g + 3]};
}
__device__ __forceinline__ void ret_scan(Frame& F) {
    const int gt = F.bid * (NWAVES * 64) + F.tid, NT = F.G * NWAVES * 64;
    for (int idx = gt; idx < 16 * 4096; idx += NT) {
        const int bh = idx >> 12, rem = idx & 4095, h = bh & 7;
        const float gC = __builtin_amdgcn_exp2f(128.f * lg2_gamma(h));
        f32x4 S = {0.f, 0.f, 0.f, 0.f};
        const size_t off0 = ((size_t)(bh * 32) * 16384) + (size_t)rem * 4;
#pragma unroll 1
        for (int n0 = 0; n0 < 32; n0 += 8) {
            f32x4 kv[8];
#pragma unroll
            for (int k = 0; k < 8; ++k) kv[k] = *(const f32x4*)(((float*)(F.ws + WS_KV)) + off0 + (size_t)(n0 + k) * 16384);
#pragma unroll
            for (int k = 0; k < 8; ++k) {
                v2u w; w.x = pk2(S.x, S.y); w.y = pk2(S.z, S.w);
                *(v2u*)(((bf16*)(F.ws + WS_ST)) + off0 + (size_t)(n0 + k) * 16384) = w;
                S = (S + kv[k]) * gC;
            }
        }
    }
}
constexpr int RO_PITCH = 272, RO_KB = 128 * RO_PITCH, RO_UNIT = 2 * RO_KB;
__device__ __forceinline__ void ret_out_stage(Frame& F, int u2) {
    const int tid = F.tid, row0 = tid >> 4, c = tid & 15;
    const int vpos = 32 * (c >> 2) + 16 * ((c & 3) >> 1) + 4 * (c & 1);
#pragma unroll 1
    for (int us = 0; us < 2; ++us) {
        const int unit = 2 * u2 + us, bh = unit >> 5, n = unit & 31, b = bh >> 3, h = bh & 7, t0 = n * 128;
        v4u kr[4], vr[4];
#pragma unroll
        for (int j = 0; j < 4; ++j) {
            const int row = row0 + 32 * j;
            kr[j] = *(const v4u*)(((bf16*)(F.ws + WS_PROJ)) + ((size_t)b * T + t0 + row) * NPB + C_RK + h * 128 + 8 * c);
            vr[j] = *(const v4u*)(((bf16*)(F.ws + WS_RVT)) + ((size_t)bh * 128 + row) * T + t0 + 8 * c);
        }
#pragma unroll
        for (int j = 0; j < 4; ++j) {
            const int row = row0 + 32 * j;
            *(LAS v4u*)(F.lds + us * RO_UNIT + row * RO_PITCH + 16 * c) = kr[j];
            *(LAS v2u*)(F.lds + us * RO_UNIT + RO_KB + row * RO_PITCH + 2 * vpos) = (v2u){vr[j].x, vr[j].y};
            *(LAS v2u*)(F.lds + us * RO_UNIT + RO_KB + row * RO_PITCH + 2 * vpos + 16) = (v2u){vr[j].z, vr[j].w};
        }
    }
    __syncthreads();
}
__device__ __forceinline__ void ret_out_unit(Frame& F, int unit, int I, int lane) {
    const int lb = ((unit & 1) * RO_UNIT);
    const int bh = unit >> 5, n = unit & 31, b = bh >> 3, h = bh & 7, t0 = n * 128, r = lane & 31, hi = lane >> 5;
    const size_t tokI = (size_t)b * T + t0 + 32 * I + r;
    bf16x8 qf[8];
    { const bf16* qp = ((bf16*)(F.ws + WS_PROJ)) + tokI * NPB + C_RQ + h * 128 + 8 * hi;
#pragma unroll
      for (int s = 0; s < 8; ++s) qf[s] = *(const bf16x8*)(qp + 16 * s); }
    f32x16 out[4];
#pragma unroll
    for (int k = 0; k < 4; ++k) out[k] = zero16();
    { const bf16* sp = ((bf16*)(F.ws + WS_ST)) + ((size_t)unit * 128 + r) * 128 + 8 * hi;
#pragma unroll
      for (int blk = 0; blk < 4; ++blk) {
          bf16x8 af[8];
#pragma unroll
          for (int s = 0; s < 8; ++s) af[s] = *(const bf16x8*)(sp + (size_t)blk * 32 * 128 + 16 * s);
          asm volatile("" ::: "memory");
#pragma unroll
          for (int s = 0; s < 8; ++s) out[blk] = MFMA32(af[s], qf[s], out[blk]);
      } }
#pragma unroll 1
    for (int J = 0; J <= I; ++J) {
        asm volatile("" ::: "memory");
        f32x16 X = zero16();
#pragma unroll
        for (int s = 0; s < 8; ++s) { const bf16x8 kf = *(const LAS bf16x8*)(F.lds + lb + (32 * J + r) * RO_PITCH + (16 * s + 8 * hi) * 2); X = MFMA32(kf, qf[s], X); }
        if (J == I) {
            int rr = r; asm volatile("" : "+v"(rr));
#pragma unroll
            for (int g = 0; g < 16; ++g) { const int jrow = (g & 3) + 8 * (g >> 2) + 4 * hi; if (jrow > rr) X[g] = 0.f; }
        }
#pragma unroll
        for (int s2 = 0; s2 < 2; ++s2) {
            v4u xp; xp.x = pk2(X[8 * s2], X[8 * s2 + 1]); xp.y = pk2(X[8 * s2 + 2], X[8 * s2 + 3]); xp.z = pk2(X[8 * s2 + 4], X[8 * s2 + 5]); xp.w = pk2(X[8 * s2 + 6], X[8 * s2 + 7]);
            const bf16x8 xb = __builtin_bit_cast(bf16x8, xp);
#pragma unroll
            for (int blk = 0; blk < 4; ++blk) {
                const bf16x8 av = *(const LAS bf16x8*)(F.lds + lb + RO_KB + (32 * blk + r) * RO_PITCH + (32 * J + 8 * (2 * s2 + hi)) * 2);
                out[blk] = MFMA32(av, xb, out[blk]);
            }
        }
    }
    float s1 = 0.f, s2 = 0.f;
#pragma unroll
    for (int blk = 0; blk < 4; ++blk) {
#pragma unroll
        for (int g = 0; g < 16; ++g) { const float v = out[blk][g]; s1 += v; s2 = __builtin_fmaf(v, v, s2); }
        asm volatile("" : "+v"(s1), "+v"(s2));
    }
    s1 = xor32_sum(s1); s2 = xor32_sum(s2);
    const float mu = s1 * (1.f / 128.f);
    const float rstd = 1.0f / sqrtf(__builtin_fmaxf(s2 * (1.f / 128.f) - mu * mu, 0.f) + NORM_EPS);
    const bf16* gp = ((bf16*)(F.ws + WS_PROJ)) + tokI * NPB + C_RG + h * 128;
    bf16* op = ((bf16*)(F.ws + WS_PIDX)) + tokI * D + h * 128;
    const float* nw = F.nret + h * 128;
    v2u ov[4][4];
#pragma unroll
    for (int blk = 0; blk < 4; ++blk)
#pragma unroll
        for (int g = 0; g < 4; ++g) {
            const int e = 32 * blk + 8 * g + 4 * hi;
            const v2u gg = *(const v2u*)(gp + e); const f32x4 w4 = *(const f32x4*)(nw + e);
            const float y0 = (out[blk][4 * g] - mu) * rstd * w4.x * bflo(gg.x), y1 = (out[blk][4 * g + 1] - mu) * rstd * w4.y * bfhi(gg.x);
            const float y2 = (out[blk][4 * g + 2] - mu) * rstd * w4.z * bflo(gg.y), y3 = (out[blk][4 * g + 3] - mu) * rstd * w4.w * bfhi(gg.y);
            ov[blk][g].x = pk2(y0, y1); ov[blk][g].y = pk2(y2, y3);
            if (g == 3) asm volatile("" ::: "memory");
        }
    asm volatile("" ::: "memory");
#pragma unroll
    for (int blk = 0; blk < 4; ++blk)
#pragma unroll
        for (int g = 0; g < 4; ++g) *(v2u*)(op + 32 * blk + 8 * g + 4 * hi) = ov[blk][g];
}

__device__ __forceinline__ unsigned fkey(float f) { unsigned b = __float_as_uint(f); if (b == 0x80000000u) b = 0u; return (b & 0x80000000u) ? ~b : (b | 0x80000000u); }
__device__ __forceinline__ int row16_sum_i(int c) {
    c += __builtin_amdgcn_update_dpp(0, c, 0xB1, 0xF, 0xF, true);
    c += __builtin_amdgcn_update_dpp(0, c, 0x4E, 0xF, 0xF, true);
    c += __builtin_amdgcn_update_dpp(0, c, 0x141, 0xF, 0xF, true);
    c += __builtin_amdgcn_update_dpp(0, c, 0x140, 0xF, 0xF, true);
    return c;
}
__device__ __forceinline__ int half_sum(int c) {
    c = row16_sum_i(c);
    auto rr = __builtin_amdgcn_permlane16_swap((unsigned)c, (unsigned)c, false, false);
    return (int)rr[0] + (int)rr[1];
}
__device__ __forceinline__ float xor16_max(float m) { auto rr = __builtin_amdgcn_permlane16_swap(__float_as_uint(m), __float_as_uint(m), false, false); return __builtin_fmaxf(__uint_as_float(rr[0]), __uint_as_float(rr[1])); }
__device__ __forceinline__ float xor32_max(float m) { auto rr = __builtin_amdgcn_permlane32_swap(__float_as_uint(m), __float_as_uint(m), false, false); return __builtin_fmaxf(__uint_as_float(rr[0]), __uint_as_float(rr[1])); }
__device__ __forceinline__ float xor16_sum(float m) { auto rr = __builtin_amdgcn_permlane16_swap(__float_as_uint(m), __float_as_uint(m), false, false); return __uint_as_float(rr[0]) + __uint_as_float(rr[1]); }
__device__ __forceinline__ float xor32_sum(float m) { auto rr = __builtin_amdgcn_permlane32_swap(__float_as_uint(m), __float_as_uint(m), false, false); return __uint_as_float(rr[0]) + __uint_as_float(rr[1]); }
#define CNT4(c, u0, u1, u2, u3, cand) do { unsigned long long _t0, _t1, _t2, _t3; \
    asm volatile("v_cmp_ge_u32_e64 %1, %5, %9\n\tv_cmp_ge_u32_e64 %2, %6, %9\n\tv_cmp_ge_u32_e64 %3, %7, %9\n\tv_cmp_ge_u32_e64 %4, %8, %9\n\t" \
                 "v_addc_co_u32_e64 %0, vcc, 0, %0, %1\n\tv_addc_co_u32_e64 %0, vcc, 0, %0, %2\n\tv_addc_co_u32_e64 %0, vcc, 0, %0, %3\n\tv_addc_co_u32_e64 %0, vcc, 0, %0, %4" \
                 : "+v"(c), "=&s"(_t0), "=&s"(_t1), "=&s"(_t2), "=&s"(_t3) : "v"(u0), "v"(u1), "v"(u2), "v"(u3), "v"(cand) : "vcc"); } while (0)
constexpr int IX_KOFF = 32768, IX_KPITCH = 144, IX_KBUF = 256 * IX_KPITCH;
__device__ __forceinline__ void idx_unit(Frame& F, int b, int qb, int wave, int lane) {
    const int q0 = qb * 16, hi = lane >> 5, r = lane & 31, tid = F.tid;
    const int myq = q0 + 2 * wave + hi;
    const int arow_q = (r >> 2) & 1, arow_h = (r & 3) | ((r >> 3) << 2);
    half8 a[4];
    { const f16* ap = ((f16*)(F.ws + WS_IQ)) + ((size_t)b * T + q0 + 2 * wave + arow_q) * 1024 + arow_h * 64 + 8 * hi;
#pragma unroll
      for (int s = 0; s < 4; ++s) a[s] = *(const half8*)(ap + 16 * s); }
    float wv[16];
    { const f32x4* wp = (const f32x4*)(((float*)(F.ws + WS_IW)) + ((size_t)b * T + myq) * 16);
#pragma unroll
      for (int k = 0; k < 4; ++k) { const f32x4 t = wp[k]; wv[4 * k] = t.x; wv[4 * k + 1] = t.y; wv[4 * k + 2] = t.z; wv[4 * k + 3] = t.w; } }
    LAS unsigned* sl = (LAS unsigned*)(F.lds + wave * 4096) + lane;
    unsigned u[128];
    const int last = (q0 + 15) >> 5, nstage = (last >> 3) + 1;
    const f16* sg = ((f16*)(F.ws + WS_IK)) + ((size_t)b * T + (tid >> 1)) * 64 + 32 * (tid & 1);
    const int sst = IX_KOFF + (tid >> 1) * IX_KPITCH + 64 * (tid & 1);
    v4u sr[4];
#pragma unroll
    for (int j = 0; j < 4; ++j) sr[j] = *(const v4u*)(sg + 8 * j);
#pragma unroll
    for (int j = 0; j < 4; ++j) *(LAS v4u*)(F.lds + sst + 16 * j) = sr[j];
    __syncthreads();
    const int kread = IX_KOFF + r * IX_KPITCH + 16 * hi;
#pragma unroll
    for (int c = 0; c < 8; ++c) {
        if (16 * c <= last) {
#pragma unroll 1
            for (int st = 0; st < 2; ++st) {
                const int sidx = 2 * c + st;
                if (sidx < nstage) {
                    const bool more = (sidx + 1) < nstage;
                    if (more) {
#pragma unroll
                        for (int j = 0; j < 4; ++j) sr[j] = *(const v4u*)(sg + (size_t)(sidx + 1) * 256 * 64 + 8 * j);
                    }
                    const int kb = kread + (sidx & 1) * IX_KBUF;
#pragma unroll 1
                    for (int ii = 0; ii < 8; ++ii) {
                        const int i = 8 * sidx + ii;
                        half8 bfr[4];
#pragma unroll
                        for (int s = 0; s < 4; ++s) bfr[s] = *(const LAS half8*)(F.lds + kb + ii * 32 * IX_KPITCH + 32 * s);
                        f32x16 acc = zero16();
#pragma unroll
                        for (int s = 0; s < 4; ++s) acc = __builtin_amdgcn_mfma_f32_32x32x16_f16(a[s], bfr[s], acc, 0, 0, 0);
                        float sc = 0.f;
#pragma unroll
                        for (int hh = 0; hh < 16; ++hh) sc = __builtin_fmaf(wv[hh], __builtin_amdgcn_fmed3f(acc[hh], 0.f, INFINITY), sc);
                        const int key = 32 * i + r;
                        sl[(8 * st + ii) * 64] = (key <= myq) ? fkey(sc) : 0u;
                    }
                    if (more) {
#pragma unroll
                        for (int j = 0; j < 4; ++j) *(LAS v4u*)(F.lds + sst + ((sidx + 1) & 1) * IX_KBUF + 16 * j) = sr[j];
                    }
                    __syncthreads();
                } else {
#pragma unroll 1
                    for (int ii = 0; ii < 8; ++ii) sl[(8 * st + ii) * 64] = 0u;
                }
            }
#pragma unroll
            for (int ii = 0; ii < 16; ++ii) u[16 * c + ii] = sl[ii * 64];
        } else {
#pragma unroll
            for (int ii = 0; ii < 16; ++ii) u[16 * c + ii] = 0u;
        }
    }
    unsigned Tk = 0u; bool done = false;
#pragma unroll 1
    for (int rep = 0; rep < (MK_ABL == 4 ? 2 : 1); ++rep) { Tk = 0u; done = false;
#pragma unroll 1
    for (int bit = 31; bit >= 0; --bit) {
        const unsigned cand = Tk | (1u << bit);
        int c = 0;
#pragma unroll
        for (int g = 0; g < 8; ++g) {
            if (16 * g <= last) {
#pragma unroll
                for (int i = 0; i < 16; i += 4) CNT4(c, u[16 * g + i], u[16 * g + i + 1], u[16 * g + i + 2], u[16 * g + i + 3], cand);
            }
        }
        asm volatile("s_nop 2" : "+v"(c));
        c = half_sum(c);
        if (!done && c >= 256) { Tk = cand; done = (c == 256); }
        if (__all(done)) break;
    }
    asm volatile("" : "+v"(Tk)); }
    int cgt = 0, ceq = 0;
#pragma unroll
    for (int i = 0; i < 128; ++i) { cgt += (u[i] > Tk) ? 1 : 0; ceq += (u[i] == Tk) ? 1 : 0; }
    cgt = half_sum(cgt); ceq = half_sum(ceq);
    int Jthr = (Tk == 0u) ? -1 : 4095;
    const int need = 256 - cgt;
    const bool trim = (Tk != 0u) && (ceq > need);
    if (__any(trim)) {
        int J = 0;
#pragma unroll 1
        for (int bit = 11; bit >= 0; --bit) {
            const int cand = J | (1 << bit);
            unsigned Tk1 = Tk; asm volatile("" : "+v"(Tk1));
            const int cr = cand - r;
            int c = 0;
#pragma unroll
            for (int i = 0; i < 128; ++i) c += ((u[i] == Tk1) && (32 * i < cr)) ? 1 : 0;
            c = half_sum(c);
            if (c < need) J = cand;
        }
        if (trim) Jthr = J;
    }
    const int jt = Jthr - r;
    unsigned Tk2 = Tk; asm volatile("" : "+v"(Tk2));
    unsigned mlo0 = 0u, mhi0 = 0u, mlo1 = 0u, mhi1 = 0u;
#pragma unroll
    for (int g = 0; g < 8; ++g) {
        if (16 * g <= last) {
#pragma unroll
            for (int ii = 0; ii < 16; ++ii) {
                const int i = 16 * g + ii;
                const bool sel = (u[i] > Tk2) || ((u[i] == Tk2) && (32 * i <= jt));
                const unsigned long long bal = __ballot(sel);
                const unsigned lo = (unsigned)bal, hi_ = (unsigned)(bal >> 32);
                int lv = lane; asm volatile("" : "+v"(lv));
                const bool me = (lv == (i & 63));
                if (i < 64) { mlo0 = me ? lo : mlo0; mhi0 = me ? hi_ : mhi0; }
                else { mlo1 = me ? lo : mlo1; mhi1 = me ? hi_ : mhi1; }
            }
        }
    }
    unsigned* mp = ((unsigned*)(F.ws + WS_MASK)) + ((size_t)b * T + q0 + 2 * wave) * 128;
    mp[lane] = mlo0; mp[64 + lane] = mlo1; mp[128 + lane] = mhi0; mp[192 + lane] = mhi1;
}

constexpr int AT_PITCH = 272, AT_KBYTES = 128 * AT_PITCH, AT_BUF = 2 * AT_KBYTES;
__device__ __forceinline__ void attn_unit(Frame& F, int b, int kvh, int qb) {
    const int tid = F.tid, lane = F.lane, wave = F.wave, fr = lane & 15, fq = lane >> 4;
    const int q = qb * 32 + 4 * wave + (fr >> 2), head = 4 * kvh + (fr & 3);
    const size_t tok = (size_t)b * T + q;
    bf16x8 qf[4];
    { const bf16* qp = ((bf16*)(F.ws + WS_PROJ)) + tok * NPB + C_AQ + head * 128 + 8 * fq;
#pragma unroll
      for (int s = 0; s < 4; ++s) qf[s] = *(const bf16x8*)(qp + 32 * s); }
    const v4u* mrow = (const v4u*)(((unsigned*)(F.ws + WS_MASK)) + tok * 128);
    f32x4 O[8];
#pragma unroll
    for (int k = 0; k < 8; ++k) O[k] = (f32x4){0.f, 0.f, 0.f, 0.f};
    float mrun = -INFINITY, lsum = 0.f;
    const int nst = (qb + 4) >> 2;
    const int srow = tid >> 4, sc8 = (tid & 15) * 8;
    const bf16* kg = ((bf16*)(F.ws + WS_PROJ)) + ((size_t)b * T + srow) * NPB + C_AK + kvh * 128 + sc8;
    const bf16* vg = ((bf16*)(F.ws + WS_AVT)) + ((size_t)(b * 2 + kvh) * 128 + srow) * T + sc8;
    LAS unsigned char* lds = F.lds;
    const int kst = srow * AT_PITCH + sc8 * 2, vst = AT_KBYTES + kst;
    v4u kr[4], vr[4];
#pragma unroll
    for (int j = 0; j < 4; ++j) { kr[j] = *(const v4u*)(kg + (size_t)(32 * j) * NPB); vr[j] = *(const v4u*)(vg + (size_t)(32 * j) * T); }
#define AT_VWRITE(base) do { _Pragma("unroll") for (int j = 0; j < 4; ++j) *(LAS v4u*)(lds + (base) + vst + 32 * j * AT_PITCH) = vr[j]; } while (0)
#pragma unroll
    for (int j = 0; j < 4; ++j) *(LAS v4u*)(lds + kst + 32 * j * AT_PITCH) = kr[j];
    AT_VWRITE(0);
    v4u W4 = mrow[0], W4n = W4;
    __syncthreads();
    if (wave >= 4) __builtin_amdgcn_s_setprio(1);
    for (int st = 0; st < nst; ++st) {
        const int bo = (st & 1) * AT_BUF;
        const bool more = (st + 1 < nst);
        if (more) {
#pragma unroll
            for (int j = 0; j < 4; ++j) { kr[j] = *(const v4u*)(kg + (size_t)((st + 1) * 128 + 32 * j) * NPB); vr[j] = *(const v4u*)(vg + (size_t)(32 * j) * T + (st + 1) * 128); }
            W4n = mrow[st + 1];
        }
        {
            f32x4 sg[8];
#pragma unroll
            for (int g = 0; g < 8; ++g) sg[g] = (f32x4){0.f, 0.f, 0.f, 0.f};
#pragma unroll
            for (int s = 0; s < 4; ++s)
#pragma unroll
                for (int g = 0; g < 8; ++g) { const bf16x8 kf = *(const LAS bf16x8*)(lds + bo + (16 * g + fr) * AT_PITCH + (32 * s + 8 * fq) * 2); sg[g] = MFMA16(kf, qf[s], sg[g]); }
            float mx = -INFINITY;
#pragma unroll
            for (int g = 0; g < 8; ++g)
#pragma unroll
                for (int j = 0; j < 4; ++j) mx = __builtin_fmaxf(mx, sg[g][j]);
            mx = xor16_max(mx); mx = xor32_max(mx);
            const float mnew = __builtin_fmaxf(mrun, mx);
            const float alpha = __builtin_amdgcn_exp2f(mrun - mnew);
            const bool resc = __any(mnew != mrun);
            mrun = mnew;
            float ps = 0.f; bf16x8 pb[4];
#pragma unroll
            for (int h = 0; h < 4; ++h) {
                float p[8];
#pragma unroll
                for (int j = 0; j < 8; ++j) {
                    const int bit = 4 * fq + 16 * (j >> 2) + (j & 3);
                    const unsigned keep = (unsigned)__builtin_amdgcn_sbfe((int)W4[h], bit, 1);
                    p[j] = __uint_as_float(__float_as_uint(__builtin_amdgcn_exp2f(sg[2 * h + (j >> 2)][j & 3] - mnew)) & keep); ps += p[j];
                }
                v4u pp; pp.x = pk2(p[0], p[1]); pp.y = pk2(p[2], p[3]); pp.z = pk2(p[4], p[5]); pp.w = pk2(p[6], p[7]);
                pb[h] = __builtin_bit_cast(bf16x8, pp);
            }
            lsum = lsum * alpha + ps;
            if (resc) {
#pragma unroll
                for (int blk = 0; blk < 8; ++blk) O[blk] = O[blk] * alpha;
            }
#pragma unroll
            for (int blk = 0; blk < 8; ++blk) {
                const LAS unsigned char* vp = lds + bo + AT_KBYTES + (16 * blk + fr) * AT_PITCH + (8 * fq) * 2;
#pragma unroll
                for (int h = 0; h < 4; ++h) { const bf16x8 av = *(const LAS bf16x8*)(vp + 64 * h); O[blk] = MFMA16(av, pb[h], O[blk]); }
            }
        }
        if (more) { const int bn = ((st + 1) & 1) * AT_BUF;
#pragma unroll
            for (int j = 0; j < 4; ++j) *(LAS v4u*)(lds + bn + kst + 32 * j * AT_PITCH) = kr[j];
            AT_VWRITE(bn); }
        __syncthreads();
        W4 = W4n;
    }
#undef AT_VWRITE
    __builtin_amdgcn_s_setprio(0);
    lsum = xor16_sum(lsum); lsum = xor32_sum(lsum);
    const float inv = 1.0f / lsum;
    bf16* op = ((bf16*)(F.ws + WS_PIDX)) + tok * D + 1024 + head * 128 + 4 * fq;
#pragma unroll
    for (int blk = 0; blk < 8; ++blk) { v2u o; o.x = pk2(O[blk][0] * inv, O[blk][1] * inv); o.y = pk2(O[blk][2] * inv, O[blk][3] * inv); *(v2u*)(op + 16 * blk) = o; }
}

struct Args { const void* in[15]; float* out; unsigned char* ws; int ph_lo, ph_hi; };
constexpr int NPHASE = 12;
__global__ void __launch_bounds__(NWAVES * 64, 2) mk_fwd(Args args) {
    extern __shared__ __attribute__((aligned(16))) unsigned char lds[];
    Frame F;
    F.lds = (LAS unsigned char*)lds;
    F.tid = threadIdx.x; F.lane = F.tid & 63; F.wave = __builtin_amdgcn_readfirstlane(F.tid >> 6);
    F.G = gridDim.x; F.bid = blockIdx.x;
    unsigned char* ws = args.ws;
    F.x = (const float*)args.in[0]; F.pos = (const int*)args.in[1];
    F.n1 = (const float*)args.in[2]; F.wg1 = (const float*)args.in[3]; F.wu1 = (const float*)args.in[4]; F.wd1 = (const float*)args.in[5];
    F.nmix = (const float*)args.in[6]; F.win = (const float*)args.in[7]; F.nret = (const float*)args.in[8]; F.wout = (const float*)args.in[9];
    F.n2 = (const float*)args.in[10]; F.wg2 = (const float*)args.in[11]; F.wu2 = (const float*)args.in[12]; F.wd2 = (const float*)args.in[13]; F.nfin = (const float*)args.in[14];
    F.X = args.out;
    F.ws = ws;
    volatile LAS unsigned* MISC = (volatile LAS unsigned*)(F.lds + MISC_OFF);
    for (int u = F.tid; u < (LDS_BYTES - LDSCTL_OFF) / 4; u += NWAVES * 64) ((LAS unsigned*)(F.lds + LDSCTL_OFF))[u] = 0u;
    __syncthreads();
    const int lo = args.ph_lo, hi = args.ph_hi;
    XcdBarrier bar; bar.bar = (unsigned*)(ws + WS_CTL) + CW_BAR; bar.x = 0; bar.st = nullptr;
    if (hi - lo > 1) bar = xcd_barrier_post((unsigned*)(ws + WS_CTL) + CW_BAR, MISC + 8);
#ifndef MK_PHMASK
#define MK_PHMASK 0xFFFF
#endif
#define IN(k) (((MK_PHMASK >> (k)) & 1) && lo <= (k) && (k) < hi)
#define SEAM(k) do { if (IN(k) && IN((k) + 1)) xcd_barrier(bar); } while (0)
    bf16* H = ((bf16*)(F.ws + WS_PROJ));

#ifndef MK_REPEAT
#define MK_REPEAT 0
#endif
#ifndef MK_TIMEPH
#define MK_TIMEPH -1
#endif
    unsigned long long tp0 = 0, tp1 = 0;
#define PHASE(k, ...) do { MK_STAMP(F.lds, 2 * (k)); if ((k) == MK_TIMEPH) tp0 = __builtin_amdgcn_s_memrealtime(); if (IN(k)) { { int t_ = threadIdx.x; asm volatile("" : "+v"(t_)); F.tid = t_; F.lane = t_ & 63; F.wave = __builtin_amdgcn_readfirstlane(t_ >> 6); } __VA_ARGS__ if ((MK_REPEAT >> (k)) & 1) { xcd_barrier(bar); __VA_ARGS__ } } MK_STAMP(F.lds, 1000 + (k)); SEAM(k); MK_STAMP(F.lds, 2 * (k) + 1); if ((k) == MK_TIMEPH) tp1 = __builtin_amdgcn_s_memrealtime(); } while (0)
    PHASE(0, { convert_job<0>(F, F.bid, F.G); if (MK_ABL == 1) convert_job<0>(F, F.bid, F.G); rope_table(F); if (MK_ABL == 2) rope_table(F); prep_rows(F, F.x, ((bf16*)(F.ws + WS_A))); if (MK_ABL == 3) prep_rows(F, F.x, ((bf16*)(F.ws + WS_A))); });
    PHASE(1, { pg8::Gemm g{((bf16*)(F.ws + WS_A)), ((bf16*)(F.ws + WS_WGU)), M, 2 * FF, D}; pg8::StaticOrder S; S.init(M, 2 * FF, F.G, F.bid); load_rstd_panels(F, S, ((float*)(F.ws + WS_SSQ))); EpiSwiGLU E{H, (const LAS float*)(F.lds + RS_OFF)};
        pg8::gemm_phase<EpiSwiGLU, pg8::StaticOrder, true, true>(F.lds, g, S, E, F.tid, 110);
        { const int nfull = (M / 256) * (2 * FF / 256) % F.G; if (nfull > 0 && F.bid >= nfull) { convert_job<1>(F, F.bid - nfull, F.G - nfull); }
          else if (nfull == 0) { convert_job<1>(F, F.bid, F.G); } } });
    PHASE(2, { pg8::Gemm g{H, ((bf16*)(F.ws + WS_WD)), M, D, FF}; pg8::StaticOrder S; S.init(M, D, F.G, F.bid); EpiResid<true> E{F.x, ((bf16*)(F.ws + WS_A)), 0.5f, ((float*)(F.ws + WS_SSQ))};
        pg8::gemm_phase<EpiResid<true>, pg8::StaticOrder, true, true>(F.lds, g, S, E, F.tid, 120); });
    PHASE(3, { pg8::Gemm g{((bf16*)(F.ws + WS_A)), ((bf16*)(F.ws + WS_WIN)), M, NINP, D}; pg8::StaticOrder S; S.init(M, NINP, F.G, F.bid); load_rstd_panels(F, S, ((float*)(F.ws + WS_SSQ))); EpiProj E{F.ws, (const LAS float*)(F.lds + RS_OFF)};
        pg8::gemm_phase<EpiProj, pg8::StaticOrder, true, true>(F.lds, g, S, E, F.tid, 130);
        { const int nfull = (M / 256) * (NINP / 256) % F.G; if (nfull > 0 && F.bid >= nfull) { convert_job<2>(F, F.bid - nfull, F.G - nfull); }
          else if (nfull == 0) { convert_job<2>(F, F.bid, F.G); } } });
    PHASE(4, { for (int tt = F.bid; tt < M / 32; tt += F.G) post_tile(F, tt); });
    PHASE(5, {
        for (int rep = 0; rep < (MK_ABL == 5 ? 2 : 1); ++rep) for (int u2 = F.bid; u2 < 256; u2 += F.G) ret_kv_unit(F, 2 * u2 + (F.wave >> 2), F.wave & 3, F.lane);
        for (int c = F.bid; c < 256; c += F.G) {
            _Pragma("unroll 1") for (int k = 0; k < 2; ++k) { const int b = c & 1, i = c >> 1; idx_unit(F, b, k ? 255 - i : i, F.wave, F.lane); } }
    });
    PHASE(6, { ret_scan(F); });
    PHASE(7, {
        for (int rep = 0; rep < (MK_ABL == 6 ? 2 : 1); ++rep) for (int u2 = F.bid; u2 < 256; u2 += F.G) { ret_out_stage(F, u2); ret_out_unit(F, 2 * u2 + (F.wave >> 2), F.wave & 3, F.lane); __syncthreads(); }
        MK_STAMP(F.lds, 210);
        for (int p = F.bid; p < 256; p += F.G) { const int grp = (p & 7) >> 1, b = grp >> 1, kvh = grp & 1, i = ((p >> 3) << 1) | (p & 1);
            _Pragma("unroll 1") for (int k = 0; k < 2; ++k) attn_unit(F, b, kvh, k ? 127 - i : i); }
    });
    PHASE(8, { pg8::Gemm g{((bf16*)(F.ws + WS_PIDX)), ((bf16*)(F.ws + WS_WOUT)), M, D, D}; pg8::StaticOrder S; S.init(M, D, F.G, F.bid); EpiResid<false> E{nullptr, ((bf16*)(F.ws + WS_A)), 1.0f, ((float*)(F.ws + WS_SSQ))};
        pg8::gemm_phase<EpiResid<false>, pg8::StaticOrder, true, true>(F.lds, g, S, E, F.tid, 180); });
    PHASE(9, { pg8::Gemm g{((bf16*)(F.ws + WS_A)), ((bf16*)(F.ws + WS_WGU)), M, 2 * FF, D}; pg8::StaticOrder S; S.init(M, 2 * FF, F.G, F.bid); load_rstd_panels(F, S, ((float*)(F.ws + WS_SSQ))); EpiSwiGLU E{H, (const LAS float*)(F.lds + RS_OFF)};
        pg8::gemm_phase<EpiSwiGLU, pg8::StaticOrder, true, true>(F.lds, g, S, E, F.tid, 190);
        { const int nfull = (M / 256) * (2 * FF / 256) % F.G; if (nfull > 0 && F.bid >= nfull) { convert_job<3>(F, F.bid - nfull, F.G - nfull); }
          else if (nfull == 0) { convert_job<3>(F, F.bid, F.G); } } });
    PHASE(10, { pg8::Gemm g{H, ((bf16*)(F.ws + WS_WD)), M, D, FF}; pg8::StaticOrder S; S.init(M, D, F.G, F.bid); EpiResid<false> E{nullptr, ((bf16*)(F.ws + WS_A)), 0.5f, ((float*)(F.ws + WS_SSQ))};
        pg8::gemm_phase<EpiResid<false>, pg8::StaticOrder, true, true>(F.lds, g, S, E, F.tid, 200); });
    PHASE(11, { rms_final(F); });
#undef PHASE
    if (MK_TA >= 0 && blockIdx.x == 0) { __syncthreads(); const unsigned long long ta = *(volatile LAS unsigned long long*)(F.lds + 147200 + 8), tb = *(volatile LAS unsigned long long*)(F.lds + 147200 + 16);
        const unsigned long long tgt = __builtin_amdgcn_s_memrealtime() + 4ull * (tb - ta); while (__builtin_amdgcn_s_memrealtime() < tgt) __builtin_amdgcn_s_sleep(8); }
    if (MK_TIMEPH >= 0 && blockIdx.x == 0) { const unsigned long long tgt = __builtin_amdgcn_s_memrealtime() + 4ull * (tp1 - tp0); while (__builtin_amdgcn_s_memrealtime() < tgt) __builtin_amdgcn_s_sleep(8); }
#undef IN
#undef SEAM
}

extern "C" void kernel_launch(void* const* d_in, const int* in_sizes, int n_in, void* d_out, int out_size, void* d_ws, size_t ws_size, hipStream_t stream) {
    static int grid = 0;
    if (grid == 0) {
        if (n_in != 15 || in_sizes[0] != M * D || out_size != M * D || ws_size < WS_END) { fprintf(stderr, "kernel_launch: unexpected shapes (n_in %d, in0 %d, out %d, ws %zu < %zu)\n", n_in, n_in > 0 ? in_sizes[0] : -1, out_size, ws_size, (size_t)WS_END); grid = -1; return; }
        int dev = 0, cus = 0;
        if (hipGetDevice(&dev) != hipSuccess || hipDeviceGetAttribute(&cus, hipDeviceAttributeMultiprocessorCount, dev) != hipSuccess) { grid = -1; return; }
        if (hipFuncSetAttribute((const void*)mk_fwd, hipFuncAttributeMaxDynamicSharedMemorySize, LDS_BYTES) != hipSuccess) { fprintf(stderr, "kernel_launch: hipFuncSetAttribute failed\n"); grid = -1; return; }
        int per_cu = 0;
        if (hipOccupancyMaxActiveBlocksPerMultiprocessor(&per_cu, (const void*)mk_fwd, NWAVES * 64, LDS_BYTES) != hipSuccess || per_cu < 1) fprintf(stderr, "kernel_launch: occupancy query reports %d\n", per_cu);
        (void)hipGetLastError();
        grid = cus;
    }
    if (grid < 0) return;
    (void)hipMemsetAsync((char*)d_ws + WS_CTL, 0, CTL_ZERO_BYTES, stream);
    Args a{};
    for (int i = 0; i < 15; ++i) a.in[i] = d_in[i];
    a.out = (float*)d_out; a.ws = (unsigned char*)d_ws;
#if MK_PER_PHASE
    for (int p = 0; p < NPHASE; ++p) { a.ph_lo = p; a.ph_hi = p + 1; hipLaunchKernelGGL(mk_fwd, dim3(grid), dim3(NWAVES * 64), LDS_BYTES, stream, a); }
#else
    a.ph_lo = 0; a.ph_hi = NPHASE;
    hipLaunchKernelGGL(mk_fwd, dim3(grid), dim3(NWAVES * 64), LDS_BYTES, stream, a);
#endif
}
```

```cpp
#include <hip/hip_runtime.h>
#include <cstdio>
#include <cstdint>

#ifndef MK_PER_PHASE
#define MK_PER_PHASE 0
#endif

#ifndef MK_ABL
#define MK_ABL 0
#endif
#ifndef MK_TA
#define MK_TA -1
#endif
#ifndef MK_TB
#define MK_TB -1
#endif
#define MK_STAMP(ldsbase, n) do { if (((n) == MK_TA || (n) == MK_TB) && blockIdx.x == 0 && threadIdx.x == 0) { \
    *(volatile __attribute__((address_space(3))) unsigned long long*)((ldsbase) + 147200 + ((n) == MK_TB ? 16 : 8)) = __builtin_amdgcn_s_memrealtime(); } } while (0)
namespace pg8 {
#define PG8_LAS __attribute__((address_space(3)))
typedef unsigned short bf16_t;
typedef short bf16x8 __attribute__((ext_vector_type(8)));
typedef float f32x4 __attribute__((ext_vector_type(4)));
typedef unsigned u32x4 __attribute__((ext_vector_type(4)));
constexpr int BM = 256, BK = 64, HALF = 128, HTB = HALF * BK * 2, STAGE_BYTES = 8 * HTB, NXCD = 8, WGM = 8;

__host__ __device__ __forceinline__ int lds_byte(int r, int c) { const int st = (r >> 4) * 2 + (c >> 5), rr = r & 15, cc = c & 31, ob = rr * 64 + cc * 2; return st * 1024 + (ob ^ (((ob >> 9) & 1) << 5)); }
__host__ __device__ __forceinline__ void stage_rc(int b, int& R, int& C) { const int st = b / 1024, sb = b % 1024, swz = sb ^ (((sb >> 9) & 1) << 5); R = (st >> 1) * 16 + swz / 64; C = (st & 1) * 32 + (swz % 64) / 2; }
__host__ __device__ __forceinline__ int perm32(int rho) { const int n = rho >> 4, i = rho & 15; return 8 * (i >> 2) + 4 * n + (i & 3); }

struct Unit { int pm, pn; };
struct Gemm { const bf16_t* A; const bf16_t* Bt; int M, N, K; };

struct StaticOrder {
    int nM, nN, nwg, G, c;
    __host__ __device__ void init(int M, int N, int G_, int c_) { nM = M / BM; nN = N / BM; nwg = nM * nN; G = G_; c = c_; }
    __host__ __device__ bool next(int i, Unit& u) const {
        const long L = (long)i * G + c; if (L >= nwg) return false;
        int wgid = (int)L; { const int q = nwg / NXCD, r = nwg % NXCD, xcd = wgid % NXCD, off = wgid / NXCD; wgid = (xcd < r ? xcd * (q + 1) : r * (q + 1) + (xcd - r) * q) + off; }
        const int nig = WGM * nN, gid = wgid / nig, fm = gid * WGM, gsz = (nM - fm) < WGM ? (nM - fm) : WGM;
        u.pm = fm + ((wgid % nig) % gsz); u.pn = (wgid % nig) / gsz; return true;
    }
    __device__ __forceinline__ void a_ready(const Unit&) const {}
    __device__ __forceinline__ void done(const Unit&) const {}
};

template <class Epi, class Sched, bool ALIGN_EPI = false, bool SP2 = false>
__device__ __forceinline__ void gemm_phase(PG8_LAS unsigned char* lds, const Gemm g, const Sched& S, const Epi& E, const int tid, const int sb = -100) {
    const int wid = __builtin_amdgcn_readfirstlane(tid >> 6), lane = tid & 63, wr = wid >> 2, wc = wid & 3, fr = lane & 15, fq = lane >> 4;
    const int K = g.K, nt = K / BK;
    unsigned voffA[2], voffB[2];
#pragma unroll
    for (int i = 0; i < 2; ++i) { int R, C; stage_rc(tid * 16 + i * 8192, R, C); const int Rb = Epi::PERM ? ((R & ~31) + perm32(R & 31)) : R;
        voffA[i] = (unsigned)(R * K + C) * 2u; voffB[i] = (unsigned)(Rb * K + C) * 2u; }
    const size_t kstep = (size_t)(BK * 2);
    const size_t hstep = (size_t)HALF * K * 2;
    const size_t tstep = 2 * hstep;
    const unsigned ldsw = (unsigned)wid * 1024u;
    const int aoff = lds_byte(wr * 64 + fr, fq * 8), boff = lds_byte(wc * 32 + fr, fq * 8);
#define PG8_SA(b, h) (((b) * 2 + (h)) * HTB)
#define PG8_SB(b, h) ((4 + (b) * 2 + (h)) * HTB)
#define PG8_STAGE(bufoff, gbase, voff) do { _Pragma("unroll") for (int _i = 0; _i < 2; ++_i) \
        __builtin_amdgcn_global_load_lds((const unsigned*)((const char*)(gbase) + (voff)[_i]), (PG8_LAS unsigned*)(lds + (bufoff) + ldsw + _i * 8192), 16, 0, 0); } while (0)
#define PG8_LDA(dst, b, h) do { _Pragma("unroll") for (int m = 0; m < 4; ++m) _Pragma("unroll") for (int k = 0; k < 2; ++k) dst[m][k] = *(const PG8_LAS bf16x8*)(lds + PG8_SA(b, h) + aoff + m * 2048 + k * 1024); } while (0)
#define PG8_LDB(dst, b, h) do { _Pragma("unroll") for (int n = 0; n < 2; ++n) _Pragma("unroll") for (int k = 0; k < 2; ++k) dst[n][k] = *(const PG8_LAS bf16x8*)(lds + PG8_SB(b, h) + boff + n * 2048 + k * 1024); } while (0)
#define PG8_MMA(ai, bj, At, Bt) do { __builtin_amdgcn_s_setprio(1); _Pragma("unroll") for (int m = 0; m < 4; ++m) _Pragma("unroll") for (int n = 0; n < 2; ++n) _Pragma("unroll") for (int k = 0; k < 2; ++k) \
        acc[ai][bj][m][n] = __builtin_amdgcn_mfma_f32_16x16x32_bf16(Bt[n][k], At[m][k], acc[ai][bj][m][n], 0, 0, 0); __builtin_amdgcn_s_setprio(0); } while (0)
#define PG8_WAIT_V(n) asm volatile("s_waitcnt vmcnt(" #n ")" ::: "memory")
#define PG8_WAIT_L(n) asm volatile("s_waitcnt lgkmcnt(" #n ")" ::: "memory")
#define PG8_BAR __builtin_amdgcn_s_barrier()
#define PG8_SCHED __builtin_amdgcn_sched_barrier(0)
    Unit cur, nxt; int ui = 0;
    if (!S.next(0, cur)) return;
    f32x4 acc[2][2][4][2];
#pragma unroll
    for (int a = 0; a < 2; ++a)
#pragma unroll
        for (int b = 0; b < 2; ++b)
#pragma unroll
            for (int m = 0; m < 4; ++m)
#pragma unroll
                for (int n = 0; n < 2; ++n) acc[a][b][m][n] = (f32x4){0.f, 0.f, 0.f, 0.f};
    bf16x8 At[4][2], B0[2][2], B1[2][2];
    const char* cA = (const char*)g.A + (size_t)cur.pm * tstep; const char* cB = (const char*)g.Bt + (size_t)cur.pn * tstep;
    S.a_ready(cur);
    if constexpr (SP2) {
        PG8_STAGE(PG8_SB(0, 0), cB, voffB); PG8_STAGE(PG8_SB(0, 1), cB + hstep, voffB); PG8_STAGE(PG8_SA(0, 0), cA, voffA); PG8_STAGE(PG8_SA(0, 1), cA + hstep, voffA);
        if (wr == 1) PG8_BAR;
        PG8_WAIT_V(2); PG8_BAR;
        PG8_STAGE(PG8_SB(1, 0), cB + kstep, voffB); PG8_STAGE(PG8_SA(1, 0), cA + kstep, voffA); PG8_STAGE(PG8_SB(1, 1), cB + hstep + kstep, voffB);
        PG8_WAIT_V(6); PG8_BAR;
    } else {
        PG8_STAGE(PG8_SB(0, 0), cB, voffB); PG8_STAGE(PG8_SA(0, 0), cA, voffA); PG8_STAGE(PG8_SB(0, 1), cB + hstep, voffB); PG8_STAGE(PG8_SA(0, 1), cA + hstep, voffA);
        if (wr == 1) PG8_BAR;
        PG8_WAIT_V(4); PG8_BAR;
        PG8_STAGE(PG8_SB(1, 0), cB + kstep, voffB); PG8_STAGE(PG8_SA(1, 0), cA + kstep, voffA); PG8_STAGE(PG8_SB(1, 1), cB + hstep + kstep, voffB);
        PG8_WAIT_V(6); PG8_BAR;
    }
    MK_STAMP(lds, sb + 0);
    for (;;) {
        const bool has_next = S.next(ui + 1, nxt);
        const char* nA = has_next ? (const char*)g.A + (size_t)nxt.pm * tstep : cA; const char* nB = has_next ? (const char*)g.Bt + (size_t)nxt.pn * tstep : cB;
        for (int t = 0; t < nt; t += 2) {
            const bool last = (t == nt - 2);
            const char* a1 = cA + (size_t)(t + 1) * kstep;
            const char* a2 = last ? nA : cA + (size_t)(t + 2) * kstep; const char* b2 = last ? nB : cB + (size_t)(t + 2) * kstep;
            const char* a3 = a2 + kstep; const char* b3 = b2 + kstep;
            if (last && has_next) S.a_ready(nxt);
            if constexpr (SP2) {
            PG8_LDB(B0, 0, 0); PG8_LDB(B1, 0, 1); PG8_SCHED; PG8_LDA(At, 0, 0); PG8_STAGE(PG8_SA(1, 1), a1 + hstep, voffA);
            PG8_WAIT_V(8); PG8_WAIT_L(0); PG8_BAR; PG8_MMA(0, 0, At, B0); PG8_MMA(0, 1, At, B1); PG8_BAR; PG8_SCHED;
            PG8_LDA(At, 0, 1); PG8_STAGE(PG8_SB(0, 0), b2, voffB); PG8_STAGE(PG8_SB(0, 1), b2 + hstep, voffB); PG8_STAGE(PG8_SA(0, 0), a2, voffA);
            PG8_WAIT_V(8); PG8_WAIT_L(0); PG8_BAR; PG8_MMA(1, 0, At, B0); PG8_MMA(1, 1, At, B1); PG8_BAR; PG8_SCHED;
            PG8_LDB(B0, 1, 0); PG8_LDB(B1, 1, 1); PG8_SCHED; PG8_LDA(At, 1, 0); PG8_STAGE(PG8_SA(0, 1), a2 + hstep, voffA);
            PG8_WAIT_V(8); PG8_WAIT_L(0); PG8_BAR; PG8_MMA(0, 0, At, B0); PG8_MMA(0, 1, At, B1); PG8_BAR; PG8_SCHED;
            PG8_LDA(At, 1, 1); PG8_STAGE(PG8_SB(1, 0), b3, voffB); PG8_STAGE(PG8_SB(1, 1), b3 + hstep, voffB); PG8_STAGE(PG8_SA(1, 0), a3, voffA);
            PG8_WAIT_V(8); PG8_WAIT_L(0); PG8_BAR; PG8_MMA(1, 0, At, B0); PG8_MMA(1, 1, At, B1); PG8_BAR; PG8_SCHED;
            } else {
            PG8_LDB(B0, 0, 0); PG8_SCHED; PG8_LDA(At, 0, 0); PG8_STAGE(PG8_SA(1, 1), a1 + hstep, voffA);
            PG8_WAIT_L(8); PG8_BAR; PG8_WAIT_L(0); PG8_MMA(0, 0, At, B0); PG8_BAR; PG8_SCHED;
            PG8_LDB(B1, 0, 1); PG8_STAGE(PG8_SB(0, 0), b2, voffB);
            PG8_BAR; PG8_WAIT_L(0); PG8_MMA(0, 1, At, B1); PG8_BAR;
            PG8_LDA(At, 0, 1); PG8_STAGE(PG8_SA(0, 0), a2, voffA);
            PG8_BAR; PG8_WAIT_L(0); PG8_MMA(1, 0, At, B0); PG8_BAR; PG8_SCHED;
            PG8_STAGE(PG8_SB(0, 1), b2 + hstep, voffB);
            PG8_WAIT_V(6); PG8_BAR; PG8_MMA(1, 1, At, B1); PG8_BAR;
            PG8_LDB(B0, 1, 0); PG8_SCHED; PG8_LDA(At, 1, 0); PG8_STAGE(PG8_SA(0, 1), a2 + hstep, voffA);
            PG8_WAIT_L(8); PG8_BAR; PG8_WAIT_L(0); PG8_MMA(0, 0, At, B0); PG8_BAR; PG8_SCHED;
            PG8_LDB(B1, 1, 1); PG8_STAGE(PG8_SB(1, 0), b3, voffB);
            PG8_BAR; PG8_WAIT_L(0); PG8_MMA(0, 1, At, B1); PG8_BAR;
            PG8_LDA(At, 1, 1); PG8_STAGE(PG8_SA(1, 0), a3, voffA);
            PG8_BAR; PG8_WAIT_L(0); PG8_MMA(1, 0, At, B0); PG8_BAR; PG8_SCHED;
            PG8_STAGE(PG8_SB(1, 1), b3 + hstep, voffB);
            PG8_WAIT_V(6); PG8_BAR; PG8_MMA(1, 1, At, B1); PG8_BAR;
            }
        }
        if constexpr (ALIGN_EPI) { if (wr == 0) PG8_BAR; }
        if (ui == 0) MK_STAMP(lds, sb + 1);
        E(acc, cur, ui, wr, wc, fr, fq); S.done(cur);
        if (ui == 0) MK_STAMP(lds, sb + 2);
        if (!has_next) break;
#pragma unroll
        for (int a = 0; a < 2; ++a)
#pragma unroll
            for (int b = 0; b < 2; ++b)
#pragma unroll
                for (int m = 0; m < 4; ++m)
#pragma unroll
                    for (int n = 0; n < 2; ++n) acc[a][b][m][n] = (f32x4){0.f, 0.f, 0.f, 0.f};
        cur = nxt; cA = nA; cB = nB; ++ui;
        if constexpr (ALIGN_EPI) { if (wr == 1) PG8_BAR; }
    }
    MK_STAMP(lds, sb + 3);
    PG8_WAIT_V(0);
    if constexpr (!ALIGN_EPI) { if (wr == 0) PG8_BAR; }
    PG8_BAR;
    MK_STAMP(lds, sb + 4);
#undef PG8_SA
#undef PG8_SB
#undef PG8_STAGE
#undef PG8_LDA
#undef PG8_LDB
#undef PG8_MMA
#undef PG8_WAIT_V
#undef PG8_WAIT_L
#undef PG8_BAR
#undef PG8_SCHED
}
}

constexpr int NWAVES = 8;
constexpr int BATCH = 2, T = 4096, D = 2048, M = BATCH * T;
constexpr int HRET = 8, HKV = 2, FF = 5632;
constexpr int NPB = 5632;
constexpr int NIDXP = 1280;
constexpr int NIN = 6736, NINP = 6912;
constexpr int C_RQ = 0, C_RK = 1024, C_RV = 2048, C_RG = 3072, C_AQ = 4096, C_AK = 5120, C_AV = 5376;
constexpr float NORM_EPS = 1e-6f;

constexpr size_t MiB = 1u << 20;
constexpr size_t WS_CTL = 0, CTL_ZERO_BYTES = 65536;
constexpr size_t WS_TAB = 1 * MiB;
constexpr size_t WS_WGU = 5 * MiB;
constexpr size_t WS_WD = 49 * MiB;
constexpr size_t WS_WIN = 71 * MiB;
constexpr size_t WS_WOUT = 98 * MiB;
constexpr size_t WS_A = 106 * MiB;
constexpr size_t WS_PROJ = 138 * MiB;
constexpr size_t WS_PIDX = 226 * MiB;
constexpr size_t WS_RKT = 266 * MiB;
constexpr size_t WS_RVT = 282 * MiB;
constexpr size_t WS_AVT = 298 * MiB;
constexpr size_t WS_IQ = 302 * MiB;
constexpr size_t WS_IK = 318 * MiB;
constexpr size_t WS_IW = 319 * MiB;
constexpr size_t WS_KV = 320 * MiB;
constexpr size_t WS_ST = 352 * MiB;
constexpr size_t WS_MASK = 368 * MiB;
constexpr size_t WS_SSQ = 372 * MiB;
constexpr size_t WS_TAB2 = 373 * MiB;
constexpr size_t WS_END = 375 * MiB;
constexpr int CW_BAR = 4096;

constexpr int RING_BYTES = 131072;
constexpr int LDS_BYTES = 147456;
constexpr int LDSCTL_OFF = LDS_BYTES - 512, MISC_OFF = LDSCTL_OFF + 320;

#define GAS __attribute__((address_space(1)))
#define LAS __attribute__((address_space(3)))
typedef unsigned short bf16;
typedef _Float16 f16;
typedef _Float16 half8 __attribute__((ext_vector_type(8)));
typedef unsigned v4u __attribute__((ext_vector_type(4)));
typedef unsigned v2u __attribute__((ext_vector_type(2)));
typedef float f32x2 __attribute__((ext_vector_type(2)));
typedef float f32x4 __attribute__((ext_vector_type(4)));
typedef float f32x16 __attribute__((ext_vector_type(16)));
typedef short bf16x8 __attribute__((ext_vector_type(8)));
typedef __bf16 bf16x2_t __attribute__((ext_vector_type(2)));
typedef GAS unsigned gu32;
#define LDS_WAIT() asm volatile("s_waitcnt lgkmcnt(0)" ::: "memory")
__device__ __forceinline__ unsigned pk2(float lo, float hi) { f32x2 v = {lo, hi}; bf16x2_t b = __builtin_convertvector(v, bf16x2_t); return __builtin_bit_cast(unsigned, b); }
__device__ __forceinline__ float bflo(unsigned w) { return __uint_as_float(w << 16); }
__device__ __forceinline__ float bfhi(unsigned w) { return __uint_as_float(w & 0xffff0000u); }
__device__ __forceinline__ float silu_f(float g) { return g * __builtin_amdgcn_rcpf(1.f + __builtin_amdgcn_exp2f(-1.4426950408889634f * g)); }

#define XB_TMO      128
#define XB_XCNT(j)  (256  + 64 * (j))
#define XB_XSUB(j)  (1280 + 64 * (j))
#define XB_XGEN(j)  (2304 + 64 * (j))
#define XB_TOP      3328
#define XB_TOPGEN   3392
#define XCD_BAR_WORDS 3456
#define XB_SPIN_CAP (1u << 22)
__device__ __forceinline__ unsigned xb_ld(unsigned* p)              { return __hip_atomic_load(p, __ATOMIC_RELAXED, __HIP_MEMORY_SCOPE_AGENT); }
__device__ __forceinline__ unsigned xb_add(unsigned* p, unsigned v) { return __hip_atomic_fetch_add(p, v, __ATOMIC_RELAXED, __HIP_MEMORY_SCOPE_AGENT); }
__device__ __forceinline__ unsigned xb_xcc_id() { return (unsigned)__builtin_amdgcn_s_getreg((3 << 11) | 20) & 0xFu; }
#define XB_SPIN(cond, bar) do { unsigned _sp = 0; while (cond) { __builtin_amdgcn_s_sleep(1); \
    if ((++_sp & 255u) == 0u) { if (xb_ld(&(bar)[XB_TMO])) break; if (_sp > XB_SPIN_CAP) { atomicAdd(&(bar)[XB_TMO], 1u); break; } } } } while (0)
struct XcdBarrier { unsigned* bar; unsigned x; volatile LAS unsigned* st; };
__device__ __forceinline__ XcdBarrier xcd_barrier_post(unsigned* bar, volatile LAS unsigned* st) {
    XcdBarrier b; b.bar = bar; b.x = xb_xcc_id(); b.st = st;
    if (threadIdx.x == 0) (void)xb_add(&bar[XB_XCNT(b.x)], 1u);
    return b;
}
__device__ __forceinline__ void xcd_barrier_complete(unsigned* bar, unsigned x, unsigned& nloc, unsigned& nx) {
    const unsigned G = gridDim.x * gridDim.y * gridDim.z;
    unsigned sum, cnt, mine, sp = 0u;
    for (;;) {
        sum = 0u; cnt = 0u; mine = 0u;
#pragma unroll
        for (unsigned j = 0; j < 16; ++j) { const unsigned c = xb_ld(&bar[XB_XCNT(j)]); sum += c; cnt += (c > 0u) ? 1u : 0u; mine = (j == x) ? c : mine; }
        if (sum == G) break;
        __builtin_amdgcn_s_sleep(1);
        if ((++sp & 255u) == 0u) { if (xb_ld(&bar[XB_TMO])) break; if (sp > XB_SPIN_CAP) { atomicAdd(&bar[XB_TMO], 1u); break; } }
    }
    nloc = mine > 0u ? mine : 1u; nx = cnt > 0u ? cnt : 1u;
}
__device__ __forceinline__ void xcd_barrier(const XcdBarrier& b) {
    asm volatile("s_waitcnt vmcnt(0)" ::: "memory");
    __syncthreads();
    if (threadIdx.x == 0) {
        unsigned* bar = b.bar;
        __builtin_amdgcn_s_waitcnt(0);
        unsigned nloc = b.st[0], nx = b.st[1];
        if (nloc == 0u) { xcd_barrier_complete(bar, b.x, nloc, nx); b.st[0] = nloc; b.st[1] = nx; }
        const unsigned old = xb_add(&bar[XB_XSUB(b.x)], 1u);
        const unsigned gen = old / nloc;
        if (old + 1u == (gen + 1u) * nloc) {
            __builtin_amdgcn_fence(__ATOMIC_RELEASE, "agent");
            asm volatile("s_waitcnt vmcnt(0)" ::: "memory");
            const unsigned og = xb_add(&bar[XB_TOP], 1u);
            const unsigned tg = og / nx;
            if (og + 1u == (tg + 1u) * nx) xb_add(&bar[XB_TOPGEN], 1u);
            else XB_SPIN(xb_ld(&bar[XB_TOPGEN]) == tg, bar);
            __builtin_amdgcn_fence(__ATOMIC_ACQUIRE, "agent");
            xb_add(&bar[XB_XGEN(b.x)], 1u);
            asm volatile("s_waitcnt vmcnt(0)" ::: "memory");
        } else {
            XB_SPIN(xb_ld(&bar[XB_XGEN(b.x)]) == gen, bar);
            __builtin_amdgcn_fence(__ATOMIC_ACQUIRE, "agent");
            asm volatile("s_waitcnt vmcnt(0)" ::: "memory");
        }
    }
    __syncthreads();
}

struct Frame {
    LAS unsigned char* lds;
    int tid, lane, wave;
    int bid, G;
    const float* x; const int* pos;
    const float *n1, *wg1, *wu1, *wd1, *nmix, *win, *nret, *wout, *n2, *wg2, *wu2, *wd2, *nfin;
    float* X;
    unsigned char* ws;
};

__device__ __forceinline__ float wave_sum(float v) {
#pragma unroll
    for (int o = 1; o < 64; o <<= 1) v += __shfl_xor(v, o);
    return v;
}

__device__ __forceinline__ float xor16_sum(float m);
__device__ __forceinline__ float xor32_sum(float m);
constexpr int RS_OFF = RING_BYTES, RS_MAXU = 6;
__device__ __forceinline__ void load_rstd_panels(Frame& F, const pg8::StaticOrder& S, const float* ssq) {
    LAS float* rs = (LAS float*)(F.lds + RS_OFF);
    const int r = F.tid >> 1, hf = F.tid & 1;
    f32x4 p[RS_MAXU][4]; bool ok[RS_MAXU];
#pragma unroll
    for (int i = 0; i < RS_MAXU; ++i) { pg8::Unit u; ok[i] = S.next(i, u);
        if (ok[i]) { const f32x4* q = (const f32x4*)(ssq + (size_t)(u.pm * 256 + r) * 32 + 16 * hf);
#pragma unroll
            for (int k = 0; k < 4; ++k) p[i][k] = q[k]; } }
#pragma unroll
    for (int i = 0; i < RS_MAXU; ++i) if (ok[i]) {
        const f32x4 s4 = (p[i][0] + p[i][1]) + (p[i][2] + p[i][3]);
        float s = (s4.x + s4.y) + (s4.z + s4.w);
        s += __shfl_xor(s, 1);
        if (hf == 0) rs[i * 256 + r] = 1.0f / sqrtf(s * (1.f / D) + NORM_EPS);
    }
    __syncthreads();
}
struct EpiSwiGLU {
    static constexpr bool PERM = true;
    bf16* H; const LAS float* rs;
    __device__ __forceinline__ void operator()(const f32x4 (&acc)[2][2][4][2], const pg8::Unit& u, int ui, int wr, int wc, int fr, int fq) const {
        const int row0 = u.pm * 256 + wr * 64 + fr, col0 = u.pn * 128 + wc * 32 + 8 * fq;
#pragma unroll
        for (int ai = 0; ai < 2; ++ai)
#pragma unroll
            for (int m = 0; m < 4; ++m) {
                const int row = row0 + ai * 128 + m * 16;
                const float r = rs[ui * 256 + ai * 128 + wr * 64 + m * 16 + fr];
                bf16* rowp = H + (size_t)row * FF + col0;
                const f32x4 g0 = acc[ai][0][m][0] * r, g1 = acc[ai][0][m][1] * r, u0 = acc[ai][1][m][0] * r, u1 = acc[ai][1][m][1] * r;
                v4u w;
                w.x = pk2(silu_f(g0[0]) * u0[0], silu_f(g0[1]) * u0[1]); w.y = pk2(silu_f(g0[2]) * u0[2], silu_f(g0[3]) * u0[3]);
                w.z = pk2(silu_f(g1[0]) * u1[0], silu_f(g1[1]) * u1[1]); w.w = pk2(silu_f(g1[2]) * u1[2], silu_f(g1[3]) * u1[3]);
                *(v4u*)rowp = w;
            }
    }
};
template <bool BASEF> struct EpiResid {
    static constexpr bool PERM = true;
    const float* basef; bf16* Ab; float alpha; float* ssq;
    __device__ __forceinline__ void operator()(const f32x4 (&acc)[2][2][4][2], const pg8::Unit& u, int ui, int wr, int wc, int fr, int fq) const {
        const int row0 = u.pm * 256 + wr * 64 + fr, col0 = u.pn * 256 + wc * 32 + 8 * fq;
#pragma unroll
        for (int ai = 0; ai < 2; ++ai) {
            f32x4 bf0[4][2], bf1[4][2]; v4u bw[4][2];
#pragma unroll
            for (int m = 0; m < 4; ++m)
#pragma unroll
                for (int bj = 0; bj < 2; ++bj) {
                    const size_t off = (size_t)(row0 + ai * 128 + m * 16) * D + col0 + bj * 128;
                    if constexpr (BASEF) { bf0[m][bj] = __builtin_nontemporal_load((const f32x4*)(basef + off)); bf1[m][bj] = __builtin_nontemporal_load((const f32x4*)(basef + off + 4)); }
                    else bw[m][bj] = *(const v4u*)(Ab + off);
                }
            asm volatile("" ::: "memory");
#pragma unroll
            for (int m = 0; m < 4; ++m) {
                const int row = row0 + ai * 128 + m * 16;
                float sq = 0.f;
#pragma unroll
                for (int bj = 0; bj < 2; ++bj) {
                    const size_t off = (size_t)row * D + col0 + bj * 128;
                    f32x4 b0, b1;
                    if constexpr (BASEF) { b0 = bf0[m][bj]; b1 = bf1[m][bj]; }
                    else { const v4u w = bw[m][bj]; b0 = (f32x4){bflo(w.x), bfhi(w.x), bflo(w.y), bfhi(w.y)}; b1 = (f32x4){bflo(w.z), bfhi(w.z), bflo(w.w), bfhi(w.w)}; }
                    const f32x4 v0 = b0 + acc[ai][bj][m][0] * alpha, v1 = b1 + acc[ai][bj][m][1] * alpha;
                    sq += (v0.x * v0.x + v0.y * v0.y) + (v0.z * v0.z + v0.w * v0.w) + (v1.x * v1.x + v1.y * v1.y) + (v1.z * v1.z + v1.w * v1.w);
                    v4u w; w.x = pk2(v0.x, v0.y); w.y = pk2(v0.z, v0.w); w.z = pk2(v1.x, v1.y); w.w = pk2(v1.z, v1.w);
                    *(v4u*)(Ab + off) = w;
                }
                sq = xor16_sum(sq); sq = xor32_sum(sq);
                if (fq == 0) ssq[(size_t)row * 32 + u.pn * 4 + wc] = sq;
            }
        }
    }
};
__device__ __forceinline__ float lg2_gamma(int h);
typedef _Float16 half4 __attribute__((ext_vector_type(4)));
struct EpiProj {
    static constexpr bool PERM = true;
    unsigned char* ws; const LAS float* rs;
    __device__ __forceinline__ void operator()(const f32x4 (&acc)[2][2][4][2], const pg8::Unit& u, int ui, int wr, int wc, int fr, int fq) const {
        const int row0 = u.pm * 256 + wr * 64 + fr, t = u.pn;
        bf16* PROJ = (bf16*)(ws + WS_PROJ);
        if (t < 8 || (t >= 16 && t <= 20)) {
            const int typ = t < 4 ? 0 : t < 8 ? 1 : t < 20 ? 2 : 3;
            const int tb = typ == 0 ? 0 : typ == 1 ? 4 : typ == 2 ? 16 : 20, cb = typ == 0 ? C_RQ : typ == 1 ? C_RK : typ == 2 ? C_AQ : C_AK;
            const int hd = 2 * (t - tb) + (wc >> 1), i0 = 32 * (wc & 1) + 8 * fq;
            const float lg = lg2_gamma(hd);
            const float2* TAB = (const float2*)(ws + WS_TAB);
#pragma unroll
            for (int ai = 0; ai < 2; ++ai) {
#pragma unroll
              for (int mp = 0; mp < 2; ++mp) {
                f32x4 cst[2][4];
#pragma unroll
                for (int mm = 0; mm < 2; ++mm) { const f32x4* tp = (const f32x4*)(TAB + (size_t)(row0 + ai * 128 + (2 * mp + mm) * 16) * 64 + i0);
#pragma unroll
                    for (int k = 0; k < 4; ++k) cst[mm][k] = tp[k]; }
                asm volatile("" ::: "memory");
#pragma unroll
                for (int mm = 0; mm < 2; ++mm) {
                    const int m = 2 * mp + mm;
                    const int row = row0 + ai * 128 + m * 16;
                    const float r = rs[ui * 256 + ai * 128 + wr * 64 + m * 16 + fr];
                    const f32x4 c01 = cst[mm][0], c23 = cst[mm][1], c45 = cst[mm][2], c67 = cst[mm][3];
                    const float pcf = (float)((row & 127) + 1);
                    const float sc = r * (typ == 0 ? __builtin_amdgcn_exp2f(lg * pcf) : typ == 1 ? 0.08838834764831845f * __builtin_amdgcn_exp2f(-lg * pcf) : typ == 2 ? 0.08838834764831845f * 1.4426950408889634f : 1.f);
                    const f32x4 a0 = acc[ai][0][m][0], a1 = acc[ai][0][m][1], b0 = acc[ai][1][m][0], b1 = acc[ai][1][m][1];
                    v4u o1, o2;
                    o1.x = pk2((a0.x * c01.x - b0.x * c01.y) * sc, (a0.y * c01.z - b0.y * c01.w) * sc); o1.y = pk2((a0.z * c23.x - b0.z * c23.y) * sc, (a0.w * c23.z - b0.w * c23.w) * sc);
                    o1.z = pk2((a1.x * c45.x - b1.x * c45.y) * sc, (a1.y * c45.z - b1.y * c45.w) * sc); o1.w = pk2((a1.z * c67.x - b1.z * c67.y) * sc, (a1.w * c67.z - b1.w * c67.w) * sc);
                    o2.x = pk2((b0.x * c01.x + a0.x * c01.y) * sc, (b0.y * c01.z + a0.y * c01.w) * sc); o2.y = pk2((b0.z * c23.x + a0.z * c23.y) * sc, (b0.w * c23.z + a0.w * c23.w) * sc);
                    o2.z = pk2((b1.x * c45.x + a1.x * c45.y) * sc, (b1.y * c45.z + a1.y * c45.w) * sc); o2.w = pk2((b1.z * c67.x + a1.z * c67.y) * sc, (b1.w * c67.z + a1.w * c67.w) * sc);
                    bf16* rowp = PROJ + (size_t)row * NPB + cb + hd * 128 + i0;
                    *(v4u*)rowp = o1; *(v4u*)(rowp + 64) = o2;
                }
              }
            }
        } else if (t < 22) {
            const bool gate = (t >= 12 && t < 16);
            const int col0 = t * 256 + wc * 32 + 8 * fq;
#pragma unroll
            for (int ai = 0; ai < 2; ++ai)
#pragma unroll
                for (int m = 0; m < 4; ++m) {
                    const int row = row0 + ai * 128 + m * 16;
                    const float r = rs[ui * 256 + ai * 128 + wr * 64 + m * 16 + fr];
                    bf16* rowp = PROJ + (size_t)row * NPB + col0;
#pragma unroll
                    for (int bj = 0; bj < 2; ++bj) {
                        f32x4 v0 = acc[ai][bj][m][0] * r, v1 = acc[ai][bj][m][1] * r;
                        if (gate) { v0 = (f32x4){silu_f(v0.x), silu_f(v0.y), silu_f(v0.z), silu_f(v0.w)}; v1 = (f32x4){silu_f(v1.x), silu_f(v1.y), silu_f(v1.z), silu_f(v1.w)}; }
                        v4u w; w.x = pk2(v0[0], v0[1]); w.y = pk2(v0[2], v0[3]); w.z = pk2(v1[0], v1[1]); w.w = pk2(v1[2], v1[3]);
                        *(v4u*)(rowp + bj * 128) = w;
                    }
                }
        } else if (t < 26 || wc == 0) {
            const bool isq = t < 26;
            const int hd = 4 * (t - 22) + wc, i0 = 8 * fq;
            const float2* TAB2 = (const float2*)(ws + WS_TAB2);
            f16* OUT = isq ? (f16*)(ws + WS_IQ) : (f16*)(ws + WS_IK);
            const int ld = isq ? 1024 : 64, cb = isq ? hd * 64 : 0;
            const float s8 = isq ? 0.125f : 1.f;
#pragma unroll
            for (int ai = 0; ai < 2; ++ai) {
#pragma unroll
              for (int mp = 0; mp < 2; ++mp) {
                f32x4 cst[2][4];
#pragma unroll
                for (int mm = 0; mm < 2; ++mm) { const f32x4* tp = (const f32x4*)(TAB2 + (size_t)(row0 + ai * 128 + (2 * mp + mm) * 16) * 32 + i0);
#pragma unroll
                    for (int k = 0; k < 4; ++k) cst[mm][k] = tp[k]; }
                asm volatile("" ::: "memory");
#pragma unroll
                for (int mm = 0; mm < 2; ++mm) {
                    const int m = 2 * mp + mm;
                    const int row = row0 + ai * 128 + m * 16;
                    const float sc = rs[ui * 256 + ai * 128 + wr * 64 + m * 16 + fr] * s8;
                    const f32x4 c01 = cst[mm][0], c23 = cst[mm][1], c45 = cst[mm][2], c67 = cst[mm][3];
                    const f32x4 a0 = acc[ai][0][m][0], a1 = acc[ai][0][m][1], b0 = acc[ai][1][m][0], b1 = acc[ai][1][m][1];
                    half8 h1, h2;
                    h1[0] = (f16)((a0.x * c01.x - b0.x * c01.y) * sc); h1[1] = (f16)((a0.y * c01.z - b0.y * c01.w) * sc); h1[2] = (f16)((a0.z * c23.x - b0.z * c23.y) * sc); h1[3] = (f16)((a0.w * c23.z - b0.w * c23.w) * sc);
                    h1[4] = (f16)((a1.x * c45.x - b1.x * c45.y) * sc); h1[5] = (f16)((a1.y * c45.z - b1.y * c45.w) * sc); h1[6] = (f16)((a1.z * c67.x - b1.z * c67.y) * sc); h1[7] = (f16)((a1.w * c67.z - b1.w * c67.w) * sc);
                    h2[0] = (f16)((b0.x * c01.x + a0.x * c01.y) * sc); h2[1] = (f16)((b0.y * c01.z + a0.y * c01.w) * sc); h2[2] = (f16)((b0.z * c23.x + a0.z * c23.y) * sc); h2[3] = (f16)((b0.w * c23.z + a0.w * c23.w) * sc);
                    h2[4] = (f16)((b1.x * c45.x + a1.x * c45.y) * sc); h2[5] = (f16)((b1.y * c45.z + a1.y * c45.w) * sc); h2[6] = (f16)((b1.z * c67.x + a1.z * c67.y) * sc); h2[7] = (f16)((b1.w * c67.z + a1.w * c67.w) * sc);
                    f16* rowp = OUT + (size_t)row * ld + cb + i0;
                    *(half8*)rowp = h1; *(half8*)(rowp + 32) = h2;
                }
              }
            }
        } else if (wc == 1 && fq < 2) {
#pragma unroll
            for (int ai = 0; ai < 2; ++ai)
#pragma unroll
                for (int m = 0; m < 4; ++m) {
                    const int row = row0 + ai * 128 + m * 16;
                    const float sc = rs[ui * 256 + ai * 128 + wr * 64 + m * 16 + fr] * 0.25f;
                    float* rowp = (float*)(ws + WS_IW) + (size_t)row * 16 + 8 * fq;
                    *(f32x4*)rowp = acc[ai][0][m][0] * sc; *(f32x4*)(rowp + 4) = acc[ai][0][m][1] * sc;
                }
        }
    }
};

__device__ __forceinline__ int win_row(int n) {
    if (n < 2048 || (n >= 4096 && n < 5376)) { const int base = n < 1024 ? 0 : n < 2048 ? 1024 : n < 5120 ? 4096 : 5120; const int rel = n - base, head = rel >> 7, half = (rel >> 6) & 1, i = rel & 63;
        return base + 256 * (head >> 1) + 128 * half + 64 * (head & 1) + i; }
    if (n < 5632) return n;
    if (n < 6656) { const int rel = n - 5632, head = rel >> 6, half = (rel >> 5) & 1, i = rel & 31; return 5632 + 256 * (head >> 2) + 128 * half + 32 * (head & 3) + i; }
    if (n < 6720) { const int rel = n - 6656; return 6656 + 128 * (rel >> 5) + (rel & 31); }
    return 6656 + 32 + (n - 6720);
}
struct CvItem { const float* W; const float* g; bf16* WT; int K, N, k0, n0, gu, up; };
constexpr int CV_G = (D / 64) * (FF / 256), CV_D = (FF / 64) * (D / 256), CV_I = (D / 64) * ((NIN + 255) / 256), CV_O = (D / 64) * (D / 256);
constexpr int CV_TILE = 64 * 257 * 4;
template <int JOB> __device__ __forceinline__ constexpr int cv_total() { return JOB == 0 ? 2 * CV_G : JOB == 1 ? CV_D + CV_I : JOB == 2 ? 2 * CV_G + CV_O : CV_D; }
template <int JOB> __device__ __forceinline__ void cv_decode(const Frame& F, int it, CvItem& x) {
    x.gu = 0; x.up = 0; x.g = nullptr;
    if (JOB == 0 || JOB == 2) {
        const float* wg = JOB == 0 ? F.wg1 : F.wg2; const float* wu = JOB == 0 ? F.wu1 : F.wu2;
        if (it < 2 * CV_G) { const int up = it >= CV_G, r = up ? it - CV_G : it, kb = r / (FF / 256), nb = r % (FF / 256);
            x.W = up ? wu : wg; x.g = JOB == 0 ? F.n1 : F.n2; x.WT = ((bf16*)(F.ws + WS_WGU)); x.K = D; x.N = FF; x.k0 = 64 * kb; x.n0 = 256 * nb; x.gu = 1; x.up = up; return; }
        it -= 2 * CV_G;
        { const int kb = it / (D / 256), nb = it % (D / 256); x.W = F.wout; x.WT = ((bf16*)(F.ws + WS_WOUT)); x.K = D; x.N = D; x.k0 = 64 * kb; x.n0 = 256 * nb; }
    } else {
        if (it < CV_D) { const int kb = it / (D / 256), nb = it % (D / 256); x.W = JOB == 1 ? F.wd1 : F.wd2; x.WT = ((bf16*)(F.ws + WS_WD)); x.K = FF; x.N = D; x.k0 = 64 * kb; x.n0 = 256 * nb; return; }
        it -= CV_D;
        constexpr int NBI = (NIN + 255) / 256;
        { const int kb = it / NBI, nb = it % NBI; x.W = F.win; x.g = F.nmix; x.WT = ((bf16*)(F.ws + WS_WIN)); x.K = D; x.N = NIN; x.k0 = 64 * kb; x.n0 = 256 * nb; x.gu = 2; }
    }
}
__device__ __forceinline__ void cv_load(const CvItem& x, f32x4 (&v)[8], int wave, int lane) {
    const bool okc = (x.n0 + 4 * lane) < x.N;
    const float* p = x.W + (size_t)(x.k0 + 8 * wave) * x.N + x.n0 + 4 * lane;
#pragma unroll
    for (int i = 0; i < 8; ++i) v[i] = okc ? __builtin_nontemporal_load((const f32x4*)(p + (size_t)i * x.N)) : (f32x4){0.f, 0.f, 0.f, 0.f};
}
__device__ __forceinline__ void cv_gain(const CvItem& x, f32x4 (&gq)[2], int wave) {
    if (x.g) { const f32x4* q = (const f32x4*)(x.g + x.k0 + 8 * wave); gq[0] = q[0]; gq[1] = q[1]; }
    else { gq[0] = (f32x4){1.f, 1.f, 1.f, 1.f}; gq[1] = gq[0]; }
}
template <int JOB> __device__ __forceinline__ void convert_job(Frame& F, int w, int nw) {
    const int lane = F.lane, wave = F.wave, c = lane & 7, nn = lane >> 3;
    constexpr int total = cv_total<JOB>();
    CvItem x0, x1, x2; f32x4 v0[8], v1[8], v2[8], g0[2], g1[2], g2[2];
    if (w < total) { cv_decode<JOB>(F, w, x0); cv_load(x0, v0, wave, lane); cv_gain(x0, g0, wave); }
    if (w + nw < total) { cv_decode<JOB>(F, w + nw, x1); cv_load(x1, v1, wave, lane); cv_gain(x1, g1, wave); }
    int par = 0;
    for (int it = w; it < total; it += nw) {
        LAS float* tile = (LAS float*)(F.lds + par * CV_TILE);
#pragma unroll
        for (int i = 0; i < 8; ++i) { LAS float* s = tile + (8 * wave + i) * 257 + 4 * lane; const float gs = g0[i >> 2][i & 3]; s[0] = v0[i].x * gs; s[1] = v0[i].y * gs; s[2] = v0[i].z * gs; s[3] = v0[i].w * gs; }
        if (it + 2 * nw < total) { cv_decode<JOB>(F, it + 2 * nw, x2); cv_load(x2, v2, wave, lane); cv_gain(x2, g2, wave); }
        __syncthreads();
#pragma unroll
        for (int q = 0; q < 4; ++q) {
            const int n = 32 * wave + nn + 8 * q, ncol = x0.n0 + n;
            const LAS float* s = tile + (8 * c) * 257 + n;
            v4u o; o.x = pk2(s[0 * 257], s[1 * 257]); o.y = pk2(s[2 * 257], s[3 * 257]); o.z = pk2(s[4 * 257], s[5 * 257]); o.w = pk2(s[6 * 257], s[7 * 257]);
            const int drow = x0.gu == 1 ? (((ncol >> 7) << 8) + (ncol & 127) + (x0.up ? 128 : 0)) : x0.gu == 2 ? win_row(ncol) : ncol;
            if (ncol < x0.N) __builtin_nontemporal_store(o, (v4u*)(x0.WT + (size_t)drow * x0.K + x0.k0 + 8 * c));
        }
        x0 = x1; x1 = x2;
#pragma unroll
        for (int i = 0; i < 8; ++i) { v0[i] = v1[i]; v1[i] = v2[i]; }
        g0[0] = g1[0]; g0[1] = g1[1]; g1[0] = g2[0]; g1[1] = g2[1];
        par ^= 1;
    }
    __syncthreads();
    if (JOB == 1) {
        v4u* z0 = (v4u*)(((bf16*)(F.ws + WS_WIN)) + (size_t)6704 * D); v4u* z1 = (v4u*)(((bf16*)(F.ws + WS_WIN)) + (size_t)6816 * D);
        for (int i = w * 512 + F.tid; i < 80 * D / 8; i += nw * 512) z0[i] = (v4u){0u, 0u, 0u, 0u};
        for (int i = w * 512 + F.tid; i < 96 * D / 8; i += nw * 512) z1[i] = (v4u){0u, 0u, 0u, 0u};
    }
}
__device__ __forceinline__ void prep_rows(Frame& F, const float* src, bf16* dst) {
    const int gw = F.bid * NWAVES + F.wave, NGW = F.G * NWAVES, lane = F.lane;
    f32x4 v[8], vn[8];
    if (gw < M) {
#pragma unroll
        for (int j = 0; j < 8; ++j) v[j] = __builtin_nontemporal_load((const f32x4*)(src + (size_t)gw * D) + lane + 64 * j);
    }
    for (int m = gw; m < M; m += NGW) {
        if (m + NGW < M) {
#pragma unroll
            for (int j = 0; j < 8; ++j) vn[j] = __builtin_nontemporal_load((const f32x4*)(src + (size_t)(m + NGW) * D) + lane + 64 * j);
        }
        float s = 0.f;
#pragma unroll
        for (int j = 0; j < 8; ++j) s += (v[j].x * v[j].x + v[j].y * v[j].y) + (v[j].z * v[j].z + v[j].w * v[j].w);
        s = wave_sum(s);
        v2u* o8 = (v2u*)(dst + (size_t)m * D) + lane;
#pragma unroll
        for (int j = 0; j < 8; ++j) { v2u w; w.x = pk2(v[j].x, v[j].y); w.y = pk2(v[j].z, v[j].w); o8[64 * j] = w; }
        if (lane < 32) ((float*)(F.ws + WS_SSQ))[(size_t)m * 32 + lane] = (lane == 0) ? s : 0.f;
#pragma unroll
        for (int j = 0; j < 8; ++j) v[j] = vn[j];
    }
}
__device__ __forceinline__ void rms_final(Frame& F) {
    const int gw = F.bid * NWAVES + F.wave, NGW = F.G * NWAVES, lane = F.lane;
    const f32x4* gr = (const f32x4*)F.nfin + lane;
    f32x4 gg[8];
#pragma unroll
    for (int j = 0; j < 8; ++j) gg[j] = gr[64 * j];
    v2u w[8], wn[8]; float sp = 0.f, spn = 0.f;
    if (gw < M) {
#pragma unroll
        for (int j = 0; j < 8; ++j) w[j] = ((const v2u*)(((bf16*)(F.ws + WS_A)) + (size_t)gw * D) + lane)[64 * j];
        sp = lane < 32 ? ((float*)(F.ws + WS_SSQ))[(size_t)gw * 32 + lane] : 0.f;
    }
    for (int m = gw; m < M; m += NGW) {
        if (m + NGW < M) {
#pragma unroll
            for (int j = 0; j < 8; ++j) wn[j] = ((const v2u*)(((bf16*)(F.ws + WS_A)) + (size_t)(m + NGW) * D) + lane)[64 * j];
            spn = lane < 32 ? ((float*)(F.ws + WS_SSQ))[(size_t)(m + NGW) * 32 + lane] : 0.f;
        }
        const float s = wave_sum(sp);
        const float rstd = 1.0f / sqrtf(s * (1.f / D) + NORM_EPS);
        f32x4* xr = (f32x4*)(F.X + (size_t)m * D) + lane;
#pragma unroll
        for (int j = 0; j < 8; ++j) __builtin_nontemporal_store((f32x4){bflo(w[j].x), bfhi(w[j].x), bflo(w[j].y), bfhi(w[j].y)} * rstd * gg[j], xr + 64 * j);
#pragma unroll
        for (int j = 0; j < 8; ++j) w[j] = wn[j];
        sp = spn;
    }
}
__device__ __forceinline__ void rope_table(Frame& F) {
    const int gt = F.bid * (NWAVES * 64) + F.tid, NT = F.G * NWAVES * 64;
    for (int e = gt; e < M * 64; e += NT) {
        const int m = e >> 6, i = e & 63;
        double inv = 1.0; const double rr = 8.65964323360065346691e-01;
        for (int k = 0; k < i; ++k) inv *= rr;
        const float invf = (float)inv;
        const float angf = (float)F.pos[m] * invf;
        const double ang = (double)angf;
        const double kq = __builtin_rint(ang * 0.63661977236758134308);
        double y = __builtin_fma(-kq, 1.57079632679489655800e+00, ang);
        y = __builtin_fma(-kq, 6.12323399573676603587e-17, y);
        const double y2 = y * y;
        double sn = 1.0 / 6227020800.0; sn = sn * y2 - 1.0 / 39916800.0; sn = sn * y2 + 1.0 / 362880.0; sn = sn * y2 - 1.0 / 5040.0; sn = sn * y2 + 1.0 / 120.0; sn = sn * y2 - 1.0 / 6.0; sn = sn * y2 * y + y;
        double cs = 1.0 / 479001600.0; cs = cs * y2 - 1.0 / 3628800.0; cs = cs * y2 + 1.0 / 40320.0; cs = cs * y2 - 1.0 / 720.0; cs = cs * y2 + 1.0 / 24.0; cs = cs * y2 - 0.5; cs = cs * y2 + 1.0;
        const int q = ((int)kq) & 3;
        const double c = (q == 0) ? cs : (q == 1) ? -sn : (q == 2) ? -cs : sn;
        const double s = (q == 0) ? sn : (q == 1) ? cs : (q == 2) ? -sn : -cs;
        ((float2*)(F.ws + WS_TAB))[e] = make_float2((float)c, (float)s);
        if ((i & 1) == 0) ((float2*)(F.ws + WS_TAB2))[(size_t)m * 32 + (i >> 1)] = make_float2((float)c, (float)s);
    }
}
__device__ __forceinline__ float lg2_gamma(int h) {
    const double x = __builtin_amdgcn_exp2f((float)(-5 - h));
    double s = 1.0 / 8.0; s = s * x + 1.0 / 7.0; s = s * x + 1.0 / 6.0; s = s * x + 0.2; s = s * x + 0.25; s = s * x + 1.0 / 3.0; s = s * x + 0.5; s = s * x + 1.0; s = -s * x;
    return (float)(s * 1.44269504088896338700);
}

constexpr int PT_IMG = 32 * 132 * 4;
__device__ __forceinline__ void post_tile(Frame& F, int tt) {
    const int tid = F.tid;
    const int m0 = tt * 32, b = m0 / T, tp0 = m0 % T;
    const int ltok = tid >> 4, lc8 = (tid & 15) * 8;
    const bf16* gp0 = ((bf16*)(F.ws + WS_PROJ)) + (size_t)(m0 + ltok) * NPB + lc8;
    v4u cur = *(const v4u*)(gp0 + C_RK), nxt = cur;
    for (int s = 0; s < 18; ++s) {
        LAS float* L = (LAS float*)(F.lds + (s & 1) * PT_IMG);
        const int typ = s < 8 ? 1 : s < 16 ? 2 : 6, h = s < 16 ? (s & 7) : (s & 1);
        if (s + 1 < 18) { const int sn = s + 1; nxt = *(const v4u*)(gp0 + (sn < 8 ? C_RK + sn * 128 : sn < 16 ? C_RV + (sn - 8) * 128 : C_AV + (sn - 16) * 128)); }
        { const v4u w = cur; LAS float* lp = L + ltok * 132 + lc8;
          lp[0] = bflo(w.x); lp[1] = bfhi(w.x); lp[2] = bflo(w.y); lp[3] = bfhi(w.y); lp[4] = bflo(w.z); lp[5] = bfhi(w.z); lp[6] = bflo(w.w); lp[7] = bfhi(w.w); }
        __syncthreads();
        {
            const int d = tid >> 2, t8 = (tid & 3) * 8;
            bf16* tb = (typ == 1) ? ((bf16*)(F.ws + WS_RKT)) + ((size_t)(b * 8 + h) * 128 + d) * T : (typ == 2) ? ((bf16*)(F.ws + WS_RVT)) + ((size_t)(b * 8 + h) * 128 + d) * T : ((bf16*)(F.ws + WS_AVT)) + ((size_t)(b * 2 + h) * 128 + d) * T;
            const LAS float* lp = L + t8 * 132 + d;
            v4u w; w.x = pk2(lp[0], lp[132]); w.y = pk2(lp[264], lp[396]); w.z = pk2(lp[528], lp[660]); w.w = pk2(lp[792], lp[924]);
            if (typ != 6) *(v4u*)(tb + tp0 + t8) = w;
            else {
                const int p0 = 8 * ((t8 >> 2) & 3) + 4 * (t8 >> 4);
                *(v2u*)(tb + tp0 + p0) = (v2u){w.x, w.y}; *(v2u*)(tb + tp0 + p0 + 8) = (v2u){w.z, w.w};
            }
        }
        cur = nxt;
    }
    __syncthreads();
}

#define MFMA32(a, b, c) __builtin_amdgcn_mfma_f32_32x32x16_bf16((a), (b), (c), 0, 0, 0)
#define MFMA16(a, b, c) __builtin_amdgcn_mfma_f32_16x16x32_bf16((a), (b), (c), 0, 0, 0)
__device__ __forceinline__ f32x16 zero16() { f32x16 z;
#pragma unroll
    for (int i = 0; i < 16; ++i) z[i] = 0.f; return z; }
__device__ __forceinline__ void ret_kv_unit(Frame& F, int unit, int w4, int lane) {
    const int bh = unit >> 5, n = unit & 31, t0 = n * 128, r = lane & 31, hi = lane >> 5;
    f32x16 acc[4];
#pragma unroll
    for (int k = 0; k < 4; ++k) acc[k] = zero16();
    const bf16* vp = ((bf16*)(F.ws + WS_RVT)) + ((size_t)bh * 128 + 32 * w4 + r) * T + t0 + 8 * hi;
    const bf16* kp = ((bf16*)(F.ws + WS_RKT)) + ((size_t)bh * 128 + r) * T + t0 + 8 * hi;
#pragma unroll
    for (int s = 0; s < 8; ++s) {
        const bf16x8 bfr = *(const bf16x8*)(vp + 16 * s);
#pragma unroll
        for (int blk = 0; blk < 4; ++blk) { const bf16x8 af = *(const bf16x8*)(kp + (size_t)blk * 32 * T + 16 * s); acc[blk] = MFMA32(af, bfr, acc[blk]); }
    }
    float* kvp = ((float*)(F.ws + WS_KV)) + ((size_t)unit * 128 + 32 * w4 + r) * 128;
#pragma unroll
    for (int blk = 0; blk < 4; ++blk)
#pragma unroll
        for (int g = 0; g < 4; ++g) *(f32x4*)(kvp + 32 * blk + 8 * g + 4 * hi) = (f32x4){acc[blk][4 * g], acc[blk][4 * g + 1], acc[blk][4 * g + 2], acc[blk][4 * g + 3]};
}
__device__ __forceinline__ void ret_scan(Frame& F) {
    const int gt = F.bid * (NWAVES * 64) + F.tid, NT = F.G * NWAVES * 64;
    for (int idx = gt; idx < 16 * 4096; idx += NT) {
        const int bh = idx >> 12, rem = idx & 4095, h = bh & 7;
        const float gC = __builtin_amdgcn_exp2f(128.f * lg2_gamma(h));
        f32x4 S = {0.f, 0.f, 0.f, 0.f};
        const size_t off0 = ((size_t)(bh * 32) * 16384) + (size_t)rem * 4;
#pragma unroll 1
        for (int n0 = 0; n0 < 32; n0 += 8) {
            f32x4 kv[8];
#pragma unroll
            for (int k = 0; k < 8; ++k) kv[k] = *(const f32x4*)(((float*)(F.ws + WS_KV)) + off0 + (size_t)(n0 + k) * 16384);
#pragma unroll
            for (int k = 0; k < 8; ++k) {
                v2u w; w.x = pk2(S.x, S.y); w.y = pk2(S.z, S.w);
                *(v2u*)(((bf16*)(F.ws + WS_ST)) + off0 + (size_t)(n0 + k) * 16384) = w;
                S = (S + kv[k]) * gC;
            }
        }
    }
}
constexpr int RO_PITCH = 272, RO_KB = 128 * RO_PITCH, RO_UNIT = 2 * RO_KB;
__device__ __forceinline__ void ret_out_stage(Frame& F, int u2) {
    const int tid = F.tid, row0 = tid >> 4, c = tid & 15;
    const int vpos = 32 * (c >> 2) + 16 * ((c & 3) >> 1) + 4 * (c & 1);
#pragma unroll 1
    for (int us = 0; us < 2; ++us) {
        const int unit = 2 * u2 + us, bh = unit >> 5, n = unit & 31, b = bh >> 3, h = bh & 7, t0 = n * 128;
        v4u kr[4], vr[4];
#pragma unroll
        for (int j = 0; j < 4; ++j) {
            const int row = row0 + 32 * j;
            kr[j] = *(const v4u*)(((bf16*)(F.ws + WS_PROJ)) + ((size_t)b * T + t0 + row) * NPB + C_RK + h * 128 + 8 * c);
            vr[j] = *(const v4u*)(((bf16*)(F.ws + WS_RVT)) + ((size_t)bh * 128 + row) * T + t0 + 8 * c);
        }
#pragma unroll
        for (int j = 0; j < 4; ++j) {
            const int row = row0 + 32 * j;
            *(LAS v4u*)(F.lds + us * RO_UNIT + row * RO_PITCH + 16 * c) = kr[j];
            *(LAS v2u*)(F.lds + us * RO_UNIT + RO_KB + row * RO_PITCH + 2 * vpos) = (v2u){vr[j].x, vr[j].y};
            *(LAS v2u*)(F.lds + us * RO_UNIT + RO_KB + row * RO_PITCH + 2 * vpos + 16) = (v2u){vr[j].z, vr[j].w};
        }
    }
    __syncthreads();
}
__device__ __forceinline__ void ret_out_unit(Frame& F, int unit, int I, int lane) {
    const int lb = ((unit & 1) * RO_UNIT);
    const int bh = unit >> 5, n = unit & 31, b = bh >> 3, h = bh & 7, t0 = n * 128, r = lane & 31, hi = lane >> 5;
    const size_t tokI = (size_t)b * T + t0 + 32 * I + r;
    bf16x8 qf[8];
    { const bf16* qp = ((bf16*)(F.ws + WS_PROJ)) + tokI * NPB + C_RQ + h * 128 + 8 * hi;
#pragma unroll
      for (int s = 0; s < 8; ++s) qf[s] = *(const bf16x8*)(qp + 16 * s); }
    f32x16 out[4];
#pragma unroll
    for (int k = 0; k < 4; ++k) out[k] = zero16();
    { const bf16* sp = ((bf16*)(F.ws + WS_ST)) + ((size_t)unit * 128 + r) * 128 + 8 * hi;
#pragma unroll
      for (int blk = 0; blk < 4; ++blk) {
          bf16x8 af[8];
#pragma unroll
          for (int s = 0; s < 8; ++s) af[s] = *(const bf16x8*)(sp + (size_t)blk * 32 * 128 + 16 * s);
          asm volatile("" ::: "memory");
#pragma unroll
          for (int s = 0; s < 8; ++s) out[blk] = MFMA32(af[s], qf[s], out[blk]);
      } }
#pragma unroll 1
    for (int J = 0; J <= I; ++J) {
        asm volatile("" ::: "memory");
        f32x16 X = zero16();
#pragma unroll
        for (int s = 0; s < 8; ++s) { const bf16x8 kf = *(const LAS bf16x8*)(F.lds + lb + (32 * J + r) * RO_PITCH + (16 * s + 8 * hi) * 2); X = MFMA32(kf, qf[s], X); }
        if (J == I) {
            int rr = r; asm volatile("" : "+v"(rr));
#pragma unroll
            for (int g = 0; g < 16; ++g) { const int jrow = (g & 3) + 8 * (g >> 2) + 4 * hi; if (jrow > rr) X[g] = 0.f; }
        }
#pragma unroll
        for (int s2 = 0; s2 < 2; ++s2) {
            v4u xp; xp.x = pk2(X[8 * s2], X[8 * s2 + 1]); xp.y = pk2(X[8 * s2 + 2], X[8 * s2 + 3]); xp.z = pk2(X[8 * s2 + 4], X[8 * s2 + 5]); xp.w = pk2(X[8 * s2 + 6], X[8 * s2 + 7]);
            const bf16x8 xb = __builtin_bit_cast(bf16x8, xp);
#pragma unroll
            for (int blk = 0; blk < 4; ++blk) {
                const bf16x8 av = *(const LAS bf16x8*)(F.lds + lb + RO_KB + (32 * blk + r) * RO_PITCH + (32 * J + 8 * (2 * s2 + hi)) * 2);
                out[blk] = MFMA32(av, xb, out[blk]);
            }
        }
    }
    float s1 = 0.f, s2 = 0.f;
#pragma unroll
    for (int blk = 0; blk < 4; ++blk) {
#pragma unroll
        for (int g = 0; g < 16; ++g) { const float v = out[blk][g]; s1 += v; s2 = __builtin_fmaf(v, v, s2); }
        asm volatile("" : "+v"(s1), "+v"(s2));
    }
    s1 = xor32_sum(s1); s2 = xor32_sum(s2);
    const float mu = s1 * (1.f / 128.f);
    const float rstd = 1.0f / sqrtf(__builtin_fmaxf(s2 * (1.f / 128.f) - mu * mu, 0.f) + NORM_EPS);
    const bf16* gp = ((bf16*)(F.ws + WS_PROJ)) + tokI * NPB + C_RG + h * 128;
    bf16* op = ((bf16*)(F.ws + WS_PIDX)) + tokI * D + h * 128;
    const float* nw = F.nret + h * 128;
    v2u ov[4][4];
#pragma unroll
    for (int blk = 0; blk < 4; ++blk)
#pragma unroll
        for (int g = 0; g < 4; ++g) {
            const int e = 32 * blk + 8 * g + 4 * hi;
            const v2u gg = *(const v2u*)(gp + e); const f32x4 w4 = *(const f32x4*)(nw + e);
            const float y0 = (out[blk][4 * g] - mu) * rstd * w4.x * bflo(gg.x), y1 = (out[blk][4 * g + 1] - mu) * rstd * w4.y * bfhi(gg.x);
            const float y2 = (out[blk][4 * g + 2] - mu) * rstd * w4.z * bflo(gg.y), y3 = (out[blk][4 * g + 3] - mu) * rstd * w4.w * bfhi(gg.y);
            ov[blk][g].x = pk2(y0, y1); ov[blk][g].y = pk2(y2, y3);
            if (g == 3) asm volatile("" ::: "memory");
        }
    asm volatile("" ::: "memory");
#pragma unroll
    for (int blk = 0; blk < 4; ++blk)
#pragma unroll
        for (int g = 0; g < 4; ++g) *(v2u*)(op + 32 * blk + 8 * g + 4 * hi) = ov[blk][g];
}

__device__ __forceinline__ unsigned fkey(float f) { unsigned b = __float_as_uint(f); if (b == 0x80000000u) b = 0u; return (b & 0x80000000u) ? ~b : (b | 0x80000000u); }
__device__ __forceinline__ int row16_sum_i(int c) {
    c += __builtin_amdgcn_update_dpp(0, c, 0xB1, 0xF, 0xF, true);
    c += __builtin_amdgcn_update_dpp(0, c, 0x4E, 0xF, 0xF, true);
    c += __builtin_amdgcn_update_dpp(0, c, 0x141, 0xF, 0xF, true);
    c += __builtin_amdgcn_update_dpp(0, c, 0x140, 0xF, 0xF, true);
    return c;
}
__device__ __forceinline__ int half_sum(int c) {
    c = row16_sum_i(c);
    auto rr = __builtin_amdgcn_permlane16_swap((unsigned)c, (unsigned)c, false, false);
    return (int)rr[0] + (int)rr[1];
}
__device__ __forceinline__ float xor16_max(float m) { auto rr = __builtin_amdgcn_permlane16_swap(__float_as_uint(m), __float_as_uint(m), false, false); return __builtin_fmaxf(__uint_as_float(rr[0]), __uint_as_float(rr[1])); }
__device__ __forceinline__ float xor32_max(float m) { auto rr = __builtin_amdgcn_permlane32_swap(__float_as_uint(m), __float_as_uint(m), false, false); return __builtin_fmaxf(__uint_as_float(rr[0]), __uint_as_float(rr[1])); }
__device__ __forceinline__ float xor16_sum(float m) { auto rr = __builtin_amdgcn_permlane16_swap(__float_as_uint(m), __float_as_uint(m), false, false); return __uint_as_float(rr[0]) + __uint_as_float(rr[1]); }
__device__ __forceinline__ float xor32_sum(float m) { auto rr = __builtin_amdgcn_permlane32_swap(__float_as_uint(m), __float_as_uint(m), false, false); return __uint_as_float(rr[0]) + __uint_as_float(rr[1]); }
#define CNT4(c, u0, u1, u2, u3, cand) do { unsigned long long _t0, _t1, _t2, _t3; \
    asm volatile("v_cmp_ge_u32_e64 %1, %5, %9\n\tv_cmp_ge_u32_e64 %2, %6, %9\n\tv_cmp_ge_u32_e64 %3, %7, %9\n\tv_cmp_ge_u32_e64 %4, %8, %9\n\t" \
                 "v_addc_co_u32_e64 %0, vcc, 0, %0, %1\n\tv_addc_co_u32_e64 %0, vcc, 0, %0, %2\n\tv_addc_co_u32_e64 %0, vcc, 0, %0, %3\n\tv_addc_co_u32_e64 %0, vcc, 0, %0, %4" \
                 : "+v"(c), "=&s"(_t0), "=&s"(_t1), "=&s"(_t2), "=&s"(_t3) : "v"(u0), "v"(u1), "v"(u2), "v"(u3), "v"(cand) : "vcc"); } while (0)
constexpr int IX_KOFF = 32768, IX_KPITCH = 144, IX_KBUF = 256 * IX_KPITCH;
__device__ __forceinline__ void idx_unit(Frame& F, int b, int qb, int wave, int lane) {
    const int q0 = qb * 16, hi = lane >> 5, r = lane & 31, tid = F.tid;
    const int myq = q0 + 2 * wave + hi;
    const int arow_q = (r >> 2) & 1, arow_h = (r & 3) | ((r >> 3) << 2);
    half8 a[4];
    { const f16* ap = ((f16*)(F.ws + WS_IQ)) + ((size_t)b * T + q0 + 2 * wave + arow_q) * 1024 + arow_h * 64 + 8 * hi;
#pragma unroll
      for (int s = 0; s < 4; ++s) a[s] = *(const half8*)(ap + 16 * s); }
    float wv[16];
    { const f32x4* wp = (const f32x4*)(((float*)(F.ws + WS_IW)) + ((size_t)b * T + myq) * 16);
#pragma unroll
      for (int k = 0; k < 4; ++k) { const f32x4 t = wp[k]; wv[4 * k] = t.x; wv[4 * k + 1] = t.y; wv[4 * k + 2] = t.z; wv[4 * k + 3] = t.w; } }
    LAS unsigned* sl = (LAS unsigned*)(F.lds + wave * 4096) + lane;
    unsigned u[128];
    const int last = (q0 + 15) >> 5, nstage = (last >> 3) + 1;
    const f16* sg = ((f16*)(F.ws + WS_IK)) + ((size_t)b * T + (tid >> 1)) * 64 + 32 * (tid & 1);
    const int sst = IX_KOFF + (tid >> 1) * IX_KPITCH + 64 * (tid & 1);
    v4u sr[4];
#pragma unroll
    for (int j = 0; j < 4; ++j) sr[j] = *(const v4u*)(sg + 8 * j);
#pragma unroll
    for (int j = 0; j < 4; ++j) *(LAS v4u*)(F.lds + sst + 16 * j) = sr[j];
    __syncthreads();
    const int kread = IX_KOFF + r * IX_KPITCH + 16 * hi;
#pragma unroll
    for (int c = 0; c < 8; ++c) {
        if (16 * c <= last) {
#pragma unroll 1
            for (int st = 0; st < 2; ++st) {
                const int sidx = 2 * c + st;
                if (sidx < nstage) {
                    const bool more = (sidx + 1) < nstage;
                    if (more) {
#pragma unroll
                        for (int j = 0; j < 4; ++j) sr[j] = *(const v4u*)(sg + (size_t)(sidx + 1) * 256 * 64 + 8 * j);
                    }
                    const int kb = kread + (sidx & 1) * IX_KBUF;
#pragma unroll 1
                    for (int ii = 0; ii < 8; ++ii) {
                        const int i = 8 * sidx + ii;
                        half8 bfr[4];
#pragma unroll
                        for (int s = 0; s < 4; ++s) bfr[s] = *(const LAS half8*)(F.lds + kb + ii * 32 * IX_KPITCH + 32 * s);
                        f32x16 acc = zero16();
#pragma unroll
                        for (int s = 0; s < 4; ++s) acc = __builtin_amdgcn_mfma_f32_32x32x16_f16(a[s], bfr[s], acc, 0, 0, 0);
                        float sc = 0.f;
#pragma unroll
                        for (int hh = 0; hh < 16; ++hh) sc = __builtin_fmaf(wv[hh], __builtin_amdgcn_fmed3f(acc[hh], 0.f, INFINITY), sc);
                        const int key = 32 * i + r;
                        sl[(8 * st + ii) * 64] = (key <= myq) ? fkey(sc) : 0u;
                    }
                    if (more) {
#pragma unroll
                        for (int j = 0; j < 4; ++j) *(LAS v4u*)(F.lds + sst + ((sidx + 1) & 1) * IX_KBUF + 16 * j) = sr[j];
                    }
                    __syncthreads();
                } else {
#pragma unroll 1
                    for (int ii = 0; ii < 8; ++ii) sl[(8 * st + ii) * 64] = 0u;
                }
            }
#pragma unroll
            for (int ii = 0; ii < 16; ++ii) u[16 * c + ii] = sl[ii * 64];
        } else {
#pragma unroll
            for (int ii = 0; ii < 16; ++ii) u[16 * c + ii] = 0u;
        }
    }
    unsigned Tk = 0u; bool done = false;
#pragma unroll 1
    for (int rep = 0; rep < (MK_ABL == 4 ? 2 : 1); ++rep) { Tk = 0u; done = false;
#pragma unroll 1
    for (int bit = 31; bit >= 0; --bit) {
        const unsigned cand = Tk | (1u << bit);
        int c = 0;
#pragma unroll
        for (int g = 0; g < 8; ++g) {
            if (16 * g <= last) {
#pragma unroll
                for (int i = 0; i < 16; i += 4) CNT4(c, u[16 * g + i], u[16 * g + i + 1], u[16 * g + i + 2], u[16 * g + i + 3], cand);
            }
        }
        asm volatile("s_nop 2" : "+v"(c));
        c = half_sum(c);
        if (!done && c >= 256) { Tk = cand; done = (c == 256); }
        if (__all(done)) break;
    }
    asm volatile("" : "+v"(Tk)); }
    int cgt = 0, ceq = 0;
#pragma unroll
    for (int i = 0; i < 128; ++i) { cgt += (u[i] > Tk) ? 1 : 0; ceq += (u[i] == Tk) ? 1 : 0; }
    cgt = half_sum(cgt); ceq = half_sum(ceq);
    int Jthr = (Tk == 0u) ? -1 : 4095;
    const int need = 256 - cgt;
    const bool trim = (Tk != 0u) && (ceq > need);
    if (__any(trim)) {
        int J = 0;
#pragma unroll 1
        for (int bit = 11; bit >= 0; --bit) {
            const int cand = J | (1 << bit);
            unsigned Tk1 = Tk; asm volatile("" : "+v"(Tk1));
            const int cr = cand - r;
            int c = 0;
#pragma unroll
            for (int i = 0; i < 128; ++i) c += ((u[i] == Tk1) && (32 * i < cr)) ? 1 : 0;
            c = half_sum(c);
            if (c < need) J = cand;
        }
        if (trim) Jthr = J;
    }
    const int jt = Jthr - r;
    unsigned Tk2 = Tk; asm volatile("" : "+v"(Tk2));
    unsigned mlo0 = 0u, mhi0 = 0u, mlo1 = 0u, mhi1 = 0u;
#pragma unroll
    for (int g = 0; g < 8; ++g) {
        if (16 * g <= last) {
#pragma unroll
            for (int ii = 0; ii < 16; ++ii) {
                const int i = 16 * g + ii;
                const bool sel = (u[i] > Tk2) || ((u[i] == Tk2) && (32 * i <= jt));
                const unsigned long long bal = __ballot(sel);
                const unsigned lo = (unsigned)bal, hi_ = (unsigned)(bal >> 32);
                int lv = lane; asm volatile("" : "+v"(lv));
                const bool me = (lv == (i & 63));
                if (i < 64) { mlo0 = me ? lo : mlo0; mhi0 = me ? hi_ : mhi0; }
                else { mlo1 = me ? lo : mlo1; mhi1 = me ? hi_ : mhi1; }
            }
        }
    }
    unsigned* mp = ((unsigned*)(F.ws + WS_MASK)) + ((size_t)b * T + q0 + 2 * wave) * 128;
    mp[lane] = mlo0; mp[64 + lane] = mlo1; mp[128 + lane] = mhi0; mp[192 + lane] = mhi1;
}

constexpr int AT_PITCH = 272, AT_KBYTES = 128 * AT_PITCH, AT_BUF = 2 * AT_KBYTES;
__device__ __forceinline__ void attn_unit(Frame& F, int b, int kvh, int qb) {
    const int tid = F.tid, lane = F.lane, wave = F.wave, fr = lane & 15, fq = lane >> 4;
    const int q = qb * 32 + 4 * wave + (fr >> 2), head = 4 * kvh + (fr & 3);
    const size_t tok = (size_t)b * T + q;
    bf16x8 qf[4];
    { const bf16* qp = ((bf16*)(F.ws + WS_PROJ)) + tok * NPB + C_AQ + head * 128 + 8 * fq;
#pragma unroll
      for (int s = 0; s < 4; ++s) qf[s] = *(const bf16x8*)(qp + 32 * s); }
    const v4u* mrow = (const v4u*)(((unsigned*)(F.ws + WS_MASK)) + tok * 128);
    f32x4 O[8];
#pragma unroll
    for (int k = 0; k < 8; ++k) O[k] = (f32x4){0.f, 0.f, 0.f, 0.f};
    float mrun = -INFINITY, lsum = 0.f;
    const int nst = (qb + 4) >> 2;
    const int srow = tid >> 4, sc8 = (tid & 15) * 8;
    const bf16* kg = ((bf16*)(F.ws + WS_PROJ)) + ((size_t)b * T + srow) * NPB + C_AK + kvh * 128 + sc8;
    const bf16* vg = ((bf16*)(F.ws + WS_AVT)) + ((size_t)(b * 2 + kvh) * 128 + srow) * T + sc8;
    LAS unsigned char* lds = F.lds;
    const int kst = srow * AT_PITCH + sc8 * 2, vst = AT_KBYTES + kst;
    v4u kr[4], vr[4];
#pragma unroll
    for (int j = 0; j < 4; ++j) { kr[j] = *(const v4u*)(kg + (size_t)(32 * j) * NPB); vr[j] = *(const v4u*)(vg + (size_t)(32 * j) * T); }
#define AT_VWRITE(base) do { _Pragma("unroll") for (int j = 0; j < 4; ++j) *(LAS v4u*)(lds + (base) + vst + 32 * j * AT_PITCH) = vr[j]; } while (0)
#pragma unroll
    for (int j = 0; j < 4; ++j) *(LAS v4u*)(lds + kst + 32 * j * AT_PITCH) = kr[j];
    AT_VWRITE(0);
    v4u W4 = mrow[0], W4n = W4;
    __syncthreads();
    if (wave >= 4) __builtin_amdgcn_s_setprio(1);
    for (int st = 0; st < nst; ++st) {
        const int bo = (st & 1) * AT_BUF;
        const bool more = (st + 1 < nst);
        if (more) {
#pragma unroll
            for (int j = 0; j < 4; ++j) { kr[j] = *(const v4u*)(kg + (size_t)((st + 1) * 128 + 32 * j) * NPB); vr[j] = *(const v4u*)(vg + (size_t)(32 * j) * T + (st + 1) * 128); }
            W4n = mrow[st + 1];
        }
        {
            f32x4 sg[8];
#pragma unroll
            for (int g = 0; g < 8; ++g) sg[g] = (f32x4){0.f, 0.f, 0.f, 0.f};
#pragma unroll
            for (int s = 0; s < 4; ++s)
#pragma unroll
                for (int g = 0; g < 8; ++g) { const bf16x8 kf = *(const LAS bf16x8*)(lds + bo + (16 * g + fr) * AT_PITCH + (32 * s + 8 * fq) * 2); sg[g] = MFMA16(kf, qf[s], sg[g]); }
            float mx = -INFINITY;
#pragma unroll
            for (int g = 0; g < 8; ++g)
#pragma unroll
                for (int j = 0; j < 4; ++j) mx = __builtin_fmaxf(mx, sg[g][j]);
            mx = xor16_max(mx); mx = xor32_max(mx);
            const float mnew = __builtin_fmaxf(mrun, mx);
            const float alpha = __builtin_amdgcn_exp2f(mrun - mnew);
            const bool resc = __any(mnew != mrun);
            mrun = mnew;
            float ps = 0.f; bf16x8 pb[4];
#pragma unroll
            for (int h = 0; h < 4; ++h) {
                float p[8];
#pragma unroll
                for (int j = 0; j < 8; ++j) {
                    const int bit = 4 * fq + 16 * (j >> 2) + (j & 3);
                    const unsigned keep = (unsigned)__builtin_amdgcn_sbfe((int)W4[h], bit, 1);
                    p[j] = __uint_as_float(__float_as_uint(__builtin_amdgcn_exp2f(sg[2 * h + (j >> 2)][j & 3] - mnew)) & keep); ps += p[j];
                }
                v4u pp; pp.x = pk2(p[0], p[1]); pp.y = pk2(p[2], p[3]); pp.z = pk2(p[4], p[5]); pp.w = pk2(p[6], p[7]);
                pb[h] = __builtin_bit_cast(bf16x8, pp);
            }
            lsum = lsum * alpha + ps;
            if (resc) {
#pragma unroll
                for (int blk = 0; blk < 8; ++blk) O[blk] = O[blk] * alpha;
            }
#pragma unroll
            for (int blk = 0; blk < 8; ++blk) {
                const LAS unsigned char* vp = lds + bo + AT_KBYTES + (16 * blk + fr) * AT_PITCH + (8 * fq) * 2;
#pragma unroll
                for (int h = 0; h < 4; ++h) { const bf16x8 av = *(const LAS bf16x8*)(vp + 64 * h); O[blk] = MFMA16(av, pb[h], O[blk]); }
            }
        }
        if (more) { const int bn = ((st + 1) & 1) * AT_BUF;
#pragma unroll
            for (int j = 0; j < 4; ++j) *(LAS v4u*)(lds + bn + kst + 32 * j * AT_PITCH) = kr[j];
            AT_VWRITE(bn); }
        __syncthreads();
        W4 = W4n;
    }
#undef AT_VWRITE
    __builtin_amdgcn_s_setprio(0);
    lsum = xor16_sum(lsum); lsum = xor32_sum(lsum);
    const float inv = 1.0f / lsum;
    bf16* op = ((bf16*)(F.ws + WS_PIDX)) + tok * D + 1024 + head * 128 + 4 * fq;
#pragma unroll
    for (int blk = 0; blk < 8; ++blk) { v2u o; o.x = pk2(O[blk][0] * inv, O[blk][1] * inv); o.y = pk2(O[blk][2] * inv, O[blk][3] * inv); *(v2u*)(op + 16 * blk) = o; }
}

struct Args { const void* in[15]; float* out; unsigned char* ws; int ph_lo, ph_hi; };
constexpr int NPHASE = 12;
__global__ void __launch_bounds__(NWAVES * 64, 2) mk_fwd(Args args) {
    extern __shared__ __attribute__((aligned(16))) unsigned char lds[];
    Frame F;
    F.lds = (LAS unsigned char*)lds;
    F.tid = threadIdx.x; F.lane = F.tid & 63; F.wave = __builtin_amdgcn_readfirstlane(F.tid >> 6);
    F.G = gridDim.x; F.bid = blockIdx.x;
    unsigned char* ws = args.ws;
    F.x = (const float*)args.in[0]; F.pos = (const int*)args.in[1];
    F.n1 = (const float*)args.in[2]; F.wg1 = (const float*)args.in[3]; F.wu1 = (const float*)args.in[4]; F.wd1 = (const float*)args.in[5];
    F.nmix = (const float*)args.in[6]; F.win = (const float*)args.in[7]; F.nret = (const float*)args.in[8]; F.wout = (const float*)args.in[9];
    F.n2 = (const float*)args.in[10]; F.wg2 = (const float*)args.in[11]; F.wu2 = (const float*)args.in[12]; F.wd2 = (const float*)args.in[13]; F.nfin = (const float*)args.in[14];
    F.X = args.out;
    F.ws = ws;
    volatile LAS unsigned* MISC = (volatile LAS unsigned*)(F.lds + MISC_OFF);
    for (int u = F.tid; u < (LDS_BYTES - LDSCTL_OFF) / 4; u += NWAVES * 64) ((LAS unsigned*)(F.lds + LDSCTL_OFF))[u] = 0u;
    __syncthreads();
    const int lo = args.ph_lo, hi = args.ph_hi;
    XcdBarrier bar; bar.bar = (unsigned*)(ws + WS_CTL) + CW_BAR; bar.x = 0; bar.st = nullptr;
    if (hi - lo > 1) bar = xcd_barrier_post((unsigned*)(ws + WS_CTL) + CW_BAR, MISC + 8);
#ifndef MK_PHMASK
#define MK_PHMASK 0xFFFF
#endif
#define IN(k) (((MK_PHMASK >> (k)) & 1) && lo <= (k) && (k) < hi)
#define SEAM(k) do { if (IN(k) && IN((k) + 1)) xcd_barrier(bar); } while (0)
    bf16* H = ((bf16*)(F.ws + WS_PROJ));

#ifndef MK_REPEAT
#define MK_REPEAT 0
#endif
#ifndef MK_TIMEPH
#define MK_TIMEPH -1
#endif
    unsigned long long tp0 = 0, tp1 = 0;
#define PHASE(k, ...) do { MK_STAMP(F.lds, 2 * (k)); if ((k) == MK_TIMEPH) tp0 = __builtin_amdgcn_s_memrealtime(); if (IN(k)) { { int t_ = threadIdx.x; asm volatile("" : "+v"(t_)); F.tid = t_; F.lane = t_ & 63; F.wave = __builtin_amdgcn_readfirstlane(t_ >> 6); } __VA_ARGS__ if ((MK_REPEAT >> (k)) & 1) { xcd_barrier(bar); __VA_ARGS__ } } MK_STAMP(F.lds, 1000 + (k)); SEAM(k); MK_STAMP(F.lds, 2 * (k) + 1); if ((k) == MK_TIMEPH) tp1 = __builtin_amdgcn_s_memrealtime(); } while (0)
    PHASE(0, { convert_job<0>(F, F.bid, F.G); if (MK_ABL == 1) convert_job<0>(F, F.bid, F.G); rope_table(F); if (MK_ABL == 2) rope_table(F); prep_rows(F, F.x, ((bf16*)(F.ws + WS_A))); if (MK_ABL == 3) prep_rows(F, F.x, ((bf16*)(F.ws + WS_A))); });
    PHASE(1, { pg8::Gemm g{((bf16*)(F.ws + WS_A)), ((bf16*)(F.ws + WS_WGU)), M, 2 * FF, D}; pg8::StaticOrder S; S.init(M, 2 * FF, F.G, F.bid); load_rstd_panels(F, S, ((float*)(F.ws + WS_SSQ))); EpiSwiGLU E{H, (const LAS float*)(F.lds + RS_OFF)};
        pg8::gemm_phase<EpiSwiGLU, pg8::StaticOrder, true, true>(F.lds, g, S, E, F.tid, 110);
        { const int nfull = (M / 256) * (2 * FF / 256) % F.G; if (nfull > 0 && F.bid >= nfull) { convert_job<1>(F, F.bid - nfull, F.G - nfull); }
          else if (nfull == 0) { convert_job<1>(F, F.bid, F.G); } } });
    PHASE(2, { pg8::Gemm g{H, ((bf16*)(F.ws + WS_WD)), M, D, FF}; pg8::StaticOrder S; S.init(M, D, F.G, F.bid); EpiResid<true> E{F.x, ((bf16*)(F.ws + WS_A)), 0.5f, ((float*)(F.ws + WS_SSQ))};
        pg8::gemm_phase<EpiResid<true>, pg8::StaticOrder, true, true>(F.lds, g, S, E, F.tid, 120); });
    PHASE(3, { pg8::Gemm g{((bf16*)(F.ws + WS_A)), ((bf16*)(F.ws + WS_WIN)), M, NINP, D}; pg8::StaticOrder S; S.init(M, NINP, F.G, F.bid); load_rstd_panels(F, S, ((float*)(F.ws + WS_SSQ))); EpiProj E{F.ws, (const LAS float*)(F.lds + RS_OFF)};
        pg8::gemm_phase<EpiProj, pg8::StaticOrder, true, true>(F.lds, g, S, E, F.tid, 130);
        { const int nfull = (M / 256) * (NINP / 256) % F.G; if (nfull > 0 && F.bid >= nfull) { convert_job<2>(F, F.bid - nfull, F.G - nfull); }
          else if (nfull == 0) { convert_job<2>(F, F.bid, F.G); } } });
    PHASE(4, { for (int tt = F.bid; tt < M / 32; tt += F.G) post_tile(F, tt); });
    PHASE(5, {
        for (int rep = 0; rep < (MK_ABL == 5 ? 2 : 1); ++rep) for (int u2 = F.bid; u2 < 256; u2 += F.G) ret_kv_unit(F, 2 * u2 + (F.wave >> 2), F.wave & 3, F.lane);
        for (int c = F.bid; c < 256; c += F.G) {
            _Pragma("unroll 1") for (int k = 0; k < 2; ++k) { const int b = c & 1, i = c >> 1; idx_unit(F, b, k ? 255 - i : i, F.wave, F.lane); } }
    });
    PHASE(6, { ret_scan(F); });
    PHASE(7, {
        for (int rep = 0; rep < (MK_ABL == 6 ? 2 : 1); ++rep) for (int u2 = F.bid; u2 < 256; u2 += F.G) { ret_out_stage(F, u2); ret_out_unit(F, 2 * u2 + (F.wave >> 2), F.wave & 3, F.lane); __syncthreads(); }
        MK_STAMP(F.lds, 210);
        for (int p = F.bid; p < 256; p += F.G) { const int grp = (p & 7) >> 1, b = grp >> 1, kvh = grp & 1, i = ((p >> 3) << 1) | (p & 1);
            _Pragma("unroll 1") for (int k = 0; k < 2; ++k) attn_unit(F, b, kvh, k ? 127 - i : i); }
    });
    PHASE(8, { pg8::Gemm g{((bf16*)(F.ws + WS_PIDX)), ((bf16*)(F.ws + WS_WOUT)), M, D, D}; pg8::StaticOrder S; S.init(M, D, F.G, F.bid); EpiResid<false> E{nullptr, ((bf16*)(F.ws + WS_A)), 1.0f, ((float*)(F.ws + WS_SSQ))};
        pg8::gemm_phase<EpiResid<false>, pg8::StaticOrder, true, true>(F.lds, g, S, E, F.tid, 180); });
    PHASE(9, { pg8::Gemm g{((bf16*)(F.ws + WS_A)), ((bf16*)(F.ws + WS_WGU)), M, 2 * FF, D}; pg8::StaticOrder S; S.init(M, 2 * FF, F.G, F.bid); load_rstd_panels(F, S, ((float*)(F.ws + WS_SSQ))); EpiSwiGLU E{H, (const LAS float*)(F.lds + RS_OFF)};
        pg8::gemm_phase<EpiSwiGLU, pg8::StaticOrder, true, true>(F.lds, g, S, E, F.tid, 190);
        { const int nfull = (M / 256) * (2 * FF / 256) % F.G; if (nfull > 0 && F.bid >= nfull) { convert_job<3>(F, F.bid - nfull, F.G - nfull); }
          else if (nfull == 0) { convert_job<3>(F, F.bid, F.G); } } });
    PHASE(10, { pg8::Gemm g{H, ((bf16*)(F.ws + WS_WD)), M, D, FF}; pg8::StaticOrder S; S.init(M, D, F.G, F.bid); EpiResid<false> E{nullptr, ((bf16*)(F.ws + WS_A)), 0.5f, ((float*)(F.ws + WS_SSQ))};
        pg8::gemm_phase<EpiResid<false>, pg8::StaticOrder, true, true>(F.lds, g, S, E, F.tid, 200); });
    PHASE(11, { rms_final(F); });
#undef PHASE
    if (MK_TA >= 0 && blockIdx.x == 0) { __syncthreads(); const unsigned long long ta = *(volatile LAS unsigned long long*)(F.lds + 147200 + 8), tb = *(volatile LAS unsigned long long*)(F.lds + 147200 + 16);
        const unsigned long long tgt = __builtin_amdgcn_s_memrealtime() + 4ull * (tb - ta); while (__builtin_amdgcn_s_memrealtime() < tgt) __builtin_amdgcn_s_sleep(8); }
    if (MK_TIMEPH >= 0 && blockIdx.x == 0) { const unsigned long long tgt = __builtin_amdgcn_s_memrealtime() + 4ull * (tp1 - tp0); while (__builtin_amdgcn_s_memrealtime() < tgt) __builtin_amdgcn_s_sleep(8); }
#undef IN
#undef SEAM
}

extern "C" void kernel_launch(void* const* d_in, const int* in_sizes, int n_in, void* d_out, int out_size, void* d_ws, size_t ws_size, hipStream_t stream) {
    static int grid = 0;
    if (grid == 0) {
        if (n_in != 15 || in_sizes[0] != M * D || out_size != M * D || ws_size < WS_END) { fprintf(stderr, "kernel_launch: unexpected shapes (n_in %d, in0 %d, out %d, ws %zu < %zu)\n", n_in, n_in > 0 ? in_sizes[0] : -1, out_size, ws_size, (size_t)WS_END); grid = -1; return; }
        int dev = 0, cus = 0;
        if (hipGetDevice(&dev) != hipSuccess || hipDeviceGetAttribute(&cus, hipDeviceAttributeMultiprocessorCount, dev) != hipSuccess) { grid = -1; return; }
        if (hipFuncSetAttribute((const void*)mk_fwd, hipFuncAttributeMaxDynamicSharedMemorySize, LDS_BYTES) != hipSuccess) { fprintf(stderr, "kernel_launch: hipFuncSetAttribute failed\n"); grid = -1; return; }
        int per_cu = 0;
        if (hipOccupancyMaxActiveBlocksPerMultiprocessor(&per_cu, (const void*)mk_fwd, NWAVES * 64, LDS_BYTES) != hipSuccess || per_cu < 1) fprintf(stderr, "kernel_launch: occupancy query reports %d\n", per_cu);
        (void)hipGetLastError();
        grid = cus;
    }
    if (grid < 0) return;
    (void)hipMemsetAsync((char*)d_ws + WS_CTL, 0, CTL_ZERO_BYTES, stream);
    Args a{};
    for (int i = 0; i < 15; ++i) a.in[i] = d_in[i];
    a.out = (float*)d_out; a.ws = (unsigned char*)d_ws;
#if MK_PER_PHASE
    for (int p = 0; p < NPHASE; ++p) { a.ph_lo = p; a.ph_hi = p + 1; hipLaunchKernelGGL(mk_fwd, dim3(grid), dim3(NWAVES * 64), LDS_BYTES, stream, a); }
#else
    a.ph_lo = 0; a.ph_hi = NPHASE;
    hipLaunchKernelGGL(mk_fwd, dim3(grid), dim3(NWAVES * 64), LDS_BYTES, stream, a);
#endif
}
```

```cpp
#include <hip/hip_runtime.h>
#include <cstdio>
#include <cstdint>

#ifndef MK_PER_PHASE
#define MK_PER_PHASE 0
#endif

#ifndef MK_ABL
#define MK_ABL 0
#endif
#ifndef MK_TA
#define MK_TA -1
#endif
#ifndef MK_TB
#define MK_TB -1
#endif
#define MK_STAMP(ldsbase, n) do { if (((n) == MK_TA || (n) == MK_TB) && blockIdx.x == 0 && threadIdx.x == 0) { \
    *(volatile __attribute__((address_space(3))) unsigned long long*)((ldsbase) + 147200 + ((n) == MK_TB ? 16 : 8)) = __builtin_amdgcn_s_memrealtime(); } } while (0)
namespace pg8 {
#define PG8_LAS __attribute__((address_space(3)))
typedef unsigned short bf16_t;
typedef short bf16x8 __attribute__((ext_vector_type(8)));
typedef float f32x4 __attribute__((ext_vector_type(4)));
typedef unsigned u32x4 __attribute__((ext_vector_type(4)));
constexpr int BM = 256, BK = 64, HALF = 128, HTB = HALF * BK * 2, STAGE_BYTES = 8 * HTB, NXCD = 8, WGM = 8;

__host__ __device__ __forceinline__ int lds_byte(int r, int c) { const int st = (r >> 4) * 2 + (c >> 5), rr = r & 15, cc = c & 31, ob = rr * 64 + cc * 2; return st * 1024 + (ob ^ (((ob >> 9) & 1) << 5)); }
__host__ __device__ __forceinline__ void stage_rc(int b, int& R, int& C) { const int st = b / 1024, sb = b % 1024, swz = sb ^ (((sb >> 9) & 1) << 5); R = (st >> 1) * 16 + swz / 64; C = (st & 1) * 32 + (swz % 64) / 2; }
__host__ __device__ __forceinline__ int perm32(int rho) { const int n = rho >> 4, i = rho & 15; return 8 * (i >> 2) + 4 * n + (i & 3); }

struct Unit { int pm, pn; };
struct Gemm { const bf16_t* A; const bf16_t* Bt; int M, N, K; };

struct StaticOrder {
    int nM, nN, nwg, G, c;
    __host__ __device__ void init(int M, int N, int G_, int c_) { nM = M / BM; nN = N / BM; nwg = nM * nN; G = G_; c = c_; }
    __host__ __device__ bool next(int i, Unit& u) const {
        const long L = (long)i * G + c; if (L >= nwg) return false;
        int wgid = (int)L; { const int q = nwg / NXCD, r = nwg % NXCD, xcd = wgid % NXCD, off = wgid / NXCD; wgid = (xcd < r ? xcd * (q + 1) : r * (q + 1) + (xcd - r) * q) + off; }
        const int nig = WGM * nN, gid = wgid / nig, fm = gid * WGM, gsz = (nM - fm) < WGM ? (nM - fm) : WGM;
        u.pm = fm + ((wgid % nig) % gsz); u.pn = (wgid % nig) / gsz; return true;
    }
    __device__ __forceinline__ void a_ready(const Unit&) const {}
    __device__ __forceinline__ void done(const Unit&) const {}
};

template <class Epi, class Sched, bool ALIGN_EPI = false, bool SP2 = false>
__device__ __forceinline__ void gemm_phase(PG8_LAS unsigned char* lds, const Gemm g, const Sched& S, const Epi& E, const int tid, const int sb = -100) {
    const int wid = __builtin_amdgcn_readfirstlane(tid >> 6), lane = tid & 63, wr = wid >> 2, wc = wid & 3, fr = lane & 15, fq = lane >> 4;
    const int K = g.K, nt = K / BK;
    unsigned voffA[2], voffB[2];
#pragma unroll
    for (int i = 0; i < 2; ++i) { int R, C; stage_rc(tid * 16 + i * 8192, R, C); const int Rb = Epi::PERM ? ((R & ~31) + perm32(R & 31)) : R;
        voffA[i] = (unsigned)(R * K + C) * 2u; voffB[i] = (unsigned)(Rb * K + C) * 2u; }
    const size_t kstep = (size_t)(BK * 2);
    const size_t hstep = (size_t)HALF * K * 2;
    const size_t tstep = 2 * hstep;
    const unsigned ldsw = (unsigned)wid * 1024u;
    const int aoff = lds_byte(wr * 64 + fr, fq * 8), boff = lds_byte(wc * 32 + fr, fq * 8);
#define PG8_SA(b, h) (((b) * 2 + (h)) * HTB)
#define PG8_SB(b, h) ((4 + (b) * 2 + (h)) * HTB)
#define PG8_STAGE(bufoff, gbase, voff) do { _Pragma("unroll") for (int _i = 0; _i < 2; ++_i) \
        __builtin_amdgcn_global_load_lds((const unsigned*)((const char*)(gbase) + (voff)[_i]), (PG8_LAS unsigned*)(lds + (bufoff) + ldsw + _i * 8192), 16, 0, 0); } while (0)
#define PG8_LDA(dst, b, h) do { _Pragma("unroll") for (int m = 0; m < 4; ++m) _Pragma("unroll") for (int k = 0; k < 2; ++k) dst[m][k] = *(const PG8_LAS bf16x8*)(lds + PG8_SA(b, h) + aoff + m * 2048 + k * 1024); } while (0)
#define PG8_LDB(dst, b, h) do { _Pragma("unroll") for (int n = 0; n < 2; ++n) _Pragma("unroll") for (int k = 0; k < 2; ++k) dst[n][k] = *(const PG8_LAS bf16x8*)(lds + PG8_SB(b, h) + boff + n * 2048 + k * 1024); } while (0)
#define PG8_MMA(ai, bj, At, Bt) do { __builtin_amdgcn_s_setprio(1); _Pragma("unroll") for (int m = 0; m < 4; ++m) _Pragma("unroll") for (int n = 0; n < 2; ++n) _Pragma("unroll") for (int k = 0; k < 2; ++k) \
        acc[ai][bj][m][n] = __builtin_amdgcn_mfma_f32_16x16x32_bf16(Bt[n][k], At[m][k], acc[ai][bj][m][n], 0, 0, 0); __builtin_amdgcn_s_setprio(0); } while (0)
#define PG8_WAIT_V(n) asm volatile("s_waitcnt vmcnt(" #n ")" ::: "memory")
#define PG8_WAIT_L(n) asm volatile("s_waitcnt lgkmcnt(" #n ")" ::: "memory")
#define PG8_BAR __builtin_amdgcn_s_barrier()
#define PG8_SCHED __builtin_amdgcn_sched_barrier(0)
    Unit cur, nxt; int ui = 0;
    if (!S.next(0, cur)) return;
    f32x4 acc[2][2][4][2];
#pragma unroll
    for (int a = 0; a < 2; ++a)
#pragma unroll
        for (int b = 0; b < 2; ++b)
#pragma unroll
            for (int m = 0; m < 4; ++m)
#pragma unroll
                for (int n = 0; n < 2; ++n) acc[a][b][m][n] = (f32x4){0.f, 0.f, 0.f, 0.f};
    bf16x8 At[4][2], B0[2][2], B1[2][2];
    const char* cA = (const char*)g.A + (size_t)cur.pm * tstep; const char* cB = (const char*)g.Bt + (size_t)cur.pn * tstep;
    S.a_ready(cur);
    if constexpr (SP2) {
        PG8_STAGE(PG8_SB(0, 0), cB, voffB); PG8_STAGE(PG8_SB(0, 1), cB + hstep, voffB); PG8_STAGE(PG8_SA(0, 0), cA, voffA); PG8_STAGE(PG8_SA(0, 1), cA + hstep, voffA);
        if (wr == 1) PG8_BAR;
        PG8_WAIT_V(2); PG8_BAR;
        PG8_STAGE(PG8_SB(1, 0), cB + kstep, voffB); PG8_STAGE(PG8_SA(1, 0), cA + kstep, voffA); PG8_STAGE(PG8_SB(1, 1), cB + hstep + kstep, voffB);
        PG8_WAIT_V(6); PG8_BAR;
    } else {
        PG8_STAGE(PG8_SB(0, 0), cB, voffB); PG8_STAGE(PG8_SA(0, 0), cA, voffA); PG8_STAGE(PG8_SB(0, 1), cB + hstep, voffB); PG8_STAGE(PG8_SA(0, 1), cA + hstep, voffA);
        if (wr == 1) PG8_BAR;
        PG8_WAIT_V(4); PG8_BAR;
        PG8_STAGE(PG8_SB(1, 0), cB + kstep, voffB); PG8_STAGE(PG8_SA(1, 0), cA + kstep, voffA); PG8_STAGE(PG8_SB(1, 1), cB + hstep + kstep, voffB);
        PG8_WAIT_V(6); PG8_BAR;
    }
    MK_STAMP(lds, sb + 0);
    for (;;) {
        const bool has_next = S.next(ui + 1, nxt);
        const char* nA = has_next ? (const char*)g.A + (size_t)nxt.pm * tstep : cA; const char* nB = has_next ? (const char*)g.Bt + (size_t)nxt.pn * tstep : cB;
        for (int t = 0; t < nt; t += 2) {
            const bool last = (t == nt - 2);
            const char* a1 = cA + (size_t)(t + 1) * kstep;
            const char* a2 = last ? nA : cA + (size_t)(t + 2) * kstep; const char* b2 = last ? nB : cB + (size_t)(t + 2) * kstep;
            const char* a3 = a2 + kstep; const char* b3 = b2 + kstep;
            if (last && has_next) S.a_ready(nxt);
            if constexpr (SP2) {
            PG8_LDB(B0, 0, 0); PG8_LDB(B1, 0, 1); PG8_SCHED; PG8_LDA(At, 0, 0); PG8_STAGE(PG8_SA(1, 1), a1 + hstep, voffA);
            PG8_WAIT_V(8); PG8_WAIT_L(0); PG8_BAR; PG8_MMA(0, 0, At, B0); PG8_MMA(0, 1, At, B1); PG8_BAR; PG8_SCHED;
            PG8_LDA(At, 0, 1); PG8_STAGE(PG8_SB(0, 0), b2, voffB); PG8_STAGE(PG8_SB(0, 1), b2 + hstep, voffB); PG8_STAGE(PG8_SA(0, 0), a2, voffA);
            PG8_WAIT_V(8); PG8_WAIT_L(0); PG8_BAR; PG8_MMA(1, 0, At, B0); PG8_MMA(1, 1, At, B1); PG8_BAR; PG8_SCHED;
            PG8_LDB(B0, 1, 0); PG8_LDB(B1, 1, 1); PG8_SCHED; PG8_LDA(At, 1, 0); PG8_STAGE(PG8_SA(0, 1), a2 + hstep, voffA);
            PG8_WAIT_V(8); PG8_WAIT_L(0); PG8_BAR; PG8_MMA(0, 0, At, B0); PG8_MMA(0, 1, At, B1); PG8_BAR; PG8_SCHED;
            PG8_LDA(At, 1, 1); PG8_STAGE(PG8_SB(1, 0), b3, voffB); PG8_STAGE(PG8_SB(1, 1), b3 + hstep, voffB); PG8_STAGE(PG8_SA(1, 0), a3, voffA);
            PG8_WAIT_V(8); PG8_WAIT_L(0); PG8_BAR; PG8_MMA(1, 0, At, B0); PG8_MMA(1, 1, At, B1); PG8_BAR; PG8_SCHED;
            } else {
            PG8_LDB(B0, 0, 0); PG8_SCHED; PG8_LDA(At, 0, 0); PG8_STAGE(PG8_SA(1, 1), a1 + hstep, voffA);
            PG8_WAIT_L(8); PG8_BAR; PG8_WAIT_L(0); PG8_MMA(0, 0, At, B0); PG8_BAR; PG8_SCHED;
            PG8_LDB(B1, 0, 1); PG8_STAGE(PG8_SB(0, 0), b2, voffB);
            PG8_BAR; PG8_WAIT_L(0); PG8_MMA(0, 1, At, B1); PG8_BAR;
            PG8_LDA(At, 0, 1); PG8_STAGE(PG8_SA(0, 0), a2, voffA);
            PG8_BAR; PG8_WAIT_L(0); PG8_MMA(1, 0, At, B0); PG8_BAR; PG8_SCHED;
            PG8_STAGE(PG8_SB(0, 1), b2 + hstep, voffB);
            PG8_WAIT_V(6); PG8_BAR; PG8_MMA(1, 1, At, B1); PG8_BAR;
            PG8_LDB(B0, 1, 0); PG8_SCHED; PG8_LDA(At, 1, 0); PG8_STAGE(PG8_SA(0, 1), a2 + hstep, voffA);
            PG8_WAIT_L(8); PG8_BAR; PG8_WAIT_L(0); PG8_MMA(0, 0, At, B0); PG8_BAR; PG8_SCHED;
            PG8_LDB(B1, 1, 1); PG8_STAGE(PG8_SB(1, 0), b3, voffB);
            PG8_BAR; PG8_WAIT_L(0); PG8_MMA(0, 1, At, B1); PG8_BAR;
            PG8_LDA(At, 1, 1); PG8_STAGE(PG8_SA(1, 0), a3, voffA);
            PG8_BAR; PG8_WAIT_L(0); PG8_MMA(1, 0, At, B0); PG8_BAR; PG8_SCHED;
            PG8_STAGE(PG8_SB(1, 1), b3 + hstep, voffB);
            PG8_WAIT_V(6); PG8_BAR; PG8_MMA(1, 1, At, B1); PG8_BAR;
            }
        }
        if constexpr (ALIGN_EPI) { if (wr == 0) PG8_BAR; }
        if (ui == 0) MK_STAMP(lds, sb + 1);
        E(acc, cur, ui, wr, wc, fr, fq); S.done(cur);
        if (ui == 0) MK_STAMP(lds, sb + 2);
        if (!has_next) break;
#pragma unroll
        for (int a = 0; a < 2; ++a)
#pragma unroll
            for (int b = 0; b < 2; ++b)
#pragma unroll
                for (int m = 0; m < 4; ++m)
#pragma unroll
                    for (int n = 0; n < 2; ++n) acc[a][b][m][n] = (f32x4){0.f, 0.f, 0.f, 0.f};
        cur = nxt; cA = nA; cB = nB; ++ui;
        if constexpr (ALIGN_EPI) { if (wr == 1) PG8_BAR; }
    }
    MK_STAMP(lds, sb + 3);
    PG8_WAIT_V(0);
    if constexpr (!ALIGN_EPI) { if (wr == 0) PG8_BAR; }
    PG8_BAR;
    MK_STAMP(lds, sb + 4);
#undef PG8_SA
#undef PG8_SB
#undef PG8_STAGE
#undef PG8_LDA
#undef PG8_LDB
#undef PG8_MMA
#undef PG8_WAIT_V
#undef PG8_WAIT_L
#undef PG8_BAR
#undef PG8_SCHED
}
}

constexpr int NWAVES = 8;
constexpr int BATCH = 2, T = 4096, D = 2048, M = BATCH * T;
constexpr int HRET = 8, HKV = 2, FF = 5632;
constexpr int NPB = 5632;
constexpr int NIDXP = 1280;
constexpr int NIN = 6736, NINP = 6912;
constexpr int C_RQ = 0, C_RK = 1024, C_RV = 2048, C_RG = 3072, C_AQ = 4096, C_AK = 5120, C_AV = 5376;
constexpr float NORM_EPS = 1e-6f;

constexpr size_t MiB = 1u << 20;
constexpr size_t WS_CTL = 0, CTL_ZERO_BYTES = 65536;
constexpr size_t WS_TAB = 1 * MiB;
constexpr size_t WS_WGU = 5 * MiB;
constexpr size_t WS_WD = 49 * MiB;
constexpr size_t WS_WIN = 71 * MiB;
constexpr size_t WS_WOUT = 98 * MiB;
constexpr size_t WS_A = 106 * MiB;
constexpr size_t WS_PROJ = 138 * MiB;
constexpr size_t WS_PIDX = 226 * MiB;
constexpr size_t WS_RKT = 266 * MiB;
constexpr size_t WS_RVT = 282 * MiB;
constexpr size_t WS_AVT = 298 * MiB;
constexpr size_t WS_IQ = 302 * MiB;
constexpr size_t WS_IK = 318 * MiB;
constexpr size_t WS_IW = 319 * MiB;
constexpr size_t WS_KV = 320 * MiB;
constexpr size_t WS_ST = 352 * MiB;
constexpr size_t WS_MASK = 368 * MiB;
constexpr size_t WS_SSQ = 372 * MiB;
constexpr size_t WS_TAB2 = 373 * MiB;
constexpr size_t WS_END = 375 * MiB;
constexpr int CW_BAR = 4096;

constexpr int RING_BYTES = 131072;
constexpr int LDS_BYTES = 147456;
constexpr int LDSCTL_OFF = LDS_BYTES - 512, MISC_OFF = LDSCTL_OFF + 320;

#define GAS __attribute__((address_space(1)))
#define LAS __attribute__((address_space(3)))
typedef unsigned short bf16;
typedef _Float16 f16;
typedef _Float16 half8 __attribute__((ext_vector_type(8)));
typedef unsigned v4u __attribute__((ext_vector_type(4)));
typedef unsigned v2u __attribute__((ext_vector_type(2)));
typedef float f32x2 __attribute__((ext_vector_type(2)));
typedef float f32x4 __attribute__((ext_vector_type(4)));
typedef float f32x16 __attribute__((ext_vector_type(16)));
typedef short bf16x8 __attribute__((ext_vector_type(8)));
typedef __bf16 bf16x2_t __attribute__((ext_vector_type(2)));
typedef GAS unsigned gu32;
#define LDS_WAIT() asm volatile("s_waitcnt lgkmcnt(0)" ::: "memory")
__device__ __forceinline__ unsigned pk2(float lo, float hi) { f32x2 v = {lo, hi}; bf16x2_t b = __builtin_convertvector(v, bf16x2_t); return __builtin_bit_cast(unsigned, b); }
__device__ __forceinline__ float bflo(unsigned w) { return __uint_as_float(w << 16); }
__device__ __forceinline__ float bfhi(unsigned w) { return __uint_as_float(w & 0xffff0000u); }
__device__ __forceinline__ float silu_f(float g) { return g * __builtin_amdgcn_rcpf(1.f + __builtin_amdgcn_exp2f(-1.4426950408889634f * g)); }

#define XB_TMO      128
#define XB_XCNT(j)  (256  + 64 * (j))
#define XB_XSUB(j)  (1280 + 64 * (j))
#define XB_XGEN(j)  (2304 + 64 * (j))
#define XB_TOP      3328
#define XB_TOPGEN   3392
#define XCD_BAR_WORDS 3456
#define XB_SPIN_CAP (1u << 22)
__device__ __forceinline__ unsigned xb_ld(unsigned* p)              { return __hip_atomic_load(p, __ATOMIC_RELAXED, __HIP_MEMORY_SCOPE_AGENT); }
__device__ __forceinline__ unsigned xb_add(unsigned* p, unsigned v) { return __hip_atomic_fetch_add(p, v, __ATOMIC_RELAXED, __HIP_MEMORY_SCOPE_AGENT); }
__device__ __forceinline__ unsigned xb_xcc_id() { return (unsigned)__builtin_amdgcn_s_getreg((3 << 11) | 20) & 0xFu; }
#define XB_SPIN(cond, bar) do { unsigned _sp = 0; while (cond) { __builtin_amdgcn_s_sleep(1); \
    if ((++_sp & 255u) == 0u) { if (xb_ld(&(bar)[XB_TMO])) break; if (_sp > XB_SPIN_CAP) { atomicAdd(&(bar)[XB_TMO], 1u); break; } } } } while (0)
struct XcdBarrier { unsigned* bar; unsigned x; volatile LAS unsigned* st; };
__device__ __forceinline__ XcdBarrier xcd_barrier_post(unsigned* bar, volatile LAS unsigned* st) {
    XcdBarrier b; b.bar = bar; b.x = xb_xcc_id(); b.st = st;
    if (threadIdx.x == 0) (void)xb_add(&bar[XB_XCNT(b.x)], 1u);
    return b;
}
__device__ __forceinline__ void xcd_barrier_complete(unsigned* bar, unsigned x, unsigned& nloc, unsigned& nx) {
    const unsigned G = gridDim.x * gridDim.y * gridDim.z;
    unsigned sum, cnt, mine, sp = 0u;
    for (;;) {
        sum = 0u; cnt = 0u; mine = 0u;
#pragma unroll
        for (unsigned j = 0; j < 16; ++j) { const unsigned c = xb_ld(&bar[XB_XCNT(j)]); sum += c; cnt += (c > 0u) ? 1u : 0u; mine = (j == x) ? c : mine; }
        if (sum == G) break;
        __builtin_amdgcn_s_sleep(1);
        if ((++sp & 255u) == 0u) { if (xb_ld(&bar[XB_TMO])) break; if (sp > XB_SPIN_CAP) { atomicAdd(&bar[XB_TMO], 1u); break; } }
    }
    nloc = mine > 0u ? mine : 1u; nx = cnt > 0u ? cnt : 1u;
}
__device__ __forceinline__ void xcd_barrier(const XcdBarrier& b) {
    asm volatile("s_waitcnt vmcnt(0)" ::: "memory");
    __syncthreads();
    if (threadIdx.x == 0) {
        unsigned* bar = b.bar;
        __builtin_amdgcn_s_waitcnt(0);
        unsigned nloc = b.st[0], nx = b.st[1];
        if (nloc == 0u) { xcd_barrier_complete(bar, b.x, nloc, nx); b.st[0] = nloc; b.st[1] = nx; }
        const unsigned old = xb_add(&bar[XB_XSUB(b.x)], 1u);
        const unsigned gen = old / nloc;
        if (old + 1u == (gen + 1u) * nloc) {
            __builtin_amdgcn_fence(__ATOMIC_RELEASE, "agent");
            asm volatile("s_waitcnt vmcnt(0)" ::: "memory");
            const unsigned og = xb_add(&bar[XB_TOP], 1u);
            const unsigned tg = og / nx;
            if (og + 1u == (tg + 1u) * nx) xb_add(&bar[XB_TOPGEN], 1u);
            else XB_SPIN(xb_ld(&bar[XB_TOPGEN]) == tg, bar);
            __builtin_amdgcn_fence(__ATOMIC_ACQUIRE, "agent");
            xb_add(&bar[XB_XGEN(b.x)], 1u);
            asm volatile("s_waitcnt vmcnt(0)" ::: "memory");
        } else {
            XB_SPIN(xb_ld(&bar[XB_XGEN(b.x)]) == gen, bar);
            __builtin_amdgcn_fence(__ATOMIC_ACQUIRE, "agent");
            asm volatile("s_waitcnt vmcnt(0)" ::: "memory");
        }
    }
    __syncthreads();
}

struct Frame {
    LAS unsigned char* lds;
    int tid, lane, wave;
    int bid, G;
    const float* x; const int* pos;
    const float *n1, *wg1, *wu1, *wd1, *nmix, *win, *nret, *wout, *n2, *wg2, *wu2, *wd2, *nfin;
    float* X;
    unsigned char* ws;
};

__device__ __forceinline__ float wave_sum(float v) {
#pragma unroll
    for (int o = 1; o < 64; o <<= 1) v += __shfl_xor(v, o);
    return v;
}

__device__ __forceinline__ float xor16_sum(float m);
__device__ __forceinline__ float xor32_sum(float m);
constexpr int RS_OFF = RING_BYTES, RS_MAXU = 6;
__device__ __forceinline__ void load_rstd_panels(Frame& F, const pg8::StaticOrder& S, const float* ssq) {
    LAS float* rs = (LAS float*)(F.lds + RS_OFF);
    const int r = F.tid >> 1, hf = F.tid & 1;
    f32x4 p[RS_MAXU][4]; bool ok[RS_MAXU];
#pragma unroll
    for (int i = 0; i < RS_MAXU; ++i) { pg8::Unit u; ok[i] = S.next(i, u);
        if (ok[i]) { const f32x4* q = (const f32x4*)(ssq + (size_t)(u.pm * 256 + r) * 32 + 16 * hf);
#pragma unroll
            for (int k = 0; k < 4; ++k) p[i][k] = q[k]; } }
#pragma unroll
    for (int i = 0; i < RS_MAXU; ++i) if (ok[i]) {
        const f32x4 s4 = (p[i][0] + p[i][1]) + (p[i][2] + p[i][3]);
        float s = (s4.x + s4.y) + (s4.z + s4.w);
        s += __shfl_xor(s, 1);
        if (hf == 0) rs[i * 256 + r] = 1.0f / sqrtf(s * (1.f / D) + NORM_EPS);
    }
    __syncthreads();
}
struct EpiSwiGLU {
    static constexpr bool PERM = true;
    bf16* H; const LAS float* rs;
    __device__ __forceinline__ void operator()(const f32x4 (&acc)[2][2][4][2], const pg8::Unit& u, int ui, int wr, int wc, int fr, int fq) const {
        const int row0 = u.pm * 256 + wr * 64 + fr, col0 = u.pn * 128 + wc * 32 + 8 * fq;
#pragma unroll
        for (int ai = 0; ai < 2; ++ai)
#pragma unroll
            for (int m = 0; m < 4; ++m) {
                const int row = row0 + ai * 128 + m * 16;
                const float r = rs[ui * 256 + ai * 128 + wr * 64 + m * 16 + fr];
                bf16* rowp = H + (size_t)row * FF + col0;
                const f32x4 g0 = acc[ai][0][m][0] * r, g1 = acc[ai][0][m][1] * r, u0 = acc[ai][1][m][0] * r, u1 = acc[ai][1][m][1] * r;
                v4u w;
                w.x = pk2(silu_f(g0[0]) * u0[0], silu_f(g0[1]) * u0[1]); w.y = pk2(silu_f(g0[2]) * u0[2], silu_f(g0[3]) * u0[3]);
                w.z = pk2(silu_f(g1[0]) * u1[0], silu_f(g1[1]) * u1[1]); w.w = pk2(silu_f(g1[2]) * u1[2], silu_f(g1[3]) * u1[3]);
                *(v4u*)rowp = w;
            }
    }
};
template <bool BASEF> struct EpiResid {
    static constexpr bool PERM = true;
    const float* basef; bf16* Ab; float alpha; float* ssq;
    __device__ __forceinline__ void operator()(const f32x4 (&acc)[2][2][4][2], const pg8::Unit& u, int ui, int wr, int wc, int fr, int fq) const {
        const int row0 = u.pm * 256 + wr * 64 + fr, col0 = u.pn * 256 + wc * 32 + 8 * fq;
#pragma unroll
        for (int ai = 0; ai < 2; ++ai) {
            f32x4 bf0[4][2], bf1[4][2]; v4u bw[4][2];
#pragma unroll
            for (int m = 0; m < 4; ++m)
#pragma unroll
                for (int bj = 0; bj < 2; ++bj) {
                    const size_t off = (size_t)(row0 + ai * 128 + m * 16) * D + col0 + bj * 128;
                    if constexpr (BASEF) { bf0[m][bj] = __builtin_nontemporal_load((const f32x4*)(basef + off)); bf1[m][bj] = __builtin_nontemporal_load((const f32x4*)(basef + off + 4)); }
                    else bw[m][bj] = *(const v4u*)(Ab + off);
                }
            asm volatile("" ::: "memory");
#pragma unroll
            for (int m = 0; m < 4; ++m) {
                const int row = row0 + ai * 128 + m * 16;
                float sq = 0.f;
#pragma unroll
                for (int bj = 0; bj < 2; ++bj) {
                    const size_t off = (size_t)row * D + col0 + bj * 128;
                    f32x4 b0, b1;
                    if constexpr (BASEF) { b0 = bf0[m][bj]; b1 = bf1[m][bj]; }
                    else { const v4u w = bw[m][bj]; b0 = (f32x4){bflo(w.x), bfhi(w.x), bflo(w.y), bfhi(w.y)}; b1 = (f32x4){bflo(w.z), bfhi(w.z), bflo(w.w), bfhi(w.w)}; }
                    const f32x4 v0 = b0 + acc[ai][bj][m][0] * alpha, v1 = b1 + acc[ai][bj][m][1] * alpha;
                    sq += (v0.x * v0.x + v0.y * v0.y) + (v0.z * v0.z + v0.w * v0.w) + (v1.x * v1.x + v1.y * v1.y) + (v1.z * v1.z + v1.w * v1.w);
                    v4u w; w.x = pk2(v0.x, v0.y); w.y = pk2(v0.z, v0.w); w.z = pk2(v1.x, v1.y); w.w = pk2(v1.z, v1.w);
                    *(v4u*)(Ab + off) = w;
                }
                sq = xor16_sum(sq); sq = xor32_sum(sq);
                if (fq == 0) ssq[(size_t)row * 32 + u.pn * 4 + wc] = sq;
            }
        }
    }
};
__device__ __forceinline__ float lg2_gamma(int h);
typedef _Float16 half4 __attribute__((ext_vector_type(4)));
struct EpiProj {
    static constexpr bool PERM = true;
    unsigned char* ws; const LAS float* rs;
    __device__ __forceinline__ void operator()(const f32x4 (&acc)[2][2][4][2], const pg8::Unit& u, int ui, int wr, int wc, int fr, int fq) const {
        const int row0 = u.pm * 256 + wr * 64 + fr, t = u.pn;
        bf16* PROJ = (bf16*)(ws + WS_PROJ);
        if (t < 8 || (t >= 16 && t <= 20)) {
            const int typ = t < 4 ? 0 : t < 8 ? 1 : t < 20 ? 2 : 3;
            const int tb = typ == 0 ? 0 : typ == 1 ? 4 : typ == 2 ? 16 : 20, cb = typ == 0 ? C_RQ : typ == 1 ? C_RK : typ == 2 ? C_AQ : C_AK;
            const int hd = 2 * (t - tb) + (wc >> 1), i0 = 32 * (wc & 1) + 8 * fq;
            const float lg = lg2_gamma(hd);
            const float2* TAB = (const float2*)(ws + WS_TAB);
#pragma unroll
            for (int ai = 0; ai < 2; ++ai) {
#pragma unroll
              for (int mp = 0; mp < 2; ++mp) {
                f32x4 cst[2][4];
#pragma unroll
                for (int mm = 0; mm < 2; ++mm) { const f32x4* tp = (const f32x4*)(TAB + (size_t)(row0 + ai * 128 + (2 * mp + mm) * 16) * 64 + i0);
#pragma unroll
                    for (int k = 0; k < 4; ++k) cst[mm][k] = tp[k]; }
                asm volatile("" ::: "memory");
#pragma unroll
                for (int mm = 0; mm < 2; ++mm) {
                    const int m = 2 * mp + mm;
                    const int row = row0 + ai * 128 + m * 16;
                    const float r = rs[ui * 256 + ai * 128 + wr * 64 + m * 16 + fr];
                    const f32x4 c01 = cst[mm][0], c23 = cst[mm][1], c45 = cst[mm][2], c67 = cst[mm][3];
                    const float pcf = (float)((row & 127) + 1);
                    const float sc = r * (typ == 0 ? __builtin_amdgcn_exp2f(lg * pcf) : typ == 1 ? 0.08838834764831845f * __builtin_amdgcn_exp2f(-lg * pcf) : typ == 2 ? 0.08838834764831845f * 1.4426950408889634f : 1.f);
                    const f32x4 a0 = acc[ai][0][m][0], a1 = acc[ai][0][m][1], b0 = acc[ai][1][m][0], b1 = acc[ai][1][m][1];
                    v4u o1, o2;
                    o1.x = pk2((a0.x * c01.x - b0.x * c01.y) * sc, (a0.y * c01.z - b0.y * c01.w) * sc); o1.y = pk2((a0.z * c23.x - b0.z * c23.y) * sc, (a0.w * c23.z - b0.w * c23.w) * sc);
                    o1.z = pk2((a1.x * c45.x - b1.x * c45.y) * sc, (a1.y * c45.z - b1.y * c45.w) * sc); o1.w = pk2((a1.z * c67.x - b1.z * c67.y) * sc, (a1.w * c67.z - b1.w * c67.w) * sc);
                    o2.x = pk2((b0.x * c01.x + a0.x * c01.y) * sc, (b0.y * c01.z + a0.y * c01.w) * sc); o2.y = pk2((b0.z * c23.x + a0.z * c23.y) * sc, (b0.w * c23.z + a0.w * c23.w) * sc);
                    o2.z = pk2((b1.x * c45.x + a1.x * c45.y) * sc, (b1.y * c45.z + a1.y * c45.w) * sc); o2.w = pk2((b1.z * c67.x + a1.z * c67.y) * sc, (b1.w * c67.z + a1.w * c67.w) * sc);
                    bf16* rowp = PROJ + (size_t)row * NPB + cb + hd * 128 + i0;
                    *(v4u*)rowp = o1; *(v4u*)(rowp + 64) = o2;
                }
              }
            }
        } else if (t < 22) {
            const bool gate = (t >= 12 && t < 16);
            const int col0 = t * 256 + wc * 32 + 8 * fq;
#pragma unroll
            for (int ai = 0; ai < 2; ++ai)
#pragma unroll
                for (int m = 0; m < 4; ++m) {
                    const int row = row0 + ai * 128 + m * 16;
                    const float r = rs[ui * 256 + ai * 128 + wr * 64 + m * 16 + fr];
                    bf16* rowp = PROJ + (size_t)row * NPB + col0;
#pragma unroll
                    for (int bj = 0; bj < 2; ++bj) {
                        f32x4 v0 = acc[ai][bj][m][0] * r, v1 = acc[ai][bj][m][1] * r;
                        if (gate) { v0 = (f32x4){silu_f(v0.x), silu_f(v0.y), silu_f(v0.z), silu_f(v0.w)}; v1 = (f32x4){silu_f(v1.x), silu_f(v1.y), silu_f(v1.z), silu_f(v1.w)}; }
                        v4u w; w.x = pk2(v0[0], v0[1]); w.y = pk2(v0[2], v0[3]); w.z = pk2(v1[0], v1[1]); w.w = pk2(v1[2], v1[3]);
                        *(v4u*)(rowp + bj * 128) = w;
                    }
                }
        } else if (t < 26 || wc == 0) {
            const bool isq = t < 26;
            const int hd = 4 * (t - 22) + wc, i0 = 8 * fq;
            const float2* TAB2 = (const float2*)(ws + WS_TAB2);
            f16* OUT = isq ? (f16*)(ws + WS_IQ) : (f16*)(ws + WS_IK);
            const int ld = isq ? 1024 : 64, cb = isq ? hd * 64 : 0;
            const float s8 = isq ? 0.125f : 1.f;
#pragma unroll
            for (int ai = 0; ai < 2; ++ai) {
#pragma unroll
              for (int mp = 0; mp < 2; ++mp) {
                f32x4 cst[2][4];
#pragma unroll
                for (int mm = 0; mm < 2; ++mm) { const f32x4* tp = (const f32x4*)(TAB2 + (size_t)(row0 + ai * 128 + (2 * mp + mm) * 16) * 32 + i0);
#pragma unroll
                    for (int k = 0; k < 4; ++k) cst[mm][k] = tp[k]; }
                asm volatile("" ::: "memory");
#pragma unroll
                for (int mm = 0; mm < 2; ++mm) {
                    const int m = 2 * mp + mm;
                    const int row = row0 + ai * 128 + m * 16;
                    const float sc = rs[ui * 256 + ai * 128 + wr * 64 + m * 16 + fr] * s8;
                    const f32x4 c01 = cst[mm][0], c23 = cst[mm][1], c45 = cst[mm][2], c67 = cst[mm][3];
                    const f32x4 a0 = acc[ai][0][m][0], a1 = acc[ai][0][m][1], b0 = acc[ai][1][m][0], b1 = acc[ai][1][m][1];
                    half8 h1, h2;
                    h1[0] = (f16)((a0.x * c01.x - b0.x * c01.y) * sc); h1[1] = (f16)((a0.y * c01.z - b0.y * c01.w) * sc); h1[2] = (f16)((a0.z * c23.x - b0.z * c23.y) * sc); h1[3] = (f16)((a0.w * c23.z - b0.w * c23.w) * sc);
                    h1[4] = (f16)((a1.x * c45.x - b1.x * c45.y) * sc); h1[5] = (f16)((a1.y * c45.z - b1.y * c45.w) * sc); h1[6] = (f16)((a1.z * c67.x - b1.z * c67.y) * sc); h1[7] = (f16)((a1.w * c67.z - b1.w * c67.w) * sc);
                    h2[0] = (f16)((b0.x * c01.x + a0.x * c01.y) * sc); h2[1] = (f16)((b0.y * c01.z + a0.y * c01.w) * sc); h2[2] = (f16)((b0.z * c23.x + a0.z * c23.y) * sc); h2[3] = (f16)((b0.w * c23.z + a0.w * c23.w) * sc);
                    h2[4] = (f16)((b1.x * c45.x + a1.x * c45.y) * sc); h2[5] = (f16)((b1.y * c45.z + a1.y * c45.w) * sc); h2[6] = (f16)((b1.z * c67.x + a1.z * c67.y) * sc); h2[7] = (f16)((b1.w * c67.z + a1.w * c67.w) * sc);
                    f16* rowp = OUT + (size_t)row * ld + cb + i0;
                    *(half8*)rowp = h1; *(half8*)(rowp + 32) = h2;
                }
              }
            }
        } else if (wc == 1 && fq < 2) {
#pragma unroll
            for (int ai = 0; ai < 2; ++ai)
#pragma unroll
                for (int m = 0; m < 4; ++m) {
                    const int row = row0 + ai * 128 + m * 16;
                    const float sc = rs[ui * 256 + ai * 128 + wr * 64 + m * 16 + fr] * 0.25f;
                    float* rowp = (float*)(ws + WS_IW) + (size_t)row * 16 + 8 * fq;
                    *(f32x4*)rowp = acc[ai][0][m][0] * sc; *(f32x4*)(rowp + 4) = acc[ai][0][m][1] * sc;
                }
        }
    }
};

__device__ __forceinline__ int win_row(int n) {
    if (n < 2048 || (n >= 4096 && n < 5376)) { const int base = n < 1024 ? 0 : n < 2048 ? 1024 : n < 5120 ? 4096 : 5120; const int rel = n - base, head = rel >> 7, half = (rel >> 6) & 1, i = rel & 63;
        return base + 256 * (head >> 1) + 128 * half + 64 * (head & 1) + i; }
    if (n < 5632) return n;
    if (n < 6656) { const int rel = n - 5632, head = rel >> 6, half = (rel >> 5) & 1, i = rel & 31; return 5632 + 256 * (head >> 2) + 128 * half + 32 * (head & 3) + i; }
    if (n < 6720) { const int rel = n - 6656; return 6656 + 128 * (rel >> 5) + (rel & 31); }
    return 6656 + 32 + (n - 6720);
}
struct CvItem { const float* W; const float* g; bf16* WT; int K, N, k0, n0, gu, up; };
constexpr int CV_G = (D / 64) * (FF / 256), CV_D = (FF / 64) * (D / 256), CV_I = (D / 64) * ((NIN + 255) / 256), CV_O = (D / 64) * (D / 256);
constexpr int CV_TILE = 64 * 257 * 4;
template <int JOB> __device__ __forceinline__ constexpr int cv_total() { return JOB == 0 ? 2 * CV_G : JOB == 1 ? CV_D + CV_I : JOB == 2 ? 2 * CV_G + CV_O : CV_D; }
template <int JOB> __device__ __forceinline__ void cv_decode(const Frame& F, int it, CvItem& x) {
    x.gu = 0; x.up = 0; x.g = nullptr;
    if (JOB == 0 || JOB == 2) {
        const float* wg = JOB == 0 ? F.wg1 : F.wg2; const float* wu = JOB == 0 ? F.wu1 : F.wu2;
        if (it < 2 * CV_G) { const int up = it >= CV_G, r = up ? it - CV_G : it, kb = r / (FF / 256), nb = r % (FF / 256);
            x.W = up ? wu : wg; x.g = JOB == 0 ? F.n1 : F.n2; x.WT = ((bf16*)(F.ws + WS_WGU)); x.K = D; x.N = FF; x.k0 = 64 * kb; x.n0 = 256 * nb; x.gu = 1; x.up = up; return; }
        it -= 2 * CV_G;
        { const int kb = it / (D / 256), nb = it % (D / 256); x.W = F.wout; x.WT = ((bf16*)(F.ws + WS_WOUT)); x.K = D; x.N = D; x.k0 = 64 * kb; x.n0 = 256 * nb; }
    } else {
        if (it < CV_D) { const int kb = it / (D / 256), nb = it % (D / 256); x.W = JOB == 1 ? F.wd1 : F.wd2; x.WT = ((bf16*)(F.ws + WS_WD)); x.K = FF; x.N = D; x.k0 = 64 * kb; x.n0 = 256 * nb; return; }
        it -= CV_D;
        constexpr int NBI = (NIN + 255) / 256;
        { const int kb = it / NBI, nb = it % NBI; x.W = F.win; x.g = F.nmix; x.WT = ((bf16*)(F.ws + WS_WIN)); x.K = D; x.N = NIN; x.k0 = 64 * kb; x.n0 = 256 * nb; x.gu = 2; }
    }
}
__device__ __forceinline__ void cv_load(const CvItem& x, f32x4 (&v)[8], int wave, int lane) {
    const bool okc = (x.n0 + 4 * lane) < x.N;
    const float* p = x.W + (size_t)(x.k0 + 8 * wave) * x.N + x.n0 + 4 * lane;
#pragma unroll
    for (int i = 0; i < 8; ++i) v[i] = okc ? __builtin_nontemporal_load((const f32x4*)(p + (size_t)i * x.N)) : (f32x4){0.f, 0.f, 0.f, 0.f};
}
__device__ __forceinline__ void cv_gain(const CvItem& x, f32x4 (&gq)[2], int wave) {
    if (x.g) { const f32x4* q = (const f32x4*)(x.g + x.k0 + 8 * wave); gq[0] = q[0]; gq[1] = q[1]; }
    else { gq[0] = (f32x4){1.f, 1.f, 1.f, 1.f}; gq[1] = gq[0]; }
}
template <int JOB> __device__ __forceinline__ void convert_job(Frame& F, int w, int nw) {
    const int lane = F.lane, wave = F.wave, c = lane & 7, nn = lane >> 3;
    constexpr int total = cv_total<JOB>();
    CvItem x0, x1, x2; f32x4 v0[8], v1[8], v2[8], g0[2], g1[2], g2[2];
    if (w < total) { cv_decode<JOB>(F, w, x0); cv_load(x0, v0, wave, lane); cv_gain(x0, g0, wave); }
    if (w + nw < total) { cv_decode<JOB>(F, w + nw, x1); cv_load(x1, v1, wave, lane); cv_gain(x1, g1, wave); }
    int par = 0;
    for (int it = w; it < total; it += nw) {
        LAS float* tile = (LAS float*)(F.lds + par * CV_TILE);
#pragma unroll
        for (int i = 0; i < 8; ++i) { LAS float* s = tile + (8 * wave + i) * 257 + 4 * lane; const float gs = g0[i >> 2][i & 3]; s[0] = v0[i].x * gs; s[1] = v0[i].y * gs; s[2] = v0[i].z * gs; s[3] = v0[i].w * gs; }
        if (it + 2 * nw < total) { cv_decode<JOB>(F, it + 2 * nw, x2); cv_load(x2, v2, wave, lane); cv_gain(x2, g2, wave); }
        __syncthreads();
#pragma unroll
        for (int q = 0; q < 4; ++q) {
            const int n = 32 * wave + nn + 8 * q, ncol = x0.n0 + n;
            const LAS float* s = tile + (8 * c) * 257 + n;
            v4u o; o.x = pk2(s[0 * 257], s[1 * 257]); o.y = pk2(s[2 * 257], s[3 * 257]); o.z = pk2(s[4 * 257], s[5 * 257]); o.w = pk2(s[6 * 257], s[7 * 257]);
            const int drow = x0.gu == 1 ? (((ncol >> 7) << 8) + (ncol & 127) + (x0.up ? 128 : 0)) : x0.gu == 2 ? win_row(ncol) : ncol;
            if (ncol < x0.N) __builtin_nontemporal_store(o, (v4u*)(x0.WT + (size_t)drow * x0.K + x0.k0 + 8 * c));
        }
        x0 = x1; x1 = x2;
#pragma unroll
        for (int i = 0; i < 8; ++i) { v0[i] = v1[i]; v1[i] = v2[i]; }
        g0[0] = g1[0]; g0[1] = g1[1]; g1[0] = g2[0]; g1[1] = g2[1];
        par ^= 1;
    }
    __syncthreads();
    if (JOB == 1) {
        v4u* z0 = (v4u*)(((bf16*)(F.ws + WS_WIN)) + (size_t)6704 * D); v4u* z1 = (v4u*)(((bf16*)(F.ws + WS_WIN)) + (size_t)6816 * D);
        for (int i = w * 512 + F.tid; i < 80 * D / 8; i += nw * 512) z0[i] = (v4u){0u, 0u, 0u, 0u};
        for (int i = w * 512 + F.tid; i < 96 * D / 8; i += nw * 512) z1[i] = (v4u){0u, 0u, 0u, 0u};
    }
}
__device__ __forceinline__ void prep_rows(Frame& F, const float* src, bf16* dst) {
    const int gw = F.bid * NWAVES + F.wave, NGW = F.G * NWAVES, lane = F.lane;
    f32x4 v[8], vn[8];
    if (gw < M) {
#pragma unroll
        for (int j = 0; j < 8; ++j) v[j] = __builtin_nontemporal_load((const f32x4*)(src + (size_t)gw * D) + lane + 64 * j);
    }
    for (int m = gw; m < M; m += NGW) {
        if (m + NGW < M) {
#pragma unroll
            for (int j = 0; j < 8; ++j) vn[j] = __builtin_nontemporal_load((const f32x4*)(src + (size_t)(m + NGW) * D) + lane + 64 * j);
        }
        float s = 0.f;
#pragma unroll
        for (int j = 0; j < 8; ++j) s += (v[j].x * v[j].x + v[j].y * v[j].y) + (v[j].z * v[j].z + v[j].w * v[j].w);
        s = wave_sum(s);
        v2u* o8 = (v2u*)(dst + (size_t)m * D) + lane;
#pragma unroll
        for (int j = 0; j < 8; ++j) { v2u w; w.x = pk2(v[j].x, v[j].y); w.y = pk2(v[j].z, v[j].w); o8[64 * j] = w; }
        if (lane < 32) ((float*)(F.ws + WS_SSQ))[(size_t)m * 32 + lane] = (lane == 0) ? s : 0.f;
#pragma unroll
        for (int j = 0; j < 8; ++j) v[j] = vn[j];
    }
}
__device__ __forceinline__ void rms_final(Frame& F) {
    const int gw = F.bid * NWAVES + F.wave, NGW = F.G * NWAVES, lane = F.lane;
    const f32x4* gr = (const f32x4*)F.nfin + lane;
    f32x4 gg[8];
#pragma unroll
    for (int j = 0; j < 8; ++j) gg[j] = gr[64 * j];
    v2u w[8], wn[8]; float sp = 0.f, spn = 0.f;
    if (gw < M) {
#pragma unroll
        for (int j = 0; j < 8; ++j) w[j] = ((const v2u*)(((bf16*)(F.ws + WS_A)) + (size_t)gw * D) + lane)[64 * j];
        sp = lane < 32 ? ((float*)(F.ws + WS_SSQ))[(size_t)gw * 32 + lane] : 0.f;
    }
    for (int m = gw; m < M; m += NGW) {
        if (m + NGW < M) {
#pragma unroll
            for (int j = 0; j < 8; ++j) wn[j] = ((const v2u*)(((bf16*)(F.ws + WS_A)) + (size_t)(m + NGW) * D) + lane)[64 * j];
            spn = lane < 32 ? ((float*)(F.ws + WS_SSQ))[(size_t)(m + NGW) * 32 + lane] : 0.f;
        }
        const float s = wave_sum(sp);
        const float rstd = 1.0f / sqrtf(s * (1.f / D) + NORM_EPS);
        f32x4* xr = (f32x4*)(F.X + (size_t)m * D) + lane;
#pragma unroll
        for (int j = 0; j < 8; ++j) __builtin_nontemporal_store((f32x4){bflo(w[j].x), bfhi(w[j].x), bflo(w[j].y), bfhi(w[j].y)} * rstd * gg[j], xr + 64 * j);
#pragma unroll
        for (int j = 0; j < 8; ++j) w[j] = wn[j];
        sp = spn;
    }
}
__device__ __forceinline__ void rope_table(Frame& F) {
    const int gt = F.bid * (NWAVES * 64) + F.tid, NT = F.G * NWAVES * 64;
    for (int e = gt; e < M * 64; e += NT) {
        const int m = e >> 6, i = e & 63;
        double inv = 1.0; const double rr = 8.65964323360065346691e-01;
        for (int k = 0; k < i; ++k) inv *= rr;
        const float invf = (float)inv;
        const float angf = (float)F.pos[m] * invf;
        const double ang = (double)angf;
        const double kq = __builtin_rint(ang * 0.63661977236758134308);
        double y = __builtin_fma(-kq, 1.57079632679489655800e+00, ang);
        y = __builtin_fma(-kq, 6.12323399573676603587e-17, y);
        const double y2 = y * y;
        double sn = 1.0 / 6227020800.0; sn = sn * y2 - 1.0 / 39916800.0; sn = sn * y2 + 1.0 / 362880.0; sn = sn * y2 - 1.0 / 5040.0; sn = sn * y2 + 1.0 / 120.0; sn = sn * y2 - 1.0 / 6.0; sn = sn * y2 * y + y;
        double cs = 1.0 / 479001600.0; cs = cs * y2 - 1.0 / 3628800.0; cs = cs * y2 + 1.0 / 40320.0; cs = cs * y2 - 1.0 / 720.0; cs = cs * y2 + 1.0 / 24.0; cs = cs * y2 - 0.5; cs = cs * y2 + 1.0;
        const int q = ((int)kq) & 3;
        const double c = (q == 0) ? cs : (q == 1) ? -sn : (q == 2) ? -cs : sn;
        const double s = (q == 0) ? sn : (q == 1) ? cs : (q == 2) ? -sn : -cs;
        ((float2*)(F.ws + WS_TAB))[e] = make_float2((float)c, (float)s);
        if ((i & 1) == 0) ((float2*)(F.ws + WS_TAB2))[(size_t)m * 32 + (i >> 1)] = make_float2((float)c, (float)s);
    }
}
__device__ __forceinline__ float lg2_gamma(int h) {
    const double x = __builtin_amdgcn_exp2f((float)(-5 - h));
    double s = 1.0 / 8.0; s = s * x + 1.0 / 7.0; s = s * x + 1.0 / 6.0; s = s * x + 0.2; s = s * x + 0.25; s = s * x + 1.0 / 3.0; s = s * x + 0.5; s = s * x + 1.0; s = -s * x;
    return (float)(s * 1.44269504088896338700);
}

constexpr int PT_IMG = 32 * 132 * 4;
__device__ __forceinline__ void post_tile(Frame& F, int tt) {
    const int tid = F.tid;
    const int m0 = tt * 32, b = m0 / T, tp0 = m0 % T;
    const int ltok = tid >> 4, lc8 = (tid & 15) * 8;
    const bf16* gp0 = ((bf16*)(F.ws + WS_PROJ)) + (size_t)(m0 + ltok) * NPB + lc8;
    v4u cur = *(const v4u*)(gp0 + C_RK), nxt = cur;
    for (int s = 0; s < 18; ++s) {
        LAS float* L = (LAS float*)(F.lds + (s & 1) * PT_IMG);
        const int typ = s < 8 ? 1 : s < 16 ? 2 : 6, h = s < 16 ? (s & 7) : (s & 1);
        if (s + 1 < 18) { const int sn = s + 1; nxt = *(const v4u*)(gp0 + (sn < 8 ? C_RK + sn * 128 : sn < 16 ? C_RV + (sn - 8) * 128 : C_AV + (sn - 16) * 128)); }
        { const v4u w = cur; LAS float* lp = L + ltok * 132 + lc8;
          lp[0] = bflo(w.x); lp[1] = bfhi(w.x); lp[2] = bflo(w.y); lp[3] = bfhi(w.y); lp[4] = bflo(w.z); lp[5] = bfhi(w.z); lp[6] = bflo(w.w); lp[7] = bfhi(w.w); }
        __syncthreads();
        {
            const int d = tid >> 2, t8 = (tid & 3) * 8;
            bf16* tb = (typ == 1) ? ((bf16*)(F.ws + WS_RKT)) + ((size_t)(b * 8 + h) * 128 + d) * T : (typ == 2) ? ((bf16*)(F.ws + WS_RVT)) + ((size_t)(b * 8 + h) * 128 + d) * T : ((bf16*)(F.ws + WS_AVT)) + ((size_t)(b * 2 + h) * 128 + d) * T;
            const LAS float* lp = L + t8 * 132 + d;
            v4u w; w.x = pk2(lp[0], lp[132]); w.y = pk2(lp[264], lp[396]); w.z = pk2(lp[528], lp[660]); w.w = pk2(lp[792], lp[924]);
            if (typ != 6) *(v4u*)(tb + tp0 + t8) = w;
            else {
                const int p0 = 8 * ((t8 >> 2) & 3) + 4 * (t8 >> 4);
                *(v2u*)(tb + tp0 + p0) = (v2u){w.x, w.y}; *(v2u*)(tb + tp0 + p0 + 8) = (v2u){w.z, w.w};
            }
        }
        cur = nxt;
    }
    __syncthreads();
}

#define MFMA32(a, b, c) __builtin_amdgcn_mfma_f32_32x32x16_bf16((a), (b), (c), 0, 0, 0)
#define MFMA16(a, b, c) __builtin_amdgcn_mfma_f32_16x16x32_bf16((a), (b), (c), 0, 0, 0)
__device__ __forceinline__ f32x16 zero16() { f32x16 z;
#pragma unroll
    for (int i = 0; i < 16; ++i) z[i] = 0.f; return z; }
__device__ __forceinline__ void ret_kv_unit(Frame& F, int unit, int w4, int lane) {
    const int bh = unit >> 5, n = unit & 31, t0 = n * 128, r = lane & 31, hi = lane >> 5;
    f32x16 acc[4];
#pragma unroll
    for (int k = 0; k < 4; ++k) acc[k] = zero16();
    const bf16* vp = ((bf16*)(F.ws + WS_RVT)) + ((size_t)bh * 128 + 32 * w4 + r) * T + t0 + 8 * hi;
    const bf16* kp = ((bf16*)(F.ws + WS_RKT)) + ((size_t)bh * 128 + r) * T + t0 + 8 * hi;
#pragma unroll
    for (int s = 0; s < 8; ++s) {
        const bf16x8 bfr = *(const bf16x8*)(vp + 16 * s);
#pragma unroll
        for (int blk = 0; blk < 4; ++blk) { const bf16x8 af = *(const bf16x8*)(kp + (size_t)blk * 32 * T + 16 * s); acc[blk] = MFMA32(af, bfr, acc[blk]); }
    }
    float* kvp = ((float*)(F.ws + WS_KV)) + ((size_t)unit * 128 + 32 * w4 + r) * 128;
#pragma unroll
    for (int blk = 0; blk < 4; ++blk)
#pragma unroll
        for (int g = 0; g < 4; ++g) *(f32x4*)(kvp + 32 * blk + 8 * g + 4 * hi) = (f32x4){acc[blk][4 * g], acc[blk][4 * g + 1], acc[blk][4 * g + 2], acc[blk][4 * g + 3]};
}
__device__ __forceinline__ void ret_scan(Frame& F) {
    const int gt = F.bid * (NWAVES * 64) + F.tid, NT = F.G * NWAVES * 64;
    for (int idx = gt; idx < 16 * 4096; idx += NT) {
        const int bh = idx >> 12, rem = idx & 4095, h = bh & 7;
        const float gC = __builtin_amdgcn_exp2f(128.f * lg2_gamma(h));
        f32x4 S = {0.f, 0.f, 0.f, 0.f};
        const size_t off0 = ((size_t)(bh * 32) * 16384) + (size_t)rem * 4;
#pragma unroll 1
        for (int n0 = 0; n0 < 32; n0 += 8) {
            f32x4 kv[8];
#pragma unroll
            for (int k = 0; k < 8; ++k) kv[k] = *(const f32x4*)(((float*)(F.ws + WS_KV)) + off0 + (size_t)(n0 + k) * 16384);
#pragma unroll
            for (int k = 0; k < 8; ++k) {
                v2u w; w.x = pk2(S.x, S.y); w.y = pk2(S.z, S.w);
                *(v2u*)(((bf16*)(F.ws + WS_ST)) + off0 + (size_t)(n0 + k) * 16384) = w;
                S = (S + kv[k]) * gC;
            }
        }
    }
}
constexpr int RO_PITCH = 272, RO_KB = 128 * RO_PITCH, RO_UNIT = 2 * RO_KB;
__device__ __forceinline__ void ret_out_stage(Frame& F, int u2) {
    const int tid = F.tid, row0 = tid >> 4, c = tid & 15;
    const int vpos = 32 * (c >> 2) + 16 * ((c & 3) >> 1) + 4 * (c & 1);
#pragma unroll 1
    for (int us = 0; us < 2; ++us) {
        const int unit = 2 * u2 + us, bh = unit >> 5, n = unit & 31, b = bh >> 3, h = bh & 7, t0 = n * 128;
        v4u kr[4], vr[4];
#pragma unroll
        for (int j = 0; j < 4; ++j) {
            const int row = row0 + 32 * j;
            kr[j] = *(const v4u*)(((bf16*)(F.ws + WS_PROJ)) + ((size_t)b * T + t0 + row) * NPB + C_RK + h * 128 + 8 * c);
            vr[j] = *(const v4u*)(((bf16*)(F.ws + WS_RVT)) + ((size_t)bh * 128 + row) * T + t0 + 8 * c);
        }
#pragma unroll
        for (int j = 0; j < 4; ++j) {
            const int row = row0 + 32 * j;
            *(LAS v4u*)(F.lds + us * RO_UNIT + row * RO_PITCH + 16 * c) = kr[j];
            *(LAS v2u*)(F.lds + us * RO_UNIT + RO_KB + row * RO_PITCH + 2 * vpos) = (v2u){vr[j].x, vr[j].y};
            *(LAS v2u*)(F.lds + us * RO_UNIT + RO_KB + row * RO_PITCH + 2 * vpos + 16) = (v2u){vr[j].z, vr[j].w};
        }
    }
    __syncthreads();
}
__device__ __forceinline__ void ret_out_unit(Frame& F, int unit, int I, int lane) {
    const int lb = ((unit & 1) * RO_UNIT);
    const int bh = unit >> 5, n = unit & 31, b = bh >> 3, h = bh & 7, t0 = n * 128, r = lane & 31, hi = lane >> 5;
    const size_t tokI = (size_t)b * T + t0 + 32 * I + r;
    bf16x8 qf[8];
    { const bf16* qp = ((bf16*)(F.ws + WS_PROJ)) + tokI * NPB + C_RQ + h * 128 + 8 * hi;
#pragma unroll
      for (int s = 0; s < 8; ++s) qf[s] = *(const bf16x8*)(qp + 16 * s); }
    f32x16 out[4];
#pragma unroll
    for (int k = 0; k < 4; ++k) out[k] = zero16();
    { const bf16* sp = ((bf16*)(F.ws + WS_ST)) + ((size_t)unit * 128 + r) * 128 + 8 * hi;
#pragma unroll
      for (int blk = 0; blk < 4; ++blk) {
          bf16x8 af[8];
#pragma unroll
          for (int s = 0; s < 8; ++s) af[s] = *(const bf16x8*)(sp + (size_t)blk * 32 * 128 + 16 * s);
          asm volatile("" ::: "memory");
#pragma unroll
          for (int s = 0; s < 8; ++s) out[blk] = MFMA32(af[s], qf[s], out[blk]);
      } }
#pragma unroll 1
    for (int J = 0; J <= I; ++J) {
        asm volatile("" ::: "memory");
        f32x16 X = zero16();
#pragma unroll
        for (int s = 0; s < 8; ++s) { const bf16x8 kf = *(const LAS bf16x8*)(F.lds + lb + (32 * J + r) * RO_PITCH + (16 * s + 8 * hi) * 2); X = MFMA32(kf, qf[s], X); }
        if (J == I) {
            int rr = r; asm volatile("" : "+v"(rr));
#pragma unroll
            for (int g = 0; g < 16; ++g) { const int jrow = (g & 3) + 8 * (g >> 2) + 4 * hi; if (jrow > rr) X[g] = 0.f; }
        }
#pragma unroll
        for (int s2 = 0; s2 < 2; ++s2) {
            v4u xp; xp.x = pk2(X[8 * s2], X[8 * s2 + 1]); xp.y = pk2(X[8 * s2 + 2], X[8 * s2 + 3]); xp.z = pk2(X[8 * s2 + 4], X[8 * s2 + 5]); xp.w = pk2(X[8 * s2 + 6], X[8 * s2 + 7]);
            const bf16x8 xb = __builtin_bit_cast(bf16x8, xp);
#pragma unroll
            for (int blk = 0; blk < 4; ++blk) {
                const bf16x8 av = *(const LAS bf16x8*)(F.lds + lb + RO_KB + (32 * blk + r) * RO_PITCH + (32 * J + 8 * (2 * s2 + hi)) * 2);
                out[blk] = MFMA32(av, xb, out[blk]);
            }
        }
    }
    float s1 = 0.f, s2 = 0.f;
#pragma unroll
    for (int blk = 0; blk < 4; ++blk) {
#pragma unroll
        for (int g = 0; g < 16; ++g) { const float v = out[blk][g]; s1 += v; s2 = __builtin_fmaf(v, v, s2); }
        asm volatile("" : "+v"(s1), "+v"(s2));
    }
    s1 = xor32_sum(s1); s2 = xor32_sum(s2);
    const float mu = s1 * (1.f / 128.f);
    const float rstd = 1.0f / sqrtf(__builtin_fmaxf(s2 * (1.f / 128.f) - mu * mu, 0.f) + NORM_EPS);
    const bf16* gp = ((bf16*)(F.ws + WS_PROJ)) + tokI * NPB + C_RG + h * 128;
    bf16* op = ((bf16*)(F.ws + WS_PIDX)) + tokI * D + h * 128;
    const float* nw = F.nret + h * 128;
    v2u ov[4][4];
#pragma unroll
    for (int blk = 0; blk < 4; ++blk)
#pragma unroll
        for (int g = 0; g < 4; ++g) {
            const int e = 32 * blk + 8 * g + 4 * hi;
            const v2u gg = *(const v2u*)(gp + e); const f32x4 w4 = *(const f32x4*)(nw + e);
            const float y0 = (out[blk][4 * g] - mu) * rstd * w4.x * bflo(gg.x), y1 = (out[blk][4 * g + 1] - mu) * rstd * w4.y * bfhi(gg.x);
            const float y2 = (out[blk][4 * g + 2] - mu) * rstd * w4.z * bflo(gg.y), y3 = (out[blk][4 * g + 3] - mu) * rstd * w4.w * bfhi(gg.y);
            ov[blk][g].x = pk2(y0, y1); ov[blk][g].y = pk2(y2, y3);
            if (g == 3) asm volatile("" ::: "memory");
        }
    asm volatile("" ::: "memory");
#pragma unroll
    for (int blk = 0; blk < 4; ++blk)
#pragma unroll
        for (int g = 0; g < 4; ++g) *(v2u*)(op + 32 * blk + 8 * g + 4 * hi) = ov[blk][g];
}

__device__ __forceinline__ unsigned fkey(float f) { unsigned b = __float_as_uint(f); if (b == 0x80000000u) b = 0u; return (b & 0x80000000u) ? ~b : (b | 0x80000000u); }
__device__ __forceinline__ int row16_sum_i(int c) {
    c += __builtin_amdgcn_update_dpp(0, c, 0xB1, 0xF, 0xF, true);
    c += __builtin_amdgcn_update_dpp(0, c, 0x4E, 0xF, 0xF, true);
    c += __builtin_amdgcn_update_dpp(0, c, 0x141, 0xF, 0xF, true);
    c += __builtin_amdgcn_update_dpp(0, c, 0x140, 0xF, 0xF, true);
    return c;
}
__device__ __forceinline__ int half_sum(int c) {
    c = row16_sum_i(c);
    auto rr = __builtin_amdgcn_permlane16_swap((unsigned)c, (unsigned)c, false, false);
    return (int)rr[0] + (int)rr[1];
}
__device__ __forceinline__ float xor16_max(float m) { auto rr = __builtin_amdgcn_permlane16_swap(__float_as_uint(m), __float_as_uint(m), false, false); return __builtin_fmaxf(__uint_as_float(rr[0]), __uint_as_float(rr[1])); }
__device__ __forceinline__ float xor32_max(float m) { auto rr = __builtin_amdgcn_permlane32_swap(__float_as_uint(m), __float_as_uint(m), false, false); return __builtin_fmaxf(__uint_as_float(rr[0]), __uint_as_float(rr[1])); }
__device__ __forceinline__ float xor16_sum(float m) { auto rr = __builtin_amdgcn_permlane16_swap(__float_as_uint(m), __float_as_uint(m), false, false); return __uint_as_float(rr[0]) + __uint_as_float(rr[1]); }
__device__ __forceinline__ float xor32_sum(float m) { auto rr = __builtin_amdgcn_permlane32_swap(__float_as_uint(m), __float_as_uint(m), false, false); return __uint_as_float(rr[0]) + __uint_as_float(rr[1]); }
#define CNT4(c, u0, u1, u2, u3, cand) do { unsigned long long _t0, _t1, _t2, _t3; \
    asm volatile("v_cmp_ge_u32_e64 %1, %5, %9\n\tv_cmp_ge_u32_e64 %2, %6, %9\n\tv_cmp_ge_u32_e64 %3, %7, %9\n\tv_cmp_ge_u32_e64 %4, %8, %9\n\t" \
                 "v_addc_co_u32_e64 %0, vcc, 0, %0, %1\n\tv_addc_co_u32_e64 %0, vcc, 0, %0, %2\n\tv_addc_co_u32_e64 %0, vcc, 0, %0, %3\n\tv_addc_co_u32_e64 %0, vcc, 0, %0, %4" \
                 : "+v"(c), "=&s"(_t0), "=&s"(_t1), "=&s"(_t2), "=&s"(_t3) : "v"(u0), "v"(u1), "v"(u2), "v"(u3), "v"(cand) : "vcc"); } while (0)
constexpr int IX_KOFF = 32768, IX_KPITCH = 144, IX_KBUF = 256 * IX_KPITCH;
__device__ __forceinline__ void idx_unit(Frame& F, int b, int qb, int wave, int lane) {
    const int q0 = qb * 16, hi = lane >> 5, r = lane & 31, tid = F.tid;
    const int myq = q0 + 2 * wave + hi;
    const int arow_q = (r >> 2) & 1, arow_h = (r & 3) | ((r >> 3) << 2);
    half8 a[4];
    { const f16* ap = ((f16*)(F.ws + WS_IQ)) + ((size_t)b * T + q0 + 2 * wave + arow_q) * 1024 + arow_h * 64 + 8 * hi;
#pragma unroll
      for (int s = 0; s < 4; ++s) a[s] = *(const half8*)(ap + 16 * s); }
    float wv[16];
    { const f32x4* wp = (const f32x4*)(((float*)(F.ws + WS_IW)) + ((size_t)b * T + myq) * 16);
#pragma unroll
      for (int k = 0; k < 4; ++k) { const f32x4 t = wp[k]; wv[4 * k] = t.x; wv[4 * k + 1] = t.y; wv[4 * k + 2] = t.z; wv[4 * k + 3] = t.w; } }
    LAS unsigned* sl = (LAS unsigned*)(F.lds + wave * 4096) + lane;
    unsigned u[128];
    const int last = (q0 + 15) >> 5, nstage = (last >> 3) + 1;
    const f16* sg = ((f16*)(F.ws + WS_IK)) + ((size_t)b * T + (tid >> 1)) * 64 + 32 * (tid & 1);
    const int sst = IX_KOFF + (tid >> 1) * IX_KPITCH + 64 * (tid & 1);
    v4u sr[4];
#pragma unroll
    for (int j = 0; j < 4; ++j) sr[j] = *(const v4u*)(sg + 8 * j);
#pragma unroll
    for (int j = 0; j < 4; ++j) *(LAS v4u*)(F.lds + sst + 16 * j) = sr[j];
    __syncthreads();
    const int kread = IX_KOFF + r * IX_KPITCH + 16 * hi;
#pragma unroll
    for (int c = 0; c < 8; ++c) {
        if (16 * c <= last) {
#pragma unroll 1
            for (int st = 0; st < 2; ++st) {
                const int sidx = 2 * c + st;
                if (sidx < nstage) {
                    const bool more = (sidx + 1) < nstage;
                    if (more) {
#pragma unroll
                        for (int j = 0; j < 4; ++j) sr[j] = *(const v4u*)(sg + (size_t)(sidx + 1) * 256 * 64 + 8 * j);
                    }
                    const int kb = kread + (sidx & 1) * IX_KBUF;
#pragma unroll 1
                    for (int ii = 0; ii < 8; ++ii) {
                        const int i = 8 * sidx + ii;
                        half8 bfr[4];
#pragma unroll
                        for (int s = 0; s < 4; ++s) bfr[s] = *(const LAS half8*)(F.lds + kb + ii * 32 * IX_KPITCH + 32 * s);
                        f32x16 acc = zero16();
#pragma unroll
                        for (int s = 0; s < 4; ++s) acc = __builtin_amdgcn_mfma_f32_32x32x16_f16(a[s], bfr[s], acc, 0, 0, 0);
                        float sc = 0.f;
#pragma unroll
                        for (int hh = 0; hh < 16; ++hh) sc = __builtin_fmaf(wv[hh], __builtin_amdgcn_fmed3f(acc[hh], 0.f, INFINITY), sc);
                        const int key = 32 * i + r;
                        sl[(8 * st + ii) * 64] = (key <= myq) ? fkey(sc) : 0u;
                    }
                    if (more) {
#pragma unroll
                        for (int j = 0; j < 4; ++j) *(LAS v4u*)(F.lds + sst + ((sidx + 1) & 1) * IX_KBUF + 16 * j) = sr[j];
                    }
                    __syncthreads();
                } else {
#pragma unroll 1
                    for (int ii = 0; ii < 8; ++ii) sl[(8 * st + ii) * 64] = 0u;
                }
            }
#pragma unroll
            for (int ii = 0; ii < 16; ++ii) u[16 * c + ii] = sl[ii * 64];
        } else {
#pragma unroll
            for (int ii = 0; ii < 16; ++ii) u[16 * c + ii] = 0u;
        }
    }
    unsigned Tk = 0u; bool done = false;
#pragma unroll 1
    for (int rep = 0; rep < (MK_ABL == 4 ? 2 : 1); ++rep) { Tk = 0u; done = false;
#pragma unroll 1
    for (int bit = 31; bit >= 0; --bit) {
        const unsigned cand = Tk | (1u << bit);
        int c = 0;
#pragma unroll
        for (int g = 0; g < 8; ++g) {
            if (16 * g <= last) {
#pragma unroll
                for (int i = 0; i < 16; i += 4) CNT4(c, u[16 * g + i], u[16 * g + i + 1], u[16 * g + i + 2], u[16 * g + i + 3], cand);
            }
        }
        asm volatile("s_nop 2" : "+v"(c));
        c = half_sum(c);
        if (!done && c >= 256) { Tk = cand; done = (c == 256); }
        if (__all(done)) break;
    }
    asm volatile("" : "+v"(Tk)); }
    unsigned Tk2 = Tk - 1u; int Jthr = -1;
    if (!__all(done)) {
        int cgt = 0, ceq = 0;
#pragma unroll
        for (int i = 0; i < 128; ++i) { cgt += (u[i] > Tk) ? 1 : 0; ceq += (u[i] == Tk) ? 1 : 0; }
        cgt = half_sum(cgt); ceq = half_sum(ceq);
        Jthr = (Tk == 0u) ? -1 : 4095;
        const int need = 256 - cgt;
        const bool trim = (Tk != 0u) && (ceq > need);
        if (__any(trim)) {
            int J = 0;
#pragma unroll 1
            for (int bit = 11; bit >= 0; --bit) {
                const int cand = J | (1 << bit);
                unsigned Tk1 = Tk; asm volatile("" : "+v"(Tk1));
                const int cr = cand - r;
                int c = 0;
#pragma unroll
                for (int i = 0; i < 128; ++i) c += ((u[i] == Tk1) && (32 * i < cr)) ? 1 : 0;
                c = half_sum(c);
                if (c < need) J = cand;
            }
            if (trim) Jthr = J;
        }
        Tk2 = Tk;
    }
    const int jt = Jthr - r;
    asm volatile("" : "+v"(Tk2));
    unsigned mlo0 = 0u, mhi0 = 0u, mlo1 = 0u, mhi1 = 0u;
#pragma unroll
    for (int g = 0; g < 8; ++g) {
        if (16 * g <= last) {
#pragma unroll
            for (int ii = 0; ii < 16; ++ii) {
                const int i = 16 * g + ii;
                const bool sel = (u[i] > Tk2) || ((u[i] == Tk2) && (32 * i <= jt));
                const unsigned long long bal = __ballot(sel);
                const unsigned lo = (unsigned)bal, hi_ = (unsigned)(bal >> 32);
                int lv = lane; asm volatile("" : "+v"(lv));
                const bool me = (lv == (i & 63));
                if (i < 64) { mlo0 = me ? lo : mlo0; mhi0 = me ? hi_ : mhi0; }
                else { mlo1 = me ? lo : mlo1; mhi1 = me ? hi_ : mhi1; }
            }
        }
    }
    unsigned* mp = ((unsigned*)(F.ws + WS_MASK)) + ((size_t)b * T + q0 + 2 * wave) * 128;
    mp[lane] = mlo0; mp[64 + lane] = mlo1; mp[128 + lane] = mhi0; mp[192 + lane] = mhi1;
}

constexpr int AT_PITCH = 272, AT_KBYTES = 128 * AT_PITCH, AT_BUF = 2 * AT_KBYTES;
__device__ __forceinline__ void attn_unit(Frame& F, int b, int kvh, int qb) {
    const int tid = F.tid, lane = F.lane, wave = F.wave, fr = lane & 15, fq = lane >> 4;
    const int q = qb * 32 + 4 * wave + (fr >> 2), head = 4 * kvh + (fr & 3);
    const size_t tok = (size_t)b * T + q;
    bf16x8 qf[4];
    { const bf16* qp = ((bf16*)(F.ws + WS_PROJ)) + tok * NPB + C_AQ + head * 128 + 8 * fq;
#pragma unroll
      for (int s = 0; s < 4; ++s) qf[s] = *(const bf16x8*)(qp + 32 * s); }
    const v4u* mrow = (const v4u*)(((unsigned*)(F.ws + WS_MASK)) + tok * 128);
    f32x4 O[8];
#pragma unroll
    for (int k = 0; k < 8; ++k) O[k] = (f32x4){0.f, 0.f, 0.f, 0.f};
    float mrun = -INFINITY, lsum = 0.f;
    const int nst = (qb + 4) >> 2;
    const int srow = tid >> 4, sc8 = (tid & 15) * 8;
    const bf16* kg = ((bf16*)(F.ws + WS_PROJ)) + ((size_t)b * T + srow) * NPB + C_AK + kvh * 128 + sc8;
    const bf16* vg = ((bf16*)(F.ws + WS_AVT)) + ((size_t)(b * 2 + kvh) * 128 + srow) * T + sc8;
    LAS unsigned char* lds = F.lds;
    const int kst = srow * AT_PITCH + sc8 * 2, vst = AT_KBYTES + kst;
    v4u kr[4], vr[4];
#pragma unroll
    for (int j = 0; j < 4; ++j) { kr[j] = *(const v4u*)(kg + (size_t)(32 * j) * NPB); vr[j] = *(const v4u*)(vg + (size_t)(32 * j) * T); }
#define AT_VWRITE(base) do { _Pragma("unroll") for (int j = 0; j < 4; ++j) *(LAS v4u*)(lds + (base) + vst + 32 * j * AT_PITCH) = vr[j]; } while (0)
#pragma unroll
    for (int j = 0; j < 4; ++j) *(LAS v4u*)(lds + kst + 32 * j * AT_PITCH) = kr[j];
    AT_VWRITE(0);
    v4u W4 = mrow[0], W4n = W4;
    __syncthreads();
    if (wave >= 4) __builtin_amdgcn_s_setprio(1);
    for (int st = 0; st < nst; ++st) {
        const int bo = (st & 1) * AT_BUF;
        const bool more = (st + 1 < nst);
        if (more) {
#pragma unroll
            for (int j = 0; j < 4; ++j) { kr[j] = *(const v4u*)(kg + (size_t)((st + 1) * 128 + 32 * j) * NPB); vr[j] = *(const v4u*)(vg + (size_t)(32 * j) * T + (st + 1) * 128); }
            W4n = mrow[st + 1];
        }
        {
            f32x4 sg[8];
#pragma unroll
            for (int g = 0; g < 8; ++g) sg[g] = (f32x4){0.f, 0.f, 0.f, 0.f};
#pragma unroll
            for (int s = 0; s < 4; ++s)
#pragma unroll
                for (int g = 0; g < 8; ++g) { const bf16x8 kf = *(const LAS bf16x8*)(lds + bo + (16 * g + fr) * AT_PITCH + (32 * s + 8 * fq) * 2); sg[g] = MFMA16(kf, qf[s], sg[g]); }
            float mx = -INFINITY;
#pragma unroll
            for (int g = 0; g < 8; ++g)
#pragma unroll
                for (int j = 0; j < 4; ++j) mx = __builtin_fmaxf(mx, sg[g][j]);
            mx = xor16_max(mx); mx = xor32_max(mx);
            const float mnew = __builtin_fmaxf(mrun, mx);
            const float alpha = __builtin_amdgcn_exp2f(mrun - mnew);
            const bool resc = __any(mnew != mrun);
            mrun = mnew;
            float ps = 0.f; bf16x8 pb[4];
#pragma unroll
            for (int h = 0; h < 4; ++h) {
                float p[8];
#pragma unroll
                for (int j = 0; j < 8; ++j) {
                    const int bit = 4 * fq + 16 * (j >> 2) + (j & 3);
                    const unsigned keep = (unsigned)__builtin_amdgcn_sbfe((int)W4[h], bit, 1);
                    p[j] = __uint_as_float(__float_as_uint(__builtin_amdgcn_exp2f(sg[2 * h + (j >> 2)][j & 3] - mnew)) & keep); ps += p[j];
                }
                v4u pp; pp.x = pk2(p[0], p[1]); pp.y = pk2(p[2], p[3]); pp.z = pk2(p[4], p[5]); pp.w = pk2(p[6], p[7]);
                pb[h] = __builtin_bit_cast(bf16x8, pp);
            }
            lsum = lsum * alpha + ps;
            if (resc) {
#pragma unroll
                for (int blk = 0; blk < 8; ++blk) O[blk] = O[blk] * alpha;
            }
#pragma unroll
            for (int blk = 0; blk < 8; ++blk) {
                const LAS unsigned char* vp = lds + bo + AT_KBYTES + (16 * blk + fr) * AT_PITCH + (8 * fq) * 2;
#pragma unroll
                for (int h = 0; h < 4; ++h) { const bf16x8 av = *(const LAS bf16x8*)(vp + 64 * h); O[blk] = MFMA16(av, pb[h], O[blk]); }
            }
        }
        if (more) { const int bn = ((st + 1) & 1) * AT_BUF;
#pragma unroll
            for (int j = 0; j < 4; ++j) *(LAS v4u*)(lds + bn + kst + 32 * j * AT_PITCH) = kr[j];
            AT_VWRITE(bn); }
        __syncthreads();
        W4 = W4n;
    }
#undef AT_VWRITE
    __builtin_amdgcn_s_setprio(0);
    lsum = xor16_sum(lsum); lsum = xor32_sum(lsum);
    const float inv = 1.0f / lsum;
    bf16* op = ((bf16*)(F.ws + WS_PIDX)) + tok * D + 1024 + head * 128 + 4 * fq;
#pragma unroll
    for (int blk = 0; blk < 8; ++blk) { v2u o; o.x = pk2(O[blk][0] * inv, O[blk][1] * inv); o.y = pk2(O[blk][2] * inv, O[blk][3] * inv); *(v2u*)(op + 16 * blk) = o; }
}

struct Args { const void* in[15]; float* out; unsigned char* ws; int ph_lo, ph_hi; };
constexpr int NPHASE = 12;
__global__ void __launch_bounds__(NWAVES * 64, 2) mk_fwd(Args args) {
    extern __shared__ __attribute__((aligned(16))) unsigned char lds[];
    Frame F;
    F.lds = (LAS unsigned char*)lds;
    F.tid = threadIdx.x; F.lane = F.tid & 63; F.wave = __builtin_amdgcn_readfirstlane(F.tid >> 6);
    F.G = gridDim.x; F.bid = blockIdx.x;
    unsigned char* ws = args.ws;
    F.x = (const float*)args.in[0]; F.pos = (const int*)args.in[1];
    F.n1 = (const float*)args.in[2]; F.wg1 = (const float*)args.in[3]; F.wu1 = (const float*)args.in[4]; F.wd1 = (const float*)args.in[5];
    F.nmix = (const float*)args.in[6]; F.win = (const float*)args.in[7]; F.nret = (const float*)args.in[8]; F.wout = (const float*)args.in[9];
    F.n2 = (const float*)args.in[10]; F.wg2 = (const float*)args.in[11]; F.wu2 = (const float*)args.in[12]; F.wd2 = (const float*)args.in[13]; F.nfin = (const float*)args.in[14];
    F.X = args.out;
    F.ws = ws;
    volatile LAS unsigned* MISC = (volatile LAS unsigned*)(F.lds + MISC_OFF);
    for (int u = F.tid; u < (LDS_BYTES - LDSCTL_OFF) / 4; u += NWAVES * 64) ((LAS unsigned*)(F.lds + LDSCTL_OFF))[u] = 0u;
    __syncthreads();
    const int lo = args.ph_lo, hi = args.ph_hi;
    XcdBarrier bar; bar.bar = (unsigned*)(ws + WS_CTL) + CW_BAR; bar.x = 0; bar.st = nullptr;
    if (hi - lo > 1) bar = xcd_barrier_post((unsigned*)(ws + WS_CTL) + CW_BAR, MISC + 8);
#ifndef MK_PHMASK
#define MK_PHMASK 0xFFFF
#endif
#define IN(k) (((MK_PHMASK >> (k)) & 1) && lo <= (k) && (k) < hi)
#define SEAM(k) do { if (IN(k) && IN((k) + 1)) xcd_barrier(bar); } while (0)
    bf16* H = ((bf16*)(F.ws + WS_PROJ));

#ifndef MK_REPEAT
#define MK_REPEAT 0
#endif
#ifndef MK_TIMEPH
#define MK_TIMEPH -1
#endif
    unsigned long long tp0 = 0, tp1 = 0;
#define PHASE(k, ...) do { MK_STAMP(F.lds, 2 * (k)); if ((k) == MK_TIMEPH) tp0 = __builtin_amdgcn_s_memrealtime(); if (IN(k)) { { int t_ = threadIdx.x; asm volatile("" : "+v"(t_)); F.tid = t_; F.lane = t_ & 63; F.wave = __builtin_amdgcn_readfirstlane(t_ >> 6); } __VA_ARGS__ if ((MK_REPEAT >> (k)) & 1) { xcd_barrier(bar); __VA_ARGS__ } } MK_STAMP(F.lds, 1000 + (k)); SEAM(k); MK_STAMP(F.lds, 2 * (k) + 1); if ((k) == MK_TIMEPH) tp1 = __builtin_amdgcn_s_memrealtime(); } while (0)
    PHASE(0, { convert_job<0>(F, F.bid, F.G); if (MK_ABL == 1) convert_job<0>(F, F.bid, F.G); rope_table(F); if (MK_ABL == 2) rope_table(F); prep_rows(F, F.x, ((bf16*)(F.ws + WS_A))); if (MK_ABL == 3) prep_rows(F, F.x, ((bf16*)(F.ws + WS_A))); });
    PHASE(1, { pg8::Gemm g{((bf16*)(F.ws + WS_A)), ((bf16*)(F.ws + WS_WGU)), M, 2 * FF, D}; pg8::StaticOrder S; S.init(M, 2 * FF, F.G, F.bid); load_rstd_panels(F, S, ((float*)(F.ws + WS_SSQ))); EpiSwiGLU E{H, (const LAS float*)(F.lds + RS_OFF)};
        pg8::gemm_phase<EpiSwiGLU, pg8::StaticOrder, true, true>(F.lds, g, S, E, F.tid, 110);
        { const int nfull = (M / 256) * (2 * FF / 256) % F.G; if (nfull > 0 && F.bid >= nfull) { convert_job<1>(F, F.bid - nfull, F.G - nfull); }
          else if (nfull == 0) { convert_job<1>(F, F.bid, F.G); } } });
    PHASE(2, { pg8::Gemm g{H, ((bf16*)(F.ws + WS_WD)), M, D, FF}; pg8::StaticOrder S; S.init(M, D, F.G, F.bid); EpiResid<true> E{F.x, ((bf16*)(F.ws + WS_A)), 0.5f, ((float*)(F.ws + WS_SSQ))};
        pg8::gemm_phase<EpiResid<true>, pg8::StaticOrder, true, true>(F.lds, g, S, E, F.tid, 120); });
    PHASE(3, { pg8::Gemm g{((bf16*)(F.ws + WS_A)), ((bf16*)(F.ws + WS_WIN)), M, NINP, D}; pg8::StaticOrder S; S.init(M, NINP, F.G, F.bid); load_rstd_panels(F, S, ((float*)(F.ws + WS_SSQ))); EpiProj E{F.ws, (const LAS float*)(F.lds + RS_OFF)};
        pg8::gemm_phase<EpiProj, pg8::StaticOrder, true, true>(F.lds, g, S, E, F.tid, 130);
        { const int nfull = (M / 256) * (NINP / 256) % F.G; if (nfull > 0 && F.bid >= nfull) { convert_job<2>(F, F.bid - nfull, F.G - nfull); }
          else if (nfull == 0) { convert_job<2>(F, F.bid, F.G); } } });
    PHASE(4, { for (int tt = F.bid; tt < M / 32; tt += F.G) post_tile(F, tt); });
    PHASE(5, {
        for (int rep = 0; rep < (MK_ABL == 5 ? 2 : 1); ++rep) for (int u2 = F.bid; u2 < 256; u2 += F.G) ret_kv_unit(F, 2 * u2 + (F.wave >> 2), F.wave & 3, F.lane);
        for (int c = F.bid; c < 256; c += F.G) {
            _Pragma("unroll 1") for (int k = 0; k < 2; ++k) { const int b = c & 1, i = c >> 1; idx_unit(F, b, k ? 255 - i : i, F.wave, F.lane); } }
    });
    PHASE(6, { ret_scan(F); });
    PHASE(7, {
        for (int rep = 0; rep < (MK_ABL == 6 ? 2 : 1); ++rep) for (int u2 = F.bid; u2 < 256; u2 += F.G) { ret_out_stage(F, u2); ret_out_unit(F, 2 * u2 + (F.wave >> 2), F.wave & 3, F.lane); __syncthreads(); }
        MK_STAMP(F.lds, 210);
        for (int p = F.bid; p < 256; p += F.G) { const int grp = (p & 7) >> 1, b = grp >> 1, kvh = grp & 1, i = ((p >> 3) << 1) | (p & 1);
            _Pragma("unroll 1") for (int k = 0; k < 2; ++k) attn_unit(F, b, kvh, k ? 127 - i : i); }
    });
    PHASE(8, { pg8::Gemm g{((bf16*)(F.ws + WS_PIDX)), ((bf16*)(F.ws + WS_WOUT)), M, D, D}; pg8::StaticOrder S; S.init(M, D, F.G, F.bid); EpiResid<false> E{nullptr, ((bf16*)(F.ws + WS_A)), 1.0f, ((float*)(F.ws + WS_SSQ))};
        pg8::gemm_phase<EpiResid<false>, pg8::StaticOrder, true, true>(F.lds, g, S, E, F.tid, 180); });
    PHASE(9, { pg8::Gemm g{((bf16*)(F.ws + WS_A)), ((bf16*)(F.ws + WS_WGU)), M, 2 * FF, D}; pg8::StaticOrder S; S.init(M, 2 * FF, F.G, F.bid); load_rstd_panels(F, S, ((float*)(F.ws + WS_SSQ))); EpiSwiGLU E{H, (const LAS float*)(F.lds + RS_OFF)};
        pg8::gemm_phase<EpiSwiGLU, pg8::StaticOrder, true, true>(F.lds, g, S, E, F.tid, 190);
        { const int nfull = (M / 256) * (2 * FF / 256) % F.G; if (nfull > 0 && F.bid >= nfull) { convert_job<3>(F, F.bid - nfull, F.G - nfull); }
          else if (nfull == 0) { convert_job<3>(F, F.bid, F.G); } } });
    PHASE(10, { pg8::Gemm g{H, ((bf16*)(F.ws + WS_WD)), M, D, FF}; pg8::StaticOrder S; S.init(M, D, F.G, F.bid); EpiResid<false> E{nullptr, ((bf16*)(F.ws + WS_A)), 0.5f, ((float*)(F.ws + WS_SSQ))};
        pg8::gemm_phase<EpiResid<false>, pg8::StaticOrder, true, true>(F.lds, g, S, E, F.tid, 200); });
    PHASE(11, { rms_final(F); });
#undef PHASE
    if (MK_TA >= 0 && blockIdx.x == 0) { __syncthreads(); const unsigned long long ta = *(volatile LAS unsigned long long*)(F.lds + 147200 + 8), tb = *(volatile LAS unsigned long long*)(F.lds + 147200 + 16);
        const unsigned long long tgt = __builtin_amdgcn_s_memrealtime() + 4ull * (tb - ta); while (__builtin_amdgcn_s_memrealtime() < tgt) __builtin_amdgcn_s_sleep(8); }
    if (MK_TIMEPH >= 0 && blockIdx.x == 0) { const unsigned long long tgt = __builtin_amdgcn_s_memrealtime() + 4ull * (tp1 - tp0); while (__builtin_amdgcn_s_memrealtime() < tgt) __builtin_amdgcn_s_sleep(8); }
#undef IN
#undef SEAM
}

extern "C" void kernel_launch(void* const* d_in, const int* in_sizes, int n_in, void* d_out, int out_size, void* d_ws, size_t ws_size, hipStream_t stream) {
    static int grid = 0;
    if (grid == 0) {
        if (n_in != 15 || in_sizes[0] != M * D || out_size != M * D || ws_size < WS_END) { fprintf(stderr, "kernel_launch: unexpected shapes (n_in %d, in0 %d, out %d, ws %zu < %zu)\n", n_in, n_in > 0 ? in_sizes[0] : -1, out_size, ws_size, (size_t)WS_END); grid = -1; return; }
        int dev = 0, cus = 0;
        if (hipGetDevice(&dev) != hipSuccess || hipDeviceGetAttribute(&cus, hipDeviceAttributeMultiprocessorCount, dev) != hipSuccess) { grid = -1; return; }
        if (hipFuncSetAttribute((const void*)mk_fwd, hipFuncAttributeMaxDynamicSharedMemorySize, LDS_BYTES) != hipSuccess) { fprintf(stderr, "kernel_launch: hipFuncSetAttribute failed\n"); grid = -1; return; }
        int per_cu = 0;
        if (hipOccupancyMaxActiveBlocksPerMultiprocessor(&per_cu, (const void*)mk_fwd, NWAVES * 64, LDS_BYTES) != hipSuccess || per_cu < 1) fprintf(stderr, "kernel_launch: occupancy query reports %d\n", per_cu);
        (void)hipGetLastError();
        grid = cus;
    }
    if (grid < 0) return;
    (void)hipMemsetAsync((char*)d_ws + WS_CTL, 0, CTL_ZERO_BYTES, stream);
    Args a{};
    for (int i = 0; i < 15; ++i) a.in[i] = d_in[i];
    a.out = (float*)d_out; a.ws = (unsigned char*)d_ws;
#if MK_PER_PHASE
    for (int p = 0; p < NPHASE; ++p) { a.ph_lo = p; a.ph_hi = p + 1; hipLaunchKernelGGL(mk_fwd, dim3(grid), dim3(NWAVES * 64), LDS_BYTES, stream, a); }
#else
    a.ph_lo = 0; a.ph_hi = NPHASE;
    hipLaunchKernelGGL(mk_fwd, dim3(grid), dim3(NWAVES * 64), LDS_BYTES, stream, a);
#endif
}
```

```cpp
#include <hip/hip_runtime.h>
#include <cstdio>
#include <cstdint>

#ifndef MK_PER_PHASE
#define MK_PER_PHASE 0
#endif

#ifndef MK_ABL
#define MK_ABL 0
#endif
#ifndef MK_TA
#define MK_TA -1
#endif
#ifndef MK_TB
#define MK_TB -1
#endif
#define MK_STAMP(ldsbase, n) do { if (((n) == MK_TA || (n) == MK_TB) && blockIdx.x == 0 && threadIdx.x == 0) { \
    *(volatile __attribute__((address_space(3))) unsigned long long*)((ldsbase) + 147200 + ((n) == MK_TB ? 16 : 8)) = __builtin_amdgcn_s_memrealtime(); } } while (0)
namespace pg8 {
#define PG8_LAS __attribute__((address_space(3)))
typedef unsigned short bf16_t;
typedef short bf16x8 __attribute__((ext_vector_type(8)));
typedef float f32x4 __attribute__((ext_vector_type(4)));
typedef unsigned u32x4 __attribute__((ext_vector_type(4)));
constexpr int BM = 256, BK = 64, HALF = 128, HTB = HALF * BK * 2, STAGE_BYTES = 8 * HTB, NXCD = 8, WGM = 8;

__host__ __device__ __forceinline__ int lds_byte(int r, int c) { const int st = (r >> 4) * 2 + (c >> 5), rr = r & 15, cc = c & 31, ob = rr * 64 + cc * 2; return st * 1024 + (ob ^ (((ob >> 9) & 1) << 5)); }
__host__ __device__ __forceinline__ void stage_rc(int b, int& R, int& C) { const int st = b / 1024, sb = b % 1024, swz = sb ^ (((sb >> 9) & 1) << 5); R = (st >> 1) * 16 + swz / 64; C = (st & 1) * 32 + (swz % 64) / 2; }
__host__ __device__ __forceinline__ int perm32(int rho) { const int n = rho >> 4, i = rho & 15; return 8 * (i >> 2) + 4 * n + (i & 3); }

struct Unit { int pm, pn; };
struct Gemm { const bf16_t* A; const bf16_t* Bt; int M, N, K; };

struct StaticOrder {
    int nM, nN, nwg, G, c;
    __host__ __device__ void init(int M, int N, int G_, int c_) { nM = M / BM; nN = N / BM; nwg = nM * nN; G = G_; c = c_; }
    __host__ __device__ bool next(int i, Unit& u) const {
        const long L = (long)i * G + c; if (L >= nwg) return false;
        int wgid = (int)L; { const int q = nwg / NXCD, r = nwg % NXCD, xcd = wgid % NXCD, off = wgid / NXCD; wgid = (xcd < r ? xcd * (q + 1) : r * (q + 1) + (xcd - r) * q) + off; }
        const int nig = WGM * nN, gid = wgid / nig, fm = gid * WGM, gsz = (nM - fm) < WGM ? (nM - fm) : WGM;
        u.pm = fm + ((wgid % nig) % gsz); u.pn = (wgid % nig) / gsz; return true;
    }
    __device__ __forceinline__ void a_ready(const Unit&) const {}
    __device__ __forceinline__ void done(const Unit&) const {}
};

template <class Epi, class Sched, bool ALIGN_EPI = false, bool SP2 = false>
__device__ __forceinline__ void gemm_phase(PG8_LAS unsigned char* lds, const Gemm g, const Sched& S, const Epi& E, const int tid, const int sb = -100) {
    const int wid = __builtin_amdgcn_readfirstlane(tid >> 6), lane = tid & 63, wr = wid >> 2, wc = wid & 3, fr = lane & 15, fq = lane >> 4;
    const int K = g.K, nt = K / BK;
    unsigned voffA[2], voffB[2];
#pragma unroll
    for (int i = 0; i < 2; ++i) { int R, C; stage_rc(tid * 16 + i * 8192, R, C); const int Rb = Epi::PERM ? ((R & ~31) + perm32(R & 31)) : R;
        voffA[i] = (unsigned)(R * K + C) * 2u; voffB[i] = (unsigned)(Rb * K + C) * 2u; }
    const size_t kstep = (size_t)(BK * 2);
    const size_t hstep = (size_t)HALF * K * 2;
    const size_t tstep = 2 * hstep;
    const unsigned ldsw = (unsigned)wid * 1024u;
    const int aoff = lds_byte(wr * 64 + fr, fq * 8), boff = lds_byte(wc * 32 + fr, fq * 8);
#define PG8_SA(b, h) (((b) * 2 + (h)) * HTB)
#define PG8_SB(b, h) ((4 + (b) * 2 + (h)) * HTB)
#define PG8_STAGE(bufoff, gbase, voff) do { _Pragma("unroll") for (int _i = 0; _i < 2; ++_i) \
        __builtin_amdgcn_global_load_lds((const unsigned*)((const char*)(gbase) + (voff)[_i]), (PG8_LAS unsigned*)(lds + (bufoff) + ldsw + _i * 8192), 16, 0, 0); } while (0)
#define PG8_LDA(dst, b, h) do { _Pragma("unroll") for (int m = 0; m < 4; ++m) _Pragma("unroll") for (int k = 0; k < 2; ++k) dst[m][k] = *(const PG8_LAS bf16x8*)(lds + PG8_SA(b, h) + aoff + m * 2048 + k * 1024); } while (0)
#define PG8_LDB(dst, b, h) do { _Pragma("unroll") for (int n = 0; n < 2; ++n) _Pragma("unroll") for (int k = 0; k < 2; ++k) dst[n][k] = *(const PG8_LAS bf16x8*)(lds + PG8_SB(b, h) + boff + n * 2048 + k * 1024); } while (0)
#define PG8_MMA(ai, bj, At, Bt) do { __builtin_amdgcn_s_setprio(1); _Pragma("unroll") for (int m = 0; m < 4; ++m) _Pragma("unroll") for (int n = 0; n < 2; ++n) _Pragma("unroll") for (int k = 0; k < 2; ++k) \
        acc[ai][bj][m][n] = __builtin_amdgcn_mfma_f32_16x16x32_bf16(Bt[n][k], At[m][k], acc[ai][bj][m][n], 0, 0, 0); __builtin_amdgcn_s_setprio(0); } while (0)
#define PG8_WAIT_V(n) asm volatile("s_waitcnt vmcnt(" #n ")" ::: "memory")
#define PG8_WAIT_L(n) asm volatile("s_waitcnt lgkmcnt(" #n ")" ::: "memory")
#define PG8_BAR __builtin_amdgcn_s_barrier()
#define PG8_SCHED __builtin_amdgcn_sched_barrier(0)
    Unit cur, nxt; int ui = 0;
    if (!S.next(0, cur)) return;
    f32x4 acc[2][2][4][2];
#pragma unroll
    for (int a = 0; a < 2; ++a)
#pragma unroll
        for (int b = 0; b < 2; ++b)
#pragma unroll
            for (int m = 0; m < 4; ++m)
#pragma unroll
                for (int n = 0; n < 2; ++n) acc[a][b][m][n] = (f32x4){0.f, 0.f, 0.f, 0.f};
    bf16x8 At[4][2], B0[2][2], B1[2][2];
    const char* cA = (const char*)g.A + (size_t)cur.pm * tstep; const char* cB = (const char*)g.Bt + (size_t)cur.pn * tstep;
    S.a_ready(cur);
    if constexpr (SP2) {
        PG8_STAGE(PG8_SB(0, 0), cB, voffB); PG8_STAGE(PG8_SB(0, 1), cB + hstep, voffB); PG8_STAGE(PG8_SA(0, 0), cA, voffA); PG8_STAGE(PG8_SA(0, 1), cA + hstep, voffA);
        if (wr == 1) PG8_BAR;
        PG8_WAIT_V(2); PG8_BAR;
        PG8_STAGE(PG8_SB(1, 0), cB + kstep, voffB); PG8_STAGE(PG8_SA(1, 0), cA + kstep, voffA); PG8_STAGE(PG8_SB(1, 1), cB + hstep + kstep, voffB);
        PG8_WAIT_V(6); PG8_BAR;
    } else {
        PG8_STAGE(PG8_SB(0, 0), cB, voffB); PG8_STAGE(PG8_SA(0, 0), cA, voffA); PG8_STAGE(PG8_SB(0, 1), cB + hstep, voffB); PG8_STAGE(PG8_SA(0, 1), cA + hstep, voffA);
        if (wr == 1) PG8_BAR;
        PG8_WAIT_V(4); PG8_BAR;
        PG8_STAGE(PG8_SB(1, 0), cB + kstep, voffB); PG8_STAGE(PG8_SA(1, 0), cA + kstep, voffA); PG8_STAGE(PG8_SB(1, 1), cB + hstep + kstep, voffB);
        PG8_WAIT_V(6); PG8_BAR;
    }
    MK_STAMP(lds, sb + 0);
    for (;;) {
        const bool has_next = S.next(ui + 1, nxt);
        const char* nA = has_next ? (const char*)g.A + (size_t)nxt.pm * tstep : cA; const char* nB = has_next ? (const char*)g.Bt + (size_t)nxt.pn * tstep : cB;
        for (int t = 0; t < nt; t += 2) {
            const bool last = (t == nt - 2);
            const char* a1 = cA + (size_t)(t + 1) * kstep;
            const char* a2 = last ? nA : cA + (size_t)(t + 2) * kstep; const char* b2 = last ? nB : cB + (size_t)(t + 2) * kstep;
            const char* a3 = a2 + kstep; const char* b3 = b2 + kstep;
            if (last && has_next) S.a_ready(nxt);
            if constexpr (SP2) {
            PG8_LDB(B0, 0, 0); PG8_LDB(B1, 0, 1); PG8_SCHED; PG8_LDA(At, 0, 0); PG8_STAGE(PG8_SA(1, 1), a1 + hstep, voffA);
            PG8_WAIT_V(8); PG8_WAIT_L(0); PG8_BAR; PG8_MMA(0, 0, At, B0); PG8_MMA(0, 1, At, B1); PG8_BAR; PG8_SCHED;
            PG8_LDA(At, 0, 1); PG8_STAGE(PG8_SB(0, 0), b2, voffB); PG8_STAGE(PG8_SB(0, 1), b2 + hstep, voffB); PG8_STAGE(PG8_SA(0, 0), a2, voffA);
            PG8_WAIT_V(8); PG8_WAIT_L(0); PG8_BAR; PG8_MMA(1, 0, At, B0); PG8_MMA(1, 1, At, B1); PG8_BAR; PG8_SCHED;
            PG8_LDB(B0, 1, 0); PG8_LDB(B1, 1, 1); PG8_SCHED; PG8_LDA(At, 1, 0); PG8_STAGE(PG8_SA(0, 1), a2 + hstep, voffA);
            PG8_WAIT_V(8); PG8_WAIT_L(0); PG8_BAR; PG8_MMA(0, 0, At, B0); PG8_MMA(0, 1, At, B1); PG8_BAR; PG8_SCHED;
            PG8_LDA(At, 1, 1); PG8_STAGE(PG8_SB(1, 0), b3, voffB); PG8_STAGE(PG8_SB(1, 1), b3 + hstep, voffB); PG8_STAGE(PG8_SA(1, 0), a3, voffA);
            PG8_WAIT_V(8); PG8_WAIT_L(0); PG8_BAR; PG8_MMA(1, 0, At, B0); PG8_MMA(1, 1, At, B1); PG8_BAR; PG8_SCHED;
            } else {
            PG8_LDB(B0, 0, 0); PG8_SCHED; PG8_LDA(At, 0, 0); PG8_STAGE(PG8_SA(1, 1), a1 + hstep, voffA);
            PG8_WAIT_L(8); PG8_BAR; PG8_WAIT_L(0); PG8_MMA(0, 0, At, B0); PG8_BAR; PG8_SCHED;
            PG8_LDB(B1, 0, 1); PG8_STAGE(PG8_SB(0, 0), b2, voffB);
            PG8_BAR; PG8_WAIT_L(0); PG8_MMA(0, 1, At, B1); PG8_BAR;
            PG8_LDA(At, 0, 1); PG8_STAGE(PG8_SA(0, 0), a2, voffA);
            PG8_BAR; PG8_WAIT_L(0); PG8_MMA(1, 0, At, B0); PG8_BAR; PG8_SCHED;
            PG8_STAGE(PG8_SB(0, 1), b2 + hstep, voffB);
            PG8_WAIT_V(6); PG8_BAR; PG8_MMA(1, 1, At, B1); PG8_BAR;
            PG8_LDB(B0, 1, 0); PG8_SCHED; PG8_LDA(At, 1, 0); PG8_STAGE(PG8_SA(0, 1), a2 + hstep, voffA);
            PG8_WAIT_L(8); PG8_BAR; PG8_WAIT_L(0); PG8_MMA(0, 0, At, B0); PG8_BAR; PG8_SCHED;
            PG8_LDB(B1, 1, 1); PG8_STAGE(PG8_SB(1, 0), b3, voffB);
            PG8_BAR; PG8_WAIT_L(0); PG8_MMA(0, 1, At, B1); PG8_BAR;
            PG8_LDA(At, 1, 1); PG8_STAGE(PG8_SA(1, 0), a3, voffA);
            PG8_BAR; PG8_WAIT_L(0); PG8_MMA(1, 0, At, B0); PG8_BAR; PG8_SCHED;
            PG8_STAGE(PG8_SB(1, 1), b3 + hstep, voffB);
            PG8_WAIT_V(6); PG8_BAR; PG8_MMA(1, 1, At, B1); PG8_BAR;
            }
        }
        if constexpr (ALIGN_EPI) { if (wr == 0) PG8_BAR; }
        if (ui == 0) MK_STAMP(lds, sb + 1);
        E(acc, cur, ui, wr, wc, fr, fq); S.done(cur);
        if (ui == 0) MK_STAMP(lds, sb + 2);
        if (!has_next) break;
#pragma unroll
        for (int a = 0; a < 2; ++a)
#pragma unroll
            for (int b = 0; b < 2; ++b)
#pragma unroll
                for (int m = 0; m < 4; ++m)
#pragma unroll
                    for (int n = 0; n < 2; ++n) acc[a][b][m][n] = (f32x4){0.f, 0.f, 0.f, 0.f};
        cur = nxt; cA = nA; cB = nB; ++ui;
        if constexpr (ALIGN_EPI) { if (wr == 1) PG8_BAR; }
    }
    MK_STAMP(lds, sb + 3);
    PG8_WAIT_V(0);
    if constexpr (!ALIGN_EPI) { if (wr == 0) PG8_BAR; }
    PG8_BAR;
    MK_STAMP(lds, sb + 4);
#undef PG8_SA
#undef PG8_SB
#undef PG8_STAGE
#undef PG8_LDA
#undef PG8_LDB
#undef PG8_MMA
#undef PG8_WAIT_V
#undef PG8_WAIT_L
#undef PG8_BAR
#undef PG8_SCHED
}
}

constexpr int NWAVES = 8;
constexpr int BATCH = 2, T = 4096, D = 2048, M = BATCH * T;
constexpr int HRET = 8, HKV = 2, FF = 5632;
constexpr int NPB = 5632;
constexpr int NIDXP = 1280;
constexpr int NIN = 6736, NINP = 6912;
constexpr int C_RQ = 0, C_RK = 1024, C_RV = 2048, C_RG = 3072, C_AQ = 4096, C_AK = 5120, C_AV = 5376;
constexpr float NORM_EPS = 1e-6f;

constexpr size_t MiB = 1u << 20;
constexpr size_t WS_CTL = 0, CTL_ZERO_BYTES = 65536;
constexpr size_t WS_TAB = 1 * MiB;
constexpr size_t WS_WGU = 5 * MiB;
constexpr size_t WS_WD = 49 * MiB;
constexpr size_t WS_WIN = 71 * MiB;
constexpr size_t WS_WOUT = 98 * MiB;
constexpr size_t WS_A = 106 * MiB;
constexpr size_t WS_PROJ = 138 * MiB;
constexpr size_t WS_PIDX = 226 * MiB;
constexpr size_t WS_RKT = 266 * MiB;
constexpr size_t WS_RVT = 282 * MiB;
constexpr size_t WS_AVT = 298 * MiB;
constexpr size_t WS_IQ = 302 * MiB;
constexpr size_t WS_IK = 318 * MiB;
constexpr size_t WS_IW = 319 * MiB;
constexpr size_t WS_KV = 320 * MiB;
constexpr size_t WS_ST = 352 * MiB;
constexpr size_t WS_MASK = 368 * MiB;
constexpr size_t WS_SSQ = 372 * MiB;
constexpr size_t WS_TAB2 = 373 * MiB;
constexpr size_t WS_END = 375 * MiB;
constexpr int CW_BAR = 4096;

constexpr int RING_BYTES = 131072;
constexpr int LDS_BYTES = 147456;
constexpr int LDSCTL_OFF = LDS_BYTES - 512, MISC_OFF = LDSCTL_OFF + 320;

#define GAS __attribute__((address_space(1)))
#define LAS __attribute__((address_space(3)))
typedef unsigned short bf16;
typedef _Float16 f16;
typedef _Float16 half8 __attribute__((ext_vector_type(8)));
typedef unsigned v4u __attribute__((ext_vector_type(4)));
typedef unsigned v2u __attribute__((ext_vector_type(2)));
typedef float f32x2 __attribute__((ext_vector_type(2)));
typedef float f32x4 __attribute__((ext_vector_type(4)));
typedef float f32x16 __attribute__((ext_vector_type(16)));
typedef short bf16x8 __attribute__((ext_vector_type(8)));
typedef __bf16 bf16x2_t __attribute__((ext_vector_type(2)));
typedef GAS unsigned gu32;
#define LDS_WAIT() asm volatile("s_waitcnt lgkmcnt(0)" ::: "memory")
__device__ __forceinline__ unsigned pk2(float lo, float hi) { f32x2 v = {lo, hi}; bf16x2_t b = __builtin_convertvector(v, bf16x2_t); return __builtin_bit_cast(unsigned, b); }
__device__ __forceinline__ float bflo(unsigned w) { return __uint_as_float(w << 16); }
__device__ __forceinline__ float bfhi(unsigned w) { return __uint_as_float(w & 0xffff0000u); }
__device__ __forceinline__ float silu_f(float g) { return g * __builtin_amdgcn_rcpf(1.f + __builtin_amdgcn_exp2f(-1.4426950408889634f * g)); }

#define XB_TMO      128
#define XB_XCNT(j)  (256  + 64 * (j))
#define XB_XSUB(j)  (1280 + 64 * (j))
#define XB_XGEN(j)  (2304 + 64 * (j))
#define XB_TOP      3328
#define XB_TOPGEN   3392
#define XCD_BAR_WORDS 3456
#define XB_SPIN_CAP (1u << 22)
__device__ __forceinline__ unsigned xb_ld(unsigned* p)              { return __hip_atomic_load(p, __ATOMIC_RELAXED, __HIP_MEMORY_SCOPE_AGENT); }
__device__ __forceinline__ unsigned xb_add(unsigned* p, unsigned v) { return __hip_atomic_fetch_add(p, v, __ATOMIC_RELAXED, __HIP_MEMORY_SCOPE_AGENT); }
__device__ __forceinline__ unsigned xb_xcc_id() { return (unsigned)__builtin_amdgcn_s_getreg((3 << 11) | 20) & 0xFu; }
#define XB_SPIN(cond, bar) do { unsigned _sp = 0; while (cond) { __builtin_amdgcn_s_sleep(1); \
    if ((++_sp & 255u) == 0u) { if (xb_ld(&(bar)[XB_TMO])) break; if (_sp > XB_SPIN_CAP) { atomicAdd(&(bar)[XB_TMO], 1u); break; } } } } while (0)
struct XcdBarrier { unsigned* bar; unsigned x; volatile LAS unsigned* st; };
__device__ __forceinline__ XcdBarrier xcd_barrier_post(unsigned* bar, volatile LAS unsigned* st) {
    XcdBarrier b; b.bar = bar; b.x = xb_xcc_id(); b.st = st;
    if (threadIdx.x == 0) (void)xb_add(&bar[XB_XCNT(b.x)], 1u);
    return b;
}
__device__ __forceinline__ void xcd_barrier_complete(unsigned* bar, unsigned x, unsigned& nloc, unsigned& nx) {
    const unsigned G = gridDim.x * gridDim.y * gridDim.z;
    unsigned sum, cnt, mine, sp = 0u;
    for (;;) {
        sum = 0u; cnt = 0u; mine = 0u;
#pragma unroll
        for (unsigned j = 0; j < 16; ++j) { const unsigned c = xb_ld(&bar[XB_XCNT(j)]); sum += c; cnt += (c > 0u) ? 1u : 0u; mine = (j == x) ? c : mine; }
        if (sum == G) break;
        __builtin_amdgcn_s_sleep(1);
        if ((++sp & 255u) == 0u) { if (xb_ld(&bar[XB_TMO])) break; if (sp > XB_SPIN_CAP) { atomicAdd(&bar[XB_TMO], 1u); break; } }
    }
    nloc = mine > 0u ? mine : 1u; nx = cnt > 0u ? cnt : 1u;
}
__device__ __forceinline__ void xcd_barrier(const XcdBarrier& b) {
    asm volatile("s_waitcnt vmcnt(0)" ::: "memory");
    __syncthreads();
    if (threadIdx.x == 0) {
        unsigned* bar = b.bar;
        __builtin_amdgcn_s_waitcnt(0);
        unsigned nloc = b.st[0], nx = b.st[1];
        if (nloc == 0u) { xcd_barrier_complete(bar, b.x, nloc, nx); b.st[0] = nloc; b.st[1] = nx; }
        const unsigned old = xb_add(&bar[XB_XSUB(b.x)], 1u);
        const unsigned gen = old / nloc;
        if (old + 1u == (gen + 1u) * nloc) {
            __builtin_amdgcn_fence(__ATOMIC_RELEASE, "agent");
            asm volatile("s_waitcnt vmcnt(0)" ::: "memory");
            const unsigned og = xb_add(&bar[XB_TOP], 1u);
            const unsigned tg = og / nx;
            if (og + 1u == (tg + 1u) * nx) xb_add(&bar[XB_TOPGEN], 1u);
            else XB_SPIN(xb_ld(&bar[XB_TOPGEN]) == tg, bar);
            __builtin_amdgcn_fence(__ATOMIC_ACQUIRE, "agent");
            xb_add(&bar[XB_XGEN(b.x)], 1u);
            asm volatile("s_waitcnt vmcnt(0)" ::: "memory");
        } else {
            XB_SPIN(xb_ld(&bar[XB_XGEN(b.x)]) == gen, bar);
            __builtin_amdgcn_fence(__ATOMIC_ACQUIRE, "agent");
            asm volatile("s_waitcnt vmcnt(0)" ::: "memory");
        }
    }
    __syncthreads();
}

struct Frame {
    LAS unsigned char* lds;
    int tid, lane, wave;
    int bid, G;
    const float* x; const int* pos;
    const float *n1, *wg1, *wu1, *wd1, *nmix, *win, *nret, *wout, *n2, *wg2, *wu2, *wd2, *nfin;
    float* X;
    unsigned char* ws;
};

__device__ __forceinline__ float wave_sum(float v) {
#pragma unroll
    for (int o = 1; o < 64; o <<= 1) v += __shfl_xor(v, o);
    return v;
}

__device__ __forceinline__ float xor16_sum(float m);
__device__ __forceinline__ float xor32_sum(float m);
constexpr int RS_OFF = RING_BYTES, RS_MAXU = 6;
__device__ __forceinline__ void load_rstd_panels(Frame& F, const pg8::StaticOrder& S, const float* ssq) {
    LAS float* rs = (LAS float*)(F.lds + RS_OFF);
    const int r = F.tid >> 1, hf = F.tid & 1;
    f32x4 p[RS_MAXU][4]; bool ok[RS_MAXU];
#pragma unroll
    for (int i = 0; i < RS_MAXU; ++i) { pg8::Unit u; ok[i] = S.next(i, u);
        if (ok[i]) { const f32x4* q = (const f32x4*)(ssq + (size_t)(u.pm * 256 + r) * 32 + 16 * hf);
#pragma unroll
            for (int k = 0; k < 4; ++k) p[i][k] = q[k]; } }
#pragma unroll
    for (int i = 0; i < RS_MAXU; ++i) if (ok[i]) {
        const f32x4 s4 = (p[i][0] + p[i][1]) + (p[i][2] + p[i][3]);
        float s = (s4.x + s4.y) + (s4.z + s4.w);
        s += __shfl_xor(s, 1);
        if (hf == 0) rs[i * 256 + r] = 1.0f / sqrtf(s * (1.f / D) + NORM_EPS);
    }
    __syncthreads();
}
struct EpiSwiGLU {
    static constexpr bool PERM = true;
    bf16* H; const LAS float* rs;
    __device__ __forceinline__ void operator()(const f32x4 (&acc)[2][2][4][2], const pg8::Unit& u, int ui, int wr, int wc, int fr, int fq) const {
        const int row0 = u.pm * 256 + wr * 64 + fr, col0 = u.pn * 128 + wc * 32 + 8 * fq;
#pragma unroll
        for (int ai = 0; ai < 2; ++ai)
#pragma unroll
            for (int m = 0; m < 4; ++m) {
                const int row = row0 + ai * 128 + m * 16;
                const float r = rs[ui * 256 + ai * 128 + wr * 64 + m * 16 + fr];
                bf16* rowp = H + (size_t)row * FF + col0;
                const f32x4 g0 = acc[ai][0][m][0] * r, g1 = acc[ai][0][m][1] * r, u0 = acc[ai][1][m][0] * r, u1 = acc[ai][1][m][1] * r;
                v4u w;
                w.x = pk2(silu_f(g0[0]) * u0[0], silu_f(g0[1]) * u0[1]); w.y = pk2(silu_f(g0[2]) * u0[2], silu_f(g0[3]) * u0[3]);
                w.z = pk2(silu_f(g1[0]) * u1[0], silu_f(g1[1]) * u1[1]); w.w = pk2(silu_f(g1[2]) * u1[2], silu_f(g1[3]) * u1[3]);
                *(v4u*)rowp = w;
            }
    }
};
template <bool BASEF> struct EpiResid {
    static constexpr bool PERM = true;
    const float* basef; bf16* Ab; float alpha; float* ssq;
    __device__ __forceinline__ void operator()(const f32x4 (&acc)[2][2][4][2], const pg8::Unit& u, int ui, int wr, int wc, int fr, int fq) const {
        const int row0 = u.pm * 256 + wr * 64 + fr, col0 = u.pn * 256 + wc * 32 + 8 * fq;
#pragma unroll
        for (int ai = 0; ai < 2; ++ai) {
            f32x4 bf0[4][2], bf1[4][2]; v4u bw[4][2];
#pragma unroll
            for (int m = 0; m < 4; ++m)
#pragma unroll
                for (int bj = 0; bj < 2; ++bj) {
                    const size_t off = (size_t)(row0 + ai * 128 + m * 16) * D + col0 + bj * 128;
                    if constexpr (BASEF) { bf0[m][bj] = __builtin_nontemporal_load((const f32x4*)(basef + off)); bf1[m][bj] = __builtin_nontemporal_load((const f32x4*)(basef + off + 4)); }
                    else bw[m][bj] = *(const v4u*)(Ab + off);
                }
            asm volatile("" ::: "memory");
#pragma unroll
            for (int m = 0; m < 4; ++m) {
                const int row = row0 + ai * 128 + m * 16;
                float sq = 0.f;
#pragma unroll
                for (int bj = 0; bj < 2; ++bj) {
                    const size_t off = (size_t)row * D + col0 + bj * 128;
                    f32x4 b0, b1;
                    if constexpr (BASEF) { b0 = bf0[m][bj]; b1 = bf1[m][bj]; }
                    else { const v4u w = bw[m][bj]; b0 = (f32x4){bflo(w.x), bfhi(w.x), bflo(w.y), bfhi(w.y)}; b1 = (f32x4){bflo(w.z), bfhi(w.z), bflo(w.w), bfhi(w.w)}; }
                    const f32x4 v0 = b0 + acc[ai][bj][m][0] * alpha, v1 = b1 + acc[ai][bj][m][1] * alpha;
                    sq += (v0.x * v0.x + v0.y * v0.y) + (v0.z * v0.z + v0.w * v0.w) + (v1.x * v1.x + v1.y * v1.y) + (v1.z * v1.z + v1.w * v1.w);
                    v4u w; w.x = pk2(v0.x, v0.y); w.y = pk2(v0.z, v0.w); w.z = pk2(v1.x, v1.y); w.w = pk2(v1.z, v1.w);
                    *(v4u*)(Ab + off) = w;
                }
                sq = xor16_sum(sq); sq = xor32_sum(sq);
                if (fq == 0) ssq[(size_t)row * 32 + u.pn * 4 + wc] = sq;
            }
        }
    }
};
__device__ __forceinline__ float lg2_gamma(int h);
typedef _Float16 half4 __attribute__((ext_vector_type(4)));
struct EpiProj {
    static constexpr bool PERM = true;
    unsigned char* ws; const LAS float* rs;
    __device__ __forceinline__ void operator()(const f32x4 (&acc)[2][2][4][2], const pg8::Unit& u, int ui, int wr, int wc, int fr, int fq) const {
        const int row0 = u.pm * 256 + wr * 64 + fr, t = u.pn;
        bf16* PROJ = (bf16*)(ws + WS_PROJ);
        if (t < 8 || (t >= 16 && t <= 20)) {
            const int typ = t < 4 ? 0 : t < 8 ? 1 : t < 20 ? 2 : 3;
            const int tb = typ == 0 ? 0 : typ == 1 ? 4 : typ == 2 ? 16 : 20, cb = typ == 0 ? C_RQ : typ == 1 ? C_RK : typ == 2 ? C_AQ : C_AK;
            const int hd = 2 * (t - tb) + (wc >> 1), i0 = 32 * (wc & 1) + 8 * fq;
            const float lg = lg2_gamma(hd);
            const float2* TAB = (const float2*)(ws + WS_TAB);
#pragma unroll
            for (int ai = 0; ai < 2; ++ai) {
#pragma unroll
              for (int mp = 0; mp < 2; ++mp) {
                f32x4 cst[2][4];
#pragma unroll
                for (int mm = 0; mm < 2; ++mm) { const f32x4* tp = (const f32x4*)(TAB + (size_t)(row0 + ai * 128 + (2 * mp + mm) * 16) * 64 + i0);
#pragma unroll
                    for (int k = 0; k < 4; ++k) cst[mm][k] = tp[k]; }
                asm volatile("" ::: "memory");
#pragma unroll
                for (int mm = 0; mm < 2; ++mm) {
                    const int m = 2 * mp + mm;
                    const int row = row0 + ai * 128 + m * 16;
                    const float r = rs[ui * 256 + ai * 128 + wr * 64 + m * 16 + fr];
                    const f32x4 c01 = cst[mm][0], c23 = cst[mm][1], c45 = cst[mm][2], c67 = cst[mm][3];
                    const float pcf = (float)((row & 127) + 1);
                    const float sc = r * (typ == 0 ? __builtin_amdgcn_exp2f(lg * pcf) : typ == 1 ? 0.08838834764831845f * __builtin_amdgcn_exp2f(-lg * pcf) : typ == 2 ? 0.08838834764831845f * 1.4426950408889634f : 1.f);
                    const f32x4 a0 = acc[ai][0][m][0], a1 = acc[ai][0][m][1], b0 = acc[ai][1][m][0], b1 = acc[ai][1][m][1];
                    v4u o1, o2;
                    o1.x = pk2((a0.x * c01.x - b0.x * c01.y) * sc, (a0.y * c01.z - b0.y * c01.w) * sc); o1.y = pk2((a0.z * c23.x - b0.z * c23.y) * sc, (a0.w * c23.z - b0.w * c23.w) * sc);
                    o1.z = pk2((a1.x * c45.x - b1.x * c45.y) * sc, (a1.y * c45.z - b1.y * c45.w) * sc); o1.w = pk2((a1.z * c67.x - b1.z * c67.y) * sc, (a1.w * c67.z - b1.w * c67.w) * sc);
                    o2.x = pk2((b0.x * c01.x + a0.x * c01.y) * sc, (b0.y * c01.z + a0.y * c01.w) * sc); o2.y = pk2((b0.z * c23.x + a0.z * c23.y) * sc, (b0.w * c23.z + a0.w * c23.w) * sc);
                    o2.z = pk2((b1.x * c45.x + a1.x * c45.y) * sc, (b1.y * c45.z + a1.y * c45.w) * sc); o2.w = pk2((b1.z * c67.x + a1.z * c67.y) * sc, (b1.w * c67.z + a1.w * c67.w) * sc);
                    bf16* rowp = PROJ + (size_t)row * NPB + cb + hd * 128 + i0;
                    *(v4u*)rowp = o1; *(v4u*)(rowp + 64) = o2;
                }
              }
            }
        } else if (t < 22) {
            const bool gate = (t >= 12 && t < 16);
            const int col0 = t * 256 + wc * 32 + 8 * fq;
#pragma unroll
            for (int ai = 0; ai < 2; ++ai)
#pragma unroll
                for (int m = 0; m < 4; ++m) {
                    const int row = row0 + ai * 128 + m * 16;
                    const float r = rs[ui * 256 + ai * 128 + wr * 64 + m * 16 + fr];
                    bf16* rowp = PROJ + (size_t)row * NPB + col0;
#pragma unroll
                    for (int bj = 0; bj < 2; ++bj) {
                        f32x4 v0 = acc[ai][bj][m][0] * r, v1 = acc[ai][bj][m][1] * r;
                        if (gate) { v0 = (f32x4){silu_f(v0.x), silu_f(v0.y), silu_f(v0.z), silu_f(v0.w)}; v1 = (f32x4){silu_f(v1.x), silu_f(v1.y), silu_f(v1.z), silu_f(v1.w)}; }
                        v4u w; w.x = pk2(v0[0], v0[1]); w.y = pk2(v0[2], v0[3]); w.z = pk2(v1[0], v1[1]); w.w = pk2(v1[2], v1[3]);
                        *(v4u*)(rowp + bj * 128) = w;
                    }
                }
        } else if (t < 26 || wc == 0) {
            const bool isq = t < 26;
            const int hd = 4 * (t - 22) + wc, i0 = 8 * fq;
            const float2* TAB2 = (const float2*)(ws + WS_TAB2);
            f16* OUT = isq ? (f16*)(ws + WS_IQ) : (f16*)(ws + WS_IK);
            const int ld = isq ? 1024 : 64, cb = isq ? hd * 64 : 0;
            const float s8 = isq ? 0.125f : 1.f;
#pragma unroll
            for (int ai = 0; ai < 2; ++ai) {
#pragma unroll
              for (int mp = 0; mp < 2; ++mp) {
                f32x4 cst[2][4];
#pragma unroll
                for (int mm = 0; mm < 2; ++mm) { const f32x4* tp = (const f32x4*)(TAB2 + (size_t)(row0 + ai * 128 + (2 * mp + mm) * 16) * 32 + i0);
#pragma unroll
                    for (int k = 0; k < 4; ++k) cst[mm][k] = tp[k]; }
                asm volatile("" ::: "memory");
#pragma unroll
                for (int mm = 0; mm < 2; ++mm) {
                    const int m = 2 * mp + mm;
                    const int row = row0 + ai * 128 + m * 16;
                    const float sc = rs[ui * 256 + ai * 128 + wr * 64 + m * 16 + fr] * s8;
                    const f32x4 c01 = cst[mm][0], c23 = cst[mm][1], c45 = cst[mm][2], c67 = cst[mm][3];
                    const f32x4 a0 = acc[ai][0][m][0], a1 = acc[ai][0][m][1], b0 = acc[ai][1][m][0], b1 = acc[ai][1][m][1];
                    half8 h1, h2;
                    h1[0] = (f16)((a0.x * c01.x - b0.x * c01.y) * sc); h1[1] = (f16)((a0.y * c01.z - b0.y * c01.w) * sc); h1[2] = (f16)((a0.z * c23.x - b0.z * c23.y) * sc); h1[3] = (f16)((a0.w * c23.z - b0.w * c23.w) * sc);
                    h1[4] = (f16)((a1.x * c45.x - b1.x * c45.y) * sc); h1[5] = (f16)((a1.y * c45.z - b1.y * c45.w) * sc); h1[6] = (f16)((a1.z * c67.x - b1.z * c67.y) * sc); h1[7] = (f16)((a1.w * c67.z - b1.w * c67.w) * sc);
                    h2[0] = (f16)((b0.x * c01.x + a0.x * c01.y) * sc); h2[1] = (f16)((b0.y * c01.z + a0.y * c01.w) * sc); h2[2] = (f16)((b0.z * c23.x + a0.z * c23.y) * sc); h2[3] = (f16)((b0.w * c23.z + a0.w * c23.w) * sc);
                    h2[4] = (f16)((b1.x * c45.x + a1.x * c45.y) * sc); h2[5] = (f16)((b1.y * c45.z + a1.y * c45.w) * sc); h2[6] = (f16)((b1.z * c67.x + a1.z * c67.y) * sc); h2[7] = (f16)((b1.w * c67.z + a1.w * c67.w) * sc);
                    f16* rowp = OUT + (size_t)row * ld + cb + i0;
                    *(half8*)rowp = h1; *(half8*)(rowp + 32) = h2;
                }
              }
            }
        } else if (wc == 1 && fq < 2) {
#pragma unroll
            for (int ai = 0; ai < 2; ++ai)
#pragma unroll
                for (int m = 0; m < 4; ++m) {
                    const int row = row0 + ai * 128 + m * 16;
                    const float sc = rs[ui * 256 + ai * 128 + wr * 64 + m * 16 + fr] * 0.25f;
                    float* rowp = (float*)(ws + WS_IW) + (size_t)row * 16 + 8 * fq;
                    *(f32x4*)rowp = acc[ai][0][m][0] * sc; *(f32x4*)(rowp + 4) = acc[ai][0][m][1] * sc;
                }
        }
    }
};

__device__ __forceinline__ int win_row(int n) {
    if (n < 2048 || (n >= 4096 && n < 5376)) { const int base = n < 1024 ? 0 : n < 2048 ? 1024 : n < 5120 ? 4096 : 5120; const int rel = n - base, head = rel >> 7, half = (rel >> 6) & 1, i = rel & 63;
        return base + 256 * (head >> 1) + 128 * half + 64 * (head & 1) + i; }
    if (n < 5632) return n;
    if (n < 6656) { const int rel = n - 5632, head = rel >> 6, half = (rel >> 5) & 1, i = rel & 31; return 5632 + 256 * (head >> 2) + 128 * half + 32 * (head & 3) + i; }
    if (n < 6720) { const int rel = n - 6656; return 6656 + 128 * (rel >> 5) + (rel & 31); }
    return 6656 + 32 + (n - 6720);
}
struct CvItem { const float* W; const float* g; bf16* WT; int K, N, k0, n0, gu, up; };
constexpr int CV_G = (D / 64) * (FF / 256), CV_D = (FF / 64) * (D / 256), CV_I = (D / 64) * ((NIN + 255) / 256), CV_O = (D / 64) * (D / 256);
constexpr int CV_TILE = 64 * 257 * 4;
template <int JOB> __device__ __forceinline__ constexpr int cv_total() { return JOB == 0 ? 2 * CV_G : JOB == 1 ? CV_D + CV_I : JOB == 2 ? 2 * CV_G + CV_O : CV_D; }
template <int JOB> __device__ __forceinline__ void cv_decode(const Frame& F, int it, CvItem& x) {
    x.gu = 0; x.up = 0; x.g = nullptr;
    if (JOB == 0 || JOB == 2) {
        const float* wg = JOB == 0 ? F.wg1 : F.wg2; const float* wu = JOB == 0 ? F.wu1 : F.wu2;
        if (it < 2 * CV_G) { const int up = it >= CV_G, r = up ? it - CV_G : it, kb = r / (FF / 256), nb = r % (FF / 256);
            x.W = up ? wu : wg; x.g = JOB == 0 ? F.n1 : F.n2; x.WT = ((bf16*)(F.ws + WS_WGU)); x.K = D; x.N = FF; x.k0 = 64 * kb; x.n0 = 256 * nb; x.gu = 1; x.up = up; return; }
        it -= 2 * CV_G;
        { const int kb = it / (D / 256), nb = it % (D / 256); x.W = F.wout; x.WT = ((bf16*)(F.ws + WS_WOUT)); x.K = D; x.N = D; x.k0 = 64 * kb; x.n0 = 256 * nb; }
    } else {
        if (it < CV_D) { const int kb = it / (D / 256), nb = it % (D / 256); x.W = JOB == 1 ? F.wd1 : F.wd2; x.WT = ((bf16*)(F.ws + WS_WD)); x.K = FF; x.N = D; x.k0 = 64 * kb; x.n0 = 256 * nb; return; }
        it -= CV_D;
        constexpr int NBI = (NIN + 255) / 256;
        { const int kb = it / NBI, nb = it % NBI; x.W = F.win; x.g = F.nmix; x.WT = ((bf16*)(F.ws + WS_WIN)); x.K = D; x.N = NIN; x.k0 = 64 * kb; x.n0 = 256 * nb; x.gu = 2; }
    }
}
__device__ __forceinline__ void cv_load(const CvItem& x, f32x4 (&v)[8], int wave, int lane) {
    const bool okc = (x.n0 + 4 * lane) < x.N;
    const float* p = x.W + (size_t)(x.k0 + 8 * wave) * x.N + x.n0 + 4 * lane;
#pragma unroll
    for (int i = 0; i < 8; ++i) v[i] = okc ? __builtin_nontemporal_load((const f32x4*)(p + (size_t)i * x.N)) : (f32x4){0.f, 0.f, 0.f, 0.f};
}
__device__ __forceinline__ void cv_gain(const CvItem& x, f32x4 (&gq)[2], int wave) {
    if (x.g) { const f32x4* q = (const f32x4*)(x.g + x.k0 + 8 * wave); gq[0] = q[0]; gq[1] = q[1]; }
    else { gq[0] = (f32x4){1.f, 1.f, 1.f, 1.f}; gq[1] = gq[0]; }
}
template <int JOB> __device__ __forceinline__ void convert_job(Frame& F, int w, int nw) {
    const int lane = F.lane, wave = F.wave, c = lane & 7, nn = lane >> 3;
    constexpr int total = cv_total<JOB>();
    CvItem x0, x1, x2; f32x4 v0[8], v1[8], v2[8], g0[2], g1[2], g2[2];
    if (w < total) { cv_decode<JOB>(F, w, x0); cv_load(x0, v0, wave, lane); cv_gain(x0, g0, wave); }
    if (w + nw < total) { cv_decode<JOB>(F, w + nw, x1); cv_load(x1, v1, wave, lane); cv_gain(x1, g1, wave); }
    int par = 0;
    for (int it = w; it < total; it += nw) {
        LAS float* tile = (LAS float*)(F.lds + par * CV_TILE);
#pragma unroll
        for (int i = 0; i < 8; ++i) { LAS float* s = tile + (8 * wave + i) * 257 + 4 * lane; const float gs = g0[i >> 2][i & 3]; s[0] = v0[i].x * gs; s[1] = v0[i].y * gs; s[2] = v0[i].z * gs; s[3] = v0[i].w * gs; }
        if (it + 2 * nw < total) { cv_decode<JOB>(F, it + 2 * nw, x2); cv_load(x2, v2, wave, lane); cv_gain(x2, g2, wave); }
        __syncthreads();
#pragma unroll
        for (int q = 0; q < 4; ++q) {
            const int n = 32 * wave + nn + 8 * q, ncol = x0.n0 + n;
            const LAS float* s = tile + (8 * c) * 257 + n;
            v4u o; o.x = pk2(s[0 * 257], s[1 * 257]); o.y = pk2(s[2 * 257], s[3 * 257]); o.z = pk2(s[4 * 257], s[5 * 257]); o.w = pk2(s[6 * 257], s[7 * 257]);
            const int drow = x0.gu == 1 ? (((ncol >> 7) << 8) + (ncol & 127) + (x0.up ? 128 : 0)) : x0.gu == 2 ? win_row(ncol) : ncol;
            if (ncol < x0.N) __builtin_nontemporal_store(o, (v4u*)(x0.WT + (size_t)drow * x0.K + x0.k0 + 8 * c));
        }
        x0 = x1; x1 = x2;
#pragma unroll
        for (int i = 0; i < 8; ++i) { v0[i] = v1[i]; v1[i] = v2[i]; }
        g0[0] = g1[0]; g0[1] = g1[1]; g1[0] = g2[0]; g1[1] = g2[1];
        par ^= 1;
    }
    __syncthreads();
    if (JOB == 1) {
        v4u* z0 = (v4u*)(((bf16*)(F.ws + WS_WIN)) + (size_t)6704 * D); v4u* z1 = (v4u*)(((bf16*)(F.ws + WS_WIN)) + (size_t)6816 * D);
        for (int i = w * 512 + F.tid; i < 80 * D / 8; i += nw * 512) z0[i] = (v4u){0u, 0u, 0u, 0u};
        for (int i = w * 512 + F.tid; i < 96 * D / 8; i += nw * 512) z1[i] = (v4u){0u, 0u, 0u, 0u};
    }
}
__device__ __forceinline__ void prep_rows(Frame& F, const float* src, bf16* dst) {
    const int gw = F.bid * NWAVES + F.wave, NGW = F.G * NWAVES, lane = F.lane;
    f32x4 v[8], vn[8];
    if (gw < M) {
#pragma unroll
        for (int j = 0; j < 8; ++j) v[j] = __builtin_nontemporal_load((const f32x4*)(src + (size_t)gw * D) + lane + 64 * j);
    }
    for (int m = gw; m < M; m += NGW) {
        if (m + NGW < M) {
#pragma unroll
            for (int j = 0; j < 8; ++j) vn[j] = __builtin_nontemporal_load((const f32x4*)(src + (size_t)(m + NGW) * D) + lane + 64 * j);
        }
        float s = 0.f;
#pragma unroll
        for (int j = 0; j < 8; ++j) s += (v[j].x * v[j].x + v[j].y * v[j].y) + (v[j].z * v[j].z + v[j].w * v[j].w);
        s = wave_sum(s);
        v2u* o8 = (v2u*)(dst + (size_t)m * D) + lane;
#pragma unroll
        for (int j = 0; j < 8; ++j) { v2u w; w.x = pk2(v[j].x, v[j].y); w.y = pk2(v[j].z, v[j].w); o8[64 * j] = w; }
        if (lane < 32) ((float*)(F.ws + WS_SSQ))[(size_t)m * 32 + lane] = (lane == 0) ? s : 0.f;
#pragma unroll
        for (int j = 0; j < 8; ++j) v[j] = vn[j];
    }
}
__device__ __forceinline__ void rms_final(Frame& F) {
    const int gw = F.bid * NWAVES + F.wave, NGW = F.G * NWAVES, lane = F.lane;
    const f32x4* gr = (const f32x4*)F.nfin + lane;
    f32x4 gg[8];
#pragma unroll
    for (int j = 0; j < 8; ++j) gg[j] = gr[64 * j];
    v2u w[8], wn[8]; float sp = 0.f, spn = 0.f;
    if (gw < M) {
#pragma unroll
        for (int j = 0; j < 8; ++j) w[j] = ((const v2u*)(((bf16*)(F.ws + WS_A)) + (size_t)gw * D) + lane)[64 * j];
        sp = lane < 32 ? ((float*)(F.ws + WS_SSQ))[(size_t)gw * 32 + lane] : 0.f;
    }
    for (int m = gw; m < M; m += NGW) {
        if (m + NGW < M) {
#pragma unroll
            for (int j = 0; j < 8; ++j) wn[j] = ((const v2u*)(((bf16*)(F.ws + WS_A)) + (size_t)(m + NGW) * D) + lane)[64 * j];
            spn = lane < 32 ? ((float*)(F.ws + WS_SSQ))[(size_t)(m + NGW) * 32 + lane] : 0.f;
        }
        const float s = wave_sum(sp);
        const float rstd = 1.0f / sqrtf(s * (1.f / D) + NORM_EPS);
        f32x4* xr = (f32x4*)(F.X + (size_t)m * D) + lane;
#pragma unroll
        for (int j = 0; j < 8; ++j) __builtin_nontemporal_store((f32x4){bflo(w[j].x), bfhi(w[j].x), bflo(w[j].y), bfhi(w[j].y)} * rstd * gg[j], xr + 64 * j);
#pragma unroll
        for (int j = 0; j < 8; ++j) w[j] = wn[j];
        sp = spn;
    }
}
__device__ __forceinline__ void rope_table(Frame& F) {
    const int gt = F.bid * (NWAVES * 64) + F.tid, NT = F.G * NWAVES * 64;
    for (int e = gt; e < M * 64; e += NT) {
        const int m = e >> 6, i = e & 63;
        double inv = 1.0; const double rr = 8.65964323360065346691e-01;
        for (int k = 0; k < i; ++k) inv *= rr;
        const float invf = (float)inv;
        const float angf = (float)F.pos[m] * invf;
        const double ang = (double)angf;
        const double kq = __builtin_rint(ang * 0.63661977236758134308);
        double y = __builtin_fma(-kq, 1.57079632679489655800e+00, ang);
        y = __builtin_fma(-kq, 6.12323399573676603587e-17, y);
        const double y2 = y * y;
        double sn = 1.0 / 6227020800.0; sn = sn * y2 - 1.0 / 39916800.0; sn = sn * y2 + 1.0 / 362880.0; sn = sn * y2 - 1.0 / 5040.0; sn = sn * y2 + 1.0 / 120.0; sn = sn * y2 - 1.0 / 6.0; sn = sn * y2 * y + y;
        double cs = 1.0 / 479001600.0; cs = cs * y2 - 1.0 / 3628800.0; cs = cs * y2 + 1.0 / 40320.0; cs = cs * y2 - 1.0 / 720.0; cs = cs * y2 + 1.0 / 24.0; cs = cs * y2 - 0.5; cs = cs * y2 + 1.0;
        const int q = ((int)kq) & 3;
        const double c = (q == 0) ? cs : (q == 1) ? -sn : (q == 2) ? -cs : sn;
        const double s = (q == 0) ? sn : (q == 1) ? cs : (q == 2) ? -sn : -cs;
        ((float2*)(F.ws + WS_TAB))[e] = make_float2((float)c, (float)s);
        if ((i & 1) == 0) ((float2*)(F.ws + WS_TAB2))[(size_t)m * 32 + (i >> 1)] = make_float2((float)c, (float)s);
    }
}
__device__ __forceinline__ float lg2_gamma(int h) {
    const double x = __builtin_amdgcn_exp2f((float)(-5 - h));
    double s = 1.0 / 8.0; s = s * x + 1.0 / 7.0; s = s * x + 1.0 / 6.0; s = s * x + 0.2; s = s * x + 0.25; s = s * x + 1.0 / 3.0; s = s * x + 0.5; s = s * x + 1.0; s = -s * x;
    return (float)(s * 1.44269504088896338700);
}

constexpr int PT_IMG = 32 * 132 * 4;
__device__ __forceinline__ void post_tile(Frame& F, int tt) {
    const int tid = F.tid;
    const int m0 = tt * 32, b = m0 / T, tp0 = m0 % T;
    const int ltok = tid >> 4, lc8 = (tid & 15) * 8;
    const bf16* gp0 = ((bf16*)(F.ws + WS_PROJ)) + (size_t)(m0 + ltok) * NPB + lc8;
    v4u cur = *(const v4u*)(gp0 + C_RK), nxt = cur;
    for (int s = 0; s < 18; ++s) {
        LAS float* L = (LAS float*)(F.lds + (s & 1) * PT_IMG);
        const int typ = s < 8 ? 1 : s < 16 ? 2 : 6, h = s < 16 ? (s & 7) : (s & 1);
        if (s + 1 < 18) { const int sn = s + 1; nxt = *(const v4u*)(gp0 + (sn < 8 ? C_RK + sn * 128 : sn < 16 ? C_RV + (sn - 8) * 128 : C_AV + (sn - 16) * 128)); }
        { const v4u w = cur; LAS float* lp = L + ltok * 132 + lc8;
          lp[0] = bflo(w.x); lp[1] = bfhi(w.x); lp[2] = bflo(w.y); lp[3] = bfhi(w.y); lp[4] = bflo(w.z); lp[5] = bfhi(w.z); lp[6] = bflo(w.w); lp[7] = bfhi(w.w); }
        __syncthreads();
        {
            const int d = tid >> 2, t8 = (tid & 3) * 8;
            bf16* tb = (typ == 1) ? ((bf16*)(F.ws + WS_RKT)) + ((size_t)(b * 8 + h) * 128 + d) * T : (typ == 2) ? ((bf16*)(F.ws + WS_RVT)) + ((size_t)(b * 8 + h) * 128 + d) * T : ((bf16*)(F.ws + WS_AVT)) + ((size_t)(b * 2 + h) * 128 + d) * T;
            const LAS float* lp = L + t8 * 132 + d;
            v4u w; w.x = pk2(lp[0], lp[132]); w.y = pk2(lp[264], lp[396]); w.z = pk2(lp[528], lp[660]); w.w = pk2(lp[792], lp[924]);
            if (typ != 6) *(v4u*)(tb + tp0 + t8) = w;
            else {
                const int p0 = 8 * ((t8 >> 2) & 3) + 4 * (t8 >> 4);
                *(v2u*)(tb + tp0 + p0) = (v2u){w.x, w.y}; *(v2u*)(tb + tp0 + p0 + 8) = (v2u){w.z, w.w};
            }
        }
        cur = nxt;
    }
    __syncthreads();
}

#define MFMA32(a, b, c) __builtin_amdgcn_mfma_f32_32x32x16_bf16((a), (b), (c), 0, 0, 0)
#define MFMA16(a, b, c) __builtin_amdgcn_mfma_f32_16x16x32_bf16((a), (b), (c), 0, 0, 0)
__device__ __forceinline__ f32x16 zero16() { f32x16 z;
#pragma unroll
    for (int i = 0; i < 16; ++i) z[i] = 0.f; return z; }
__device__ __forceinline__ void ret_kv_unit(Frame& F, int unit, int w4, int lane) {
    const int bh = unit >> 5, n = unit & 31, t0 = n * 128, r = lane & 31, hi = lane >> 5;
    f32x16 acc[4];
#pragma unroll
    for (int k = 0; k < 4; ++k) acc[k] = zero16();
    const bf16* vp = ((bf16*)(F.ws + WS_RVT)) + ((size_t)bh * 128 + 32 * w4 + r) * T + t0 + 8 * hi;
    const bf16* kp = ((bf16*)(F.ws + WS_RKT)) + ((size_t)bh * 128 + r) * T + t0 + 8 * hi;
#pragma unroll
    for (int s = 0; s < 8; ++s) {
        const bf16x8 bfr = *(const bf16x8*)(vp + 16 * s);
#pragma unroll
        for (int blk = 0; blk < 4; ++blk) { const bf16x8 af = *(const bf16x8*)(kp + (size_t)blk * 32 * T + 16 * s); acc[blk] = MFMA32(af, bfr, acc[blk]); }
    }
    float* kvp = ((float*)(F.ws + WS_KV)) + ((size_t)unit * 128 + 32 * w4 + r) * 128;
#pragma unroll
    for (int blk = 0; blk < 4; ++blk)
#pragma unroll
        for (int g = 0; g < 4; ++g) *(f32x4*)(kvp + 32 * blk + 8 * g + 4 * hi) = (f32x4){acc[blk][4 * g], acc[blk][4 * g + 1], acc[blk][4 * g + 2], acc[blk][4 * g + 3]};
}
__device__ __forceinline__ void ret_scan(Frame& F) {
    const int gt = F.bid * (NWAVES * 64) + F.tid, NT = F.G * NWAVES * 64;
    for (int idx = gt; idx < 16 * 4096; idx += NT) {
        const int bh = idx >> 12, rem = idx & 4095, h = bh & 7;
        const float gC = __builtin_amdgcn_exp2f(128.f * lg2_gamma(h));
        f32x4 S = {0.f, 0.f, 0.f, 0.f};
        const size_t off0 = ((size_t)(bh * 32) * 16384) + (size_t)rem * 4;
#pragma unroll 1
        for (int n0 = 0; n0 < 32; n0 += 8) {
            f32x4 kv[8];
#pragma unroll
            for (int k = 0; k < 8; ++k) kv[k] = *(const f32x4*)(((float*)(F.ws + WS_KV)) + off0 + (size_t)(n0 + k) * 16384);
#pragma unroll
            for (int k = 0; k < 8; ++k) {
                v2u w; w.x = pk2(S.x, S.y); w.y = pk2(S.z, S.w);
                *(v2u*)(((bf16*)(F.ws + WS_ST)) + off0 + (size_t)(n0 + k) * 16384) = w;
                S = (S + kv[k]) * gC;
            }
        }
    }
}
constexpr int RO_PITCH = 272, RO_KB = 128 * RO_PITCH, RO_UNIT = 2 * RO_KB;
__device__ __forceinline__ void ret_out_stage(Frame& F, int u2) {
    const int tid = F.tid, row0 = tid >> 4, c = tid & 15;
    const int vpos = 32 * (c >> 2) + 16 * ((c & 3) >> 1) + 4 * (c & 1);
#pragma unroll 1
    for (int us = 0; us < 2; ++us) {
        const int unit = 2 * u2 + us, bh = unit >> 5, n = unit & 31, b = bh >> 3, h = bh & 7, t0 = n * 128;
        v4u kr[4], vr[4];
#pragma unroll
        for (int j = 0; j < 4; ++j) {
            const int row = row0 + 32 * j;
            kr[j] = *(const v4u*)(((bf16*)(F.ws + WS_PROJ)) + ((size_t)b * T + t0 + row) * NPB + C_RK + h * 128 + 8 * c);
            vr[j] = *(const v4u*)(((bf16*)(F.ws + WS_RVT)) + ((size_t)bh * 128 + row) * T + t0 + 8 * c);
        }
#pragma unroll
        for (int j = 0; j < 4; ++j) {
            const int row = row0 + 32 * j;
            *(LAS v4u*)(F.lds + us * RO_UNIT + row * RO_PITCH + 16 * c) = kr[j];
            *(LAS v2u*)(F.lds + us * RO_UNIT + RO_KB + row * RO_PITCH + 2 * vpos) = (v2u){vr[j].x, vr[j].y};
            *(LAS v2u*)(F.lds + us * RO_UNIT + RO_KB + row * RO_PITCH + 2 * vpos + 16) = (v2u){vr[j].z, vr[j].w};
        }
    }
    __syncthreads();
}
__device__ __forceinline__ void ret_out_unit(Frame& F, int unit, int I, int lane) {
    const int lb = ((unit & 1) * RO_UNIT);
    const int bh = unit >> 5, n = unit & 31, b = bh >> 3, h = bh & 7, t0 = n * 128, r = lane & 31, hi = lane >> 5;
    const size_t tokI = (size_t)b * T + t0 + 32 * I + r;
    bf16x8 qf[8];
    { const bf16* qp = ((bf16*)(F.ws + WS_PROJ)) + tokI * NPB + C_RQ + h * 128 + 8 * hi;
#pragma unroll
      for (int s = 0; s < 8; ++s) qf[s] = *(const bf16x8*)(qp + 16 * s); }
    f32x16 out[4];
#pragma unroll
    for (int k = 0; k < 4; ++k) out[k] = zero16();
    { const bf16* sp = ((bf16*)(F.ws + WS_ST)) + ((size_t)unit * 128 + r) * 128 + 8 * hi;
#pragma unroll
      for (int blk = 0; blk < 4; ++blk) {
          bf16x8 af[8];
#pragma unroll
          for (int s = 0; s < 8; ++s) af[s] = *(const bf16x8*)(sp + (size_t)blk * 32 * 128 + 16 * s);
          asm volatile("" ::: "memory");
#pragma unroll
          for (int s = 0; s < 8; ++s) out[blk] = MFMA32(af[s], qf[s], out[blk]);
      } }
#pragma unroll 1
    for (int J = 0; J <= I; ++J) {
        asm volatile("" ::: "memory");
        f32x16 X = zero16();
#pragma unroll
        for (int s = 0; s < 8; ++s) { const bf16x8 kf = *(const LAS bf16x8*)(F.lds + lb + (32 * J + r) * RO_PITCH + (16 * s + 8 * hi) * 2); X = MFMA32(kf, qf[s], X); }
        if (J == I) {
            int rr = r; asm volatile("" : "+v"(rr));
#pragma unroll
            for (int g = 0; g < 16; ++g) { const int jrow = (g & 3) + 8 * (g >> 2) + 4 * hi; if (jrow > rr) X[g] = 0.f; }
        }
#pragma unroll
        for (int s2 = 0; s2 < 2; ++s2) {
            v4u xp; xp.x = pk2(X[8 * s2], X[8 * s2 + 1]); xp.y = pk2(X[8 * s2 + 2], X[8 * s2 + 3]); xp.z = pk2(X[8 * s2 + 4], X[8 * s2 + 5]); xp.w = pk2(X[8 * s2 + 6], X[8 * s2 + 7]);
            const bf16x8 xb = __builtin_bit_cast(bf16x8, xp);
#pragma unroll
            for (int blk = 0; blk < 4; ++blk) {
                const bf16x8 av = *(const LAS bf16x8*)(F.lds + lb + RO_KB + (32 * blk + r) * RO_PITCH + (32 * J + 8 * (2 * s2 + hi)) * 2);
                out[blk] = MFMA32(av, xb, out[blk]);
            }
        }
    }
    float s1 = 0.f, s2 = 0.f;
#pragma unroll
    for (int blk = 0; blk < 4; ++blk) {
#pragma unroll
        for (int g = 0; g < 16; ++g) { const float v = out[blk][g]; s1 += v; s2 = __builtin_fmaf(v, v, s2); }
        asm volatile("" : "+v"(s1), "+v"(s2));
    }
    s1 = xor32_sum(s1); s2 = xor32_sum(s2);
    const float mu = s1 * (1.f / 128.f);
    const float rstd = 1.0f / sqrtf(__builtin_fmaxf(s2 * (1.f / 128.f) - mu * mu, 0.f) + NORM_EPS);
    const bf16* gp = ((bf16*)(F.ws + WS_PROJ)) + tokI * NPB + C_RG + h * 128;
    bf16* op = ((bf16*)(F.ws + WS_PIDX)) + tokI * D + h * 128;
    const float* nw = F.nret + h * 128;
    v2u ov[4][4];
#pragma unroll
    for (int blk = 0; blk < 4; ++blk)
#pragma unroll
        for (int g = 0; g < 4; ++g) {
            const int e = 32 * blk + 8 * g + 4 * hi;
            const v2u gg = *(const v2u*)(gp + e); const f32x4 w4 = *(const f32x4*)(nw + e);
            const float y0 = (out[blk][4 * g] - mu) * rstd * w4.x * bflo(gg.x), y1 = (out[blk][4 * g + 1] - mu) * rstd * w4.y * bfhi(gg.x);
            const float y2 = (out[blk][4 * g + 2] - mu) * rstd * w4.z * bflo(gg.y), y3 = (out[blk][4 * g + 3] - mu) * rstd * w4.w * bfhi(gg.y);
            ov[blk][g].x = pk2(y0, y1); ov[blk][g].y = pk2(y2, y3);
            if (g == 3) asm volatile("" ::: "memory");
        }
    asm volatile("" ::: "memory");
#pragma unroll
    for (int blk = 0; blk < 4; ++blk)
#pragma unroll
        for (int g = 0; g < 4; ++g) *(v2u*)(op + 32 * blk + 8 * g + 4 * hi) = ov[blk][g];
}

__device__ __forceinline__ unsigned fkey(float f) { unsigned b = __float_as_uint(f); if (b == 0x80000000u) b = 0u; return (b & 0x80000000u) ? ~b : (b | 0x80000000u); }
__device__ __forceinline__ int row16_sum_i(int c) {
    c += __builtin_amdgcn_update_dpp(0, c, 0xB1, 0xF, 0xF, true);
    c += __builtin_amdgcn_update_dpp(0, c, 0x4E, 0xF, 0xF, true);
    c += __builtin_amdgcn_update_dpp(0, c, 0x141, 0xF, 0xF, true);
    c += __builtin_amdgcn_update_dpp(0, c, 0x140, 0xF, 0xF, true);
    return c;
}
__device__ __forceinline__ int half_sum(int c) {
    c = row16_sum_i(c);
    auto rr = __builtin_amdgcn_permlane16_swap((unsigned)c, (unsigned)c, false, false);
    return (int)rr[0] + (int)rr[1];
}
__device__ __forceinline__ unsigned half_max_u(unsigned c) {
    unsigned t;
    t = (unsigned)__builtin_amdgcn_update_dpp(0, (int)c, 0xB1, 0xF, 0xF, true); c = c > t ? c : t;
    t = (unsigned)__builtin_amdgcn_update_dpp(0, (int)c, 0x4E, 0xF, 0xF, true); c = c > t ? c : t;
    t = (unsigned)__builtin_amdgcn_update_dpp(0, (int)c, 0x141, 0xF, 0xF, true); c = c > t ? c : t;
    t = (unsigned)__builtin_amdgcn_update_dpp(0, (int)c, 0x140, 0xF, 0xF, true); c = c > t ? c : t;
    auto rr = __builtin_amdgcn_permlane16_swap(c, c, false, false);
    return rr[0] > rr[1] ? rr[0] : rr[1];
}
__device__ __forceinline__ float xor16_max(float m) { auto rr = __builtin_amdgcn_permlane16_swap(__float_as_uint(m), __float_as_uint(m), false, false); return __builtin_fmaxf(__uint_as_float(rr[0]), __uint_as_float(rr[1])); }
__device__ __forceinline__ float xor32_max(float m) { auto rr = __builtin_amdgcn_permlane32_swap(__float_as_uint(m), __float_as_uint(m), false, false); return __builtin_fmaxf(__uint_as_float(rr[0]), __uint_as_float(rr[1])); }
__device__ __forceinline__ float xor16_sum(float m) { auto rr = __builtin_amdgcn_permlane16_swap(__float_as_uint(m), __float_as_uint(m), false, false); return __uint_as_float(rr[0]) + __uint_as_float(rr[1]); }
__device__ __forceinline__ float xor32_sum(float m) { auto rr = __builtin_amdgcn_permlane32_swap(__float_as_uint(m), __float_as_uint(m), false, false); return __uint_as_float(rr[0]) + __uint_as_float(rr[1]); }
#define CNT4(c, u0, u1, u2, u3, cand) do { unsigned long long _t0, _t1, _t2, _t3; \
    asm volatile("v_cmp_ge_u32_e64 %1, %5, %9\n\tv_cmp_ge_u32_e64 %2, %6, %9\n\tv_cmp_ge_u32_e64 %3, %7, %9\n\tv_cmp_ge_u32_e64 %4, %8, %9\n\t" \
                 "v_addc_co_u32_e64 %0, vcc, 0, %0, %1\n\tv_addc_co_u32_e64 %0, vcc, 0, %0, %2\n\tv_addc_co_u32_e64 %0, vcc, 0, %0, %3\n\tv_addc_co_u32_e64 %0, vcc, 0, %0, %4" \
                 : "+v"(c), "=&s"(_t0), "=&s"(_t1), "=&s"(_t2), "=&s"(_t3) : "v"(u0), "v"(u1), "v"(u2), "v"(u3), "v"(cand) : "vcc"); } while (0)
constexpr int IX_KOFF = 32768, IX_KPITCH = 144, IX_KBUF = 256 * IX_KPITCH;
__device__ __forceinline__ void idx_unit(Frame& F, int b, int qb, int wave, int lane) {
    const int q0 = qb * 16, hi = lane >> 5, r = lane & 31, tid = F.tid;
    const int myq = q0 + 2 * wave + hi;
    const int arow_q = (r >> 2) & 1, arow_h = (r & 3) | ((r >> 3) << 2);
    half8 a[4];
    { const f16* ap = ((f16*)(F.ws + WS_IQ)) + ((size_t)b * T + q0 + 2 * wave + arow_q) * 1024 + arow_h * 64 + 8 * hi;
#pragma unroll
      for (int s = 0; s < 4; ++s) a[s] = *(const half8*)(ap + 16 * s); }
    float wv[16];
    { const f32x4* wp = (const f32x4*)(((float*)(F.ws + WS_IW)) + ((size_t)b * T + myq) * 16);
#pragma unroll
      for (int k = 0; k < 4; ++k) { const f32x4 t = wp[k]; wv[4 * k] = t.x; wv[4 * k + 1] = t.y; wv[4 * k + 2] = t.z; wv[4 * k + 3] = t.w; } }
    LAS unsigned* sl = (LAS unsigned*)(F.lds + wave * 4096) + lane;
    unsigned u[128];
    const int last = (q0 + 15) >> 5, nstage = (last >> 3) + 1;
    const f16* sg = ((f16*)(F.ws + WS_IK)) + ((size_t)b * T + (tid >> 1)) * 64 + 32 * (tid & 1);
    const int sst = IX_KOFF + (tid >> 1) * IX_KPITCH + 64 * (tid & 1);
    v4u sr[4];
#pragma unroll
    for (int j = 0; j < 4; ++j) sr[j] = *(const v4u*)(sg + 8 * j);
#pragma unroll
    for (int j = 0; j < 4; ++j) *(LAS v4u*)(F.lds + sst + 16 * j) = sr[j];
    __syncthreads();
    const int kread = IX_KOFF + r * IX_KPITCH + 16 * hi;
#pragma unroll
    for (int c = 0; c < 8; ++c) {
        if (16 * c <= last) {
#pragma unroll 1
            for (int st = 0; st < 2; ++st) {
                const int sidx = 2 * c + st;
                if (sidx < nstage) {
                    const bool more = (sidx + 1) < nstage;
                    if (more) {
#pragma unroll
                        for (int j = 0; j < 4; ++j) sr[j] = *(const v4u*)(sg + (size_t)(sidx + 1) * 256 * 64 + 8 * j);
                    }
                    const int kb = kread + (sidx & 1) * IX_KBUF;
#pragma unroll 1
                    for (int ii = 0; ii < 8; ++ii) {
                        const int i = 8 * sidx + ii;
                        half8 bfr[4];
#pragma unroll
                        for (int s = 0; s < 4; ++s) bfr[s] = *(const LAS half8*)(F.lds + kb + ii * 32 * IX_KPITCH + 32 * s);
                        f32x16 acc = zero16();
#pragma unroll
                        for (int s = 0; s < 4; ++s) acc = __builtin_amdgcn_mfma_f32_32x32x16_f16(a[s], bfr[s], acc, 0, 0, 0);
                        float sc = 0.f;
#pragma unroll
                        for (int hh = 0; hh < 16; ++hh) sc = __builtin_fmaf(wv[hh], __builtin_amdgcn_fmed3f(acc[hh], 0.f, INFINITY), sc);
                        const int key = 32 * i + r;
                        sl[(8 * st + ii) * 64] = (key <= myq) ? fkey(sc) : 0u;
                    }
                    if (more) {
#pragma unroll
                        for (int j = 0; j < 4; ++j) *(LAS v4u*)(F.lds + sst + ((sidx + 1) & 1) * IX_KBUF + 16 * j) = sr[j];
                    }
                    __syncthreads();
                } else {
#pragma unroll 1
                    for (int ii = 0; ii < 8; ++ii) sl[(8 * st + ii) * 64] = 0u;
                }
            }
#pragma unroll
            for (int ii = 0; ii < 16; ++ii) u[16 * c + ii] = sl[ii * 64];
        } else {
#pragma unroll
            for (int ii = 0; ii < 16; ++ii) u[16 * c + ii] = 0u;
        }
    }
#define IDX_COUNT(c, cand) do { c = 0; _Pragma("unroll") for (int g = 0; g < 8; ++g) { if (16 * g <= last) { \
        _Pragma("unroll") for (int i = 0; i < 16; i += 4) CNT4(c, u[16 * g + i], u[16 * g + i + 1], u[16 * g + i + 2], u[16 * g + i + 3], cand); } } \
        asm volatile("s_nop 2" : "+v"(c)); c = half_sum(c); } while (0)
    unsigned Tk = 0u; bool done = false, found = false;
    {
        unsigned um = 0u;
#pragma unroll
        for (int g = 0; g < 8; ++g) { if (16 * g <= last) {
#pragma unroll
            for (int i = 0; i < 16; ++i) um = um > u[16 * g + i] ? um : u[16 * g + i]; } }
        um = half_max_u(um);
        const int Eb = (um >> 31) ? (int)((um >> 23) & 0xFFu) : 0;
#pragma unroll 1
        for (int k = 0; k < 4; ++k) {
            const int e = Eb - k;
            const unsigned cand = (e >= 1) ? (0x80000000u | ((unsigned)e << 23)) : 0xFFFFFFFFu;
            int c; IDX_COUNT(c, cand);
            if (!found && e >= 1 && c >= 256) { found = true; Tk = cand; done = (c == 256); }
            if (__all(found)) break;
        }
    }
    int startbit = 22;
    if (!__all(found)) { Tk = 0u; done = false; startbit = 31; }
#pragma unroll 1
    for (int bit = startbit; bit >= 0; --bit) {
        if (__all(done)) break;
        const unsigned cand = Tk | (1u << bit);
        int c; IDX_COUNT(c, cand);
        if (!done && c >= 256) { Tk = cand; done = (c == 256); }
    }
#undef IDX_COUNT
    unsigned Tk2 = Tk - 1u; int Jthr = -1;
    if (!__all(done)) {
        int cgt = 0, ceq = 0;
#pragma unroll
        for (int i = 0; i < 128; ++i) { cgt += (u[i] > Tk) ? 1 : 0; ceq += (u[i] == Tk) ? 1 : 0; }
        cgt = half_sum(cgt); ceq = half_sum(ceq);
        Jthr = (Tk == 0u) ? -1 : 4095;
        const int need = 256 - cgt;
        const bool trim = (Tk != 0u) && (ceq > need);
        if (__any(trim)) {
            int J = 0;
#pragma unroll 1
            for (int bit = 11; bit >= 0; --bit) {
                const int cand = J | (1 << bit);
                unsigned Tk1 = Tk; asm volatile("" : "+v"(Tk1));
                const int cr = cand - r;
                int c = 0;
#pragma unroll
                for (int i = 0; i < 128; ++i) c += ((u[i] == Tk1) && (32 * i < cr)) ? 1 : 0;
                c = half_sum(c);
                if (c < need) J = cand;
            }
            if (trim) Jthr = J;
        }
        Tk2 = Tk;
    }
    const int jt = Jthr - r;
    asm volatile("" : "+v"(Tk2));
    unsigned mlo0 = 0u, mhi0 = 0u, mlo1 = 0u, mhi1 = 0u;
#pragma unroll
    for (int g = 0; g < 8; ++g) {
        if (16 * g <= last) {
#pragma unroll
            for (int ii = 0; ii < 16; ++ii) {
                const int i = 16 * g + ii;
                const bool sel = (u[i] > Tk2) || ((u[i] == Tk2) && (32 * i <= jt));
                const unsigned long long bal = __ballot(sel);
                const unsigned lo = (unsigned)bal, hi_ = (unsigned)(bal >> 32);
                int lv = lane; asm volatile("" : "+v"(lv));
                const bool me = (lv == (i & 63));
                if (i < 64) { mlo0 = me ? lo : mlo0; mhi0 = me ? hi_ : mhi0; }
                else { mlo1 = me ? lo : mlo1; mhi1 = me ? hi_ : mhi1; }
            }
        }
    }
    unsigned* mp = ((unsigned*)(F.ws + WS_MASK)) + ((size_t)b * T + q0 + 2 * wave) * 128;
    mp[lane] = mlo0; mp[64 + lane] = mlo1; mp[128 + lane] = mhi0; mp[192 + lane] = mhi1;
}

constexpr int AT_PITCH = 272, AT_KBYTES = 128 * AT_PITCH, AT_BUF = 2 * AT_KBYTES;
__device__ __forceinline__ void attn_unit(Frame& F, int b, int kvh, int qb) {
    const int tid = F.tid, lane = F.lane, wave = F.wave, fr = lane & 15, fq = lane >> 4;
    const int q = qb * 32 + 4 * wave + (fr >> 2), head = 4 * kvh + (fr & 3);
    const size_t tok = (size_t)b * T + q;
    bf16x8 qf[4];
    { const bf16* qp = ((bf16*)(F.ws + WS_PROJ)) + tok * NPB + C_AQ + head * 128 + 8 * fq;
#pragma unroll
      for (int s = 0; s < 4; ++s) qf[s] = *(const bf16x8*)(qp + 32 * s); }
    const v4u* mrow = (const v4u*)(((unsigned*)(F.ws + WS_MASK)) + tok * 128);
    f32x4 O[8];
#pragma unroll
    for (int k = 0; k < 8; ++k) O[k] = (f32x4){0.f, 0.f, 0.f, 0.f};
    float mrun = -INFINITY, lsum = 0.f;
    const int nst = (qb + 4) >> 2;
    const int srow = tid >> 4, sc8 = (tid & 15) * 8;
    const bf16* kg = ((bf16*)(F.ws + WS_PROJ)) + ((size_t)b * T + srow) * NPB + C_AK + kvh * 128 + sc8;
    const bf16* vg = ((bf16*)(F.ws + WS_AVT)) + ((size_t)(b * 2 + kvh) * 128 + srow) * T + sc8;
    LAS unsigned char* lds = F.lds;
    const int kst = srow * AT_PITCH + sc8 * 2, vst = AT_KBYTES + kst;
    v4u kr[4], vr[4];
#pragma unroll
    for (int j = 0; j < 4; ++j) { kr[j] = *(const v4u*)(kg + (size_t)(32 * j) * NPB); vr[j] = *(const v4u*)(vg + (size_t)(32 * j) * T); }
#define AT_VWRITE(base) do { _Pragma("unroll") for (int j = 0; j < 4; ++j) *(LAS v4u*)(lds + (base) + vst + 32 * j * AT_PITCH) = vr[j]; } while (0)
#pragma unroll
    for (int j = 0; j < 4; ++j) *(LAS v4u*)(lds + kst + 32 * j * AT_PITCH) = kr[j];
    AT_VWRITE(0);
    v4u W4 = mrow[0], W4n = W4;
    __syncthreads();
    if (wave >= 4) __builtin_amdgcn_s_setprio(1);
    for (int st = 0; st < nst; ++st) {
        const int bo = (st & 1) * AT_BUF;
        const bool more = (st + 1 < nst);
        if (more) {
#pragma unroll
            for (int j = 0; j < 4; ++j) { kr[j] = *(const v4u*)(kg + (size_t)((st + 1) * 128 + 32 * j) * NPB); vr[j] = *(const v4u*)(vg + (size_t)(32 * j) * T + (st + 1) * 128); }
            W4n = mrow[st + 1];
        }
        {
            f32x4 sg[8];
#pragma unroll
            for (int g = 0; g < 8; ++g) sg[g] = (f32x4){0.f, 0.f, 0.f, 0.f};
#pragma unroll
            for (int s = 0; s < 4; ++s)
#pragma unroll
                for (int g = 0; g < 8; ++g) { const bf16x8 kf = *(const LAS bf16x8*)(lds + bo + (16 * g + fr) * AT_PITCH + (32 * s + 8 * fq) * 2); sg[g] = MFMA16(kf, qf[s], sg[g]); }
            float mx = -INFINITY;
#pragma unroll
            for (int g = 0; g < 8; ++g)
#pragma unroll
                for (int j = 0; j < 4; ++j) mx = __builtin_fmaxf(mx, sg[g][j]);
            mx = xor16_max(mx); mx = xor32_max(mx);
            const float mnew = __builtin_fmaxf(mrun, mx);
            const float alpha = __builtin_amdgcn_exp2f(mrun - mnew);
            const bool resc = __any(mnew != mrun);
            mrun = mnew;
            float ps = 0.f; bf16x8 pb[4];
#pragma unroll
            for (int h = 0; h < 4; ++h) {
                float p[8];
#pragma unroll
                for (int j = 0; j < 8; ++j) {
                    const int bit = 4 * fq + 16 * (j >> 2) + (j & 3);
                    const unsigned keep = (unsigned)__builtin_amdgcn_sbfe((int)W4[h], bit, 1);
                    p[j] = __uint_as_float(__float_as_uint(__builtin_amdgcn_exp2f(sg[2 * h + (j >> 2)][j & 3] - mnew)) & keep); ps += p[j];
                }
                v4u pp; pp.x = pk2(p[0], p[1]); pp.y = pk2(p[2], p[3]); pp.z = pk2(p[4], p[5]); pp.w = pk2(p[6], p[7]);
                pb[h] = __builtin_bit_cast(bf16x8, pp);
            }
            lsum = lsum * alpha + ps;
            if (resc) {
#pragma unroll
                for (int blk = 0; blk < 8; ++blk) O[blk] = O[blk] * alpha;
            }
#pragma unroll
            for (int blk = 0; blk < 8; ++blk) {
                const LAS unsigned char* vp = lds + bo + AT_KBYTES + (16 * blk + fr) * AT_PITCH + (8 * fq) * 2;
#pragma unroll
                for (int h = 0; h < 4; ++h) { const bf16x8 av = *(const LAS bf16x8*)(vp + 64 * h); O[blk] = MFMA16(av, pb[h], O[blk]); }
            }
        }
        if (more) { const int bn = ((st + 1) & 1) * AT_BUF;
#pragma unroll
            for (int j = 0; j < 4; ++j) *(LAS v4u*)(lds + bn + kst + 32 * j * AT_PITCH) = kr[j];
            AT_VWRITE(bn); }
        __syncthreads();
        W4 = W4n;
    }
#undef AT_VWRITE
    __builtin_amdgcn_s_setprio(0);
    lsum = xor16_sum(lsum); lsum = xor32_sum(lsum);
    const float inv = 1.0f / lsum;
    bf16* op = ((bf16*)(F.ws + WS_PIDX)) + tok * D + 1024 + head * 128 + 4 * fq;
#pragma unroll
    for (int blk = 0; blk < 8; ++blk) { v2u o; o.x = pk2(O[blk][0] * inv, O[blk][1] * inv); o.y = pk2(O[blk][2] * inv, O[blk][3] * inv); *(v2u*)(op + 16 * blk) = o; }
}

struct Args { const void* in[15]; float* out; unsigned char* ws; int ph_lo, ph_hi; };
constexpr int NPHASE = 12;
__global__ void __launch_bounds__(NWAVES * 64, 2) mk_fwd(Args args) {
    extern __shared__ __attribute__((aligned(16))) unsigned char lds[];
    Frame F;
    F.lds = (LAS unsigned char*)lds;
    F.tid = threadIdx.x; F.lane = F.tid & 63; F.wave = __builtin_amdgcn_readfirstlane(F.tid >> 6);
    F.G = gridDim.x; F.bid = blockIdx.x;
    unsigned char* ws = args.ws;
    F.x = (const float*)args.in[0]; F.pos = (const int*)args.in[1];
    F.n1 = (const float*)args.in[2]; F.wg1 = (const float*)args.in[3]; F.wu1 = (const float*)args.in[4]; F.wd1 = (const float*)args.in[5];
    F.nmix = (const float*)args.in[6]; F.win = (const float*)args.in[7]; F.nret = (const float*)args.in[8]; F.wout = (const float*)args.in[9];
    F.n2 = (const float*)args.in[10]; F.wg2 = (const float*)args.in[11]; F.wu2 = (const float*)args.in[12]; F.wd2 = (const float*)args.in[13]; F.nfin = (const float*)args.in[14];
    F.X = args.out;
    F.ws = ws;
    volatile LAS unsigned* MISC = (volatile LAS unsigned*)(F.lds + MISC_OFF);
    for (int u = F.tid; u < (LDS_BYTES - LDSCTL_OFF) / 4; u += NWAVES * 64) ((LAS unsigned*)(F.lds + LDSCTL_OFF))[u] = 0u;
    __syncthreads();
    const int lo = args.ph_lo, hi = args.ph_hi;
    XcdBarrier bar; bar.bar = (unsigned*)(ws + WS_CTL) + CW_BAR; bar.x = 0; bar.st = nullptr;
    if (hi - lo > 1) bar = xcd_barrier_post((unsigned*)(ws + WS_CTL) + CW_BAR, MISC + 8);
#ifndef MK_PHMASK
#define MK_PHMASK 0xFFFF
#endif
#define IN(k) (((MK_PHMASK >> (k)) & 1) && lo <= (k) && (k) < hi)
#define SEAM(k) do { if (IN(k) && IN((k) + 1)) xcd_barrier(bar); } while (0)
    bf16* H = ((bf16*)(F.ws + WS_PROJ));

#ifndef MK_REPEAT
#define MK_REPEAT 0
#endif
#ifndef MK_TIMEPH
#define MK_TIMEPH -1
#endif
    unsigned long long tp0 = 0, tp1 = 0;
#define PHASE(k, ...) do { MK_STAMP(F.lds, 2 * (k)); if ((k) == MK_TIMEPH) tp0 = __builtin_amdgcn_s_memrealtime(); if (IN(k)) { { int t_ = threadIdx.x; asm volatile("" : "+v"(t_)); F.tid = t_; F.lane = t_ & 63; F.wave = __builtin_amdgcn_readfirstlane(t_ >> 6); } __VA_ARGS__ if ((MK_REPEAT >> (k)) & 1) { xcd_barrier(bar); __VA_ARGS__ } } MK_STAMP(F.lds, 1000 + (k)); SEAM(k); MK_STAMP(F.lds, 2 * (k) + 1); if ((k) == MK_TIMEPH) tp1 = __builtin_amdgcn_s_memrealtime(); } while (0)
    PHASE(0, { convert_job<0>(F, F.bid, F.G); if (MK_ABL == 1) convert_job<0>(F, F.bid, F.G); rope_table(F); if (MK_ABL == 2) rope_table(F); prep_rows(F, F.x, ((bf16*)(F.ws + WS_A))); if (MK_ABL == 3) prep_rows(F, F.x, ((bf16*)(F.ws + WS_A))); });
    PHASE(1, { pg8::Gemm g{((bf16*)(F.ws + WS_A)), ((bf16*)(F.ws + WS_WGU)), M, 2 * FF, D}; pg8::StaticOrder S; S.init(M, 2 * FF, F.G, F.bid); load_rstd_panels(F, S, ((float*)(F.ws + WS_SSQ))); EpiSwiGLU E{H, (const LAS float*)(F.lds + RS_OFF)};
        pg8::gemm_phase<EpiSwiGLU, pg8::StaticOrder, true, true>(F.lds, g, S, E, F.tid, 110);
        { const int nfull = (M / 256) * (2 * FF / 256) % F.G; if (nfull > 0 && F.bid >= nfull) { convert_job<1>(F, F.bid - nfull, F.G - nfull); }
          else if (nfull == 0) { convert_job<1>(F, F.bid, F.G); } } });
    PHASE(2, { pg8::Gemm g{H, ((bf16*)(F.ws + WS_WD)), M, D, FF}; pg8::StaticOrder S; S.init(M, D, F.G, F.bid); EpiResid<true> E{F.x, ((bf16*)(F.ws + WS_A)), 0.5f, ((float*)(F.ws + WS_SSQ))};
        pg8::gemm_phase<EpiResid<true>, pg8::StaticOrder, true, true>(F.lds, g, S, E, F.tid, 120); });
    PHASE(3, { pg8::Gemm g{((bf16*)(F.ws + WS_A)), ((bf16*)(F.ws + WS_WIN)), M, NINP, D}; pg8::StaticOrder S; S.init(M, NINP, F.G, F.bid); load_rstd_panels(F, S, ((float*)(F.ws + WS_SSQ))); EpiProj E{F.ws, (const LAS float*)(F.lds + RS_OFF)};
        pg8::gemm_phase<EpiProj, pg8::StaticOrder, true, true>(F.lds, g, S, E, F.tid, 130);
        { const int nfull = (M / 256) * (NINP / 256) % F.G; if (nfull > 0 && F.bid >= nfull) { convert_job<2>(F, F.bid - nfull, F.G - nfull); }
          else if (nfull == 0) { convert_job<2>(F, F.bid, F.G); } } });
    PHASE(4, { for (int tt = F.bid; tt < M / 32; tt += F.G) post_tile(F, tt); });
    PHASE(5, {
        for (int rep = 0; rep < (MK_ABL == 5 ? 2 : 1); ++rep) for (int u2 = F.bid; u2 < 256; u2 += F.G) ret_kv_unit(F, 2 * u2 + (F.wave >> 2), F.wave & 3, F.lane);
        for (int c = F.bid; c < 256; c += F.G) {
            _Pragma("unroll 1") for (int k = 0; k < 2; ++k) { const int b = c & 1, i = c >> 1; idx_unit(F, b, k ? 255 - i : i, F.wave, F.lane); } }
    });
    PHASE(6, { ret_scan(F); });
    PHASE(7, {
        for (int rep = 0; rep < (MK_ABL == 6 ? 2 : 1); ++rep) for (int u2 = F.bid; u2 < 256; u2 += F.G) { ret_out_stage(F, u2); ret_out_unit(F, 2 * u2 + (F.wave >> 2), F.wave & 3, F.lane); __syncthreads(); }
        MK_STAMP(F.lds, 210);
        for (int p = F.bid; p < 256; p += F.G) { const int grp = (p & 7) >> 1, b = grp >> 1, kvh = grp & 1, i = ((p >> 3) << 1) | (p & 1);
            _Pragma("unroll 1") for (int k = 0; k < 2; ++k) attn_unit(F, b, kvh, k ? 127 - i : i); }
    });
    PHASE(8, { pg8::Gemm g{((bf16*)(F.ws + WS_PIDX)), ((bf16*)(F.ws + WS_WOUT)), M, D, D}; pg8::StaticOrder S; S.init(M, D, F.G, F.bid); EpiResid<false> E{nullptr, ((bf16*)(F.ws + WS_A)), 1.0f, ((float*)(F.ws + WS_SSQ))};
        pg8::gemm_phase<EpiResid<false>, pg8::StaticOrder, true, true>(F.lds, g, S, E, F.tid, 180); });
    PHASE(9, { pg8::Gemm g{((bf16*)(F.ws + WS_A)), ((bf16*)(F.ws + WS_WGU)), M, 2 * FF, D}; pg8::StaticOrder S; S.init(M, 2 * FF, F.G, F.bid); load_rstd_panels(F, S, ((float*)(F.ws + WS_SSQ))); EpiSwiGLU E{H, (const LAS float*)(F.lds + RS_OFF)};
        pg8::gemm_phase<EpiSwiGLU, pg8::StaticOrder, true, true>(F.lds, g, S, E, F.tid, 190);
        { const int nfull = (M / 256) * (2 * FF / 256) % F.G; if (nfull > 0 && F.bid >= nfull) { convert_job<3>(F, F.bid - nfull, F.G - nfull); }
          else if (nfull == 0) { convert_job<3>(F, F.bid, F.G); } } });
    PHASE(10, { pg8::Gemm g{H, ((bf16*)(F.ws + WS_WD)), M, D, FF}; pg8::StaticOrder S; S.init(M, D, F.G, F.bid); EpiResid<false> E{nullptr, ((bf16*)(F.ws + WS_A)), 0.5f, ((float*)(F.ws + WS_SSQ))};
        pg8::gemm_phase<EpiResid<false>, pg8::StaticOrder, true, true>(F.lds, g, S, E, F.tid, 200); });
    PHASE(11, { rms_final(F); });
#undef PHASE
    if (MK_TA >= 0 && blockIdx.x == 0) { __syncthreads(); const unsigned long long ta = *(volatile LAS unsigned long long*)(F.lds + 147200 + 8), tb = *(volatile LAS unsigned long long*)(F.lds + 147200 + 16);
        const unsigned long long tgt = __builtin_amdgcn_s_memrealtime() + 4ull * (tb - ta); while (__builtin_amdgcn_s_memrealtime() < tgt) __builtin_amdgcn_s_sleep(8); }
    if (MK_TIMEPH >= 0 && blockIdx.x == 0) { const unsigned long long tgt = __builtin_amdgcn_s_memrealtime() + 4ull * (tp1 - tp0); while (__builtin_amdgcn_s_memrealtime() < tgt) __builtin_amdgcn_s_sleep(8); }
#undef IN
#undef SEAM
}

extern "C" void kernel_launch(void* const* d_in, const int* in_sizes, int n_in, void* d_out, int out_size, void* d_ws, size_t ws_size, hipStream_t stream) {
    static int grid = 0;
    if (grid == 0) {
        if (n_in != 15 || in_sizes[0] != M * D || out_size != M * D || ws_size < WS_END) { fprintf(stderr, "kernel_launch: unexpected shapes (n_in %d, in0 %d, out %d, ws %zu < %zu)\n", n_in, n_in > 0 ? in_sizes[0] : -1, out_size, ws_size, (size_t)WS_END); grid = -1; return; }
        int dev = 0, cus = 0;
        if (hipGetDevice(&dev) != hipSuccess || hipDeviceGetAttribute(&cus, hipDeviceAttributeMultiprocessorCount, dev) != hipSuccess) { grid = -1; return; }
        if (hipFuncSetAttribute((const void*)mk_fwd, hipFuncAttributeMaxDynamicSharedMemorySize, LDS_BYTES) != hipSuccess) { fprintf(stderr, "kernel_launch: hipFuncSetAttribute failed\n"); grid = -1; return; }
        int per_cu = 0;
        if (hipOccupancyMaxActiveBlocksPerMultiprocessor(&per_cu, (const void*)mk_fwd, NWAVES * 64, LDS_BYTES) != hipSuccess || per_cu < 1) fprintf(stderr, "kernel_launch: occupancy query reports %d\n", per_cu);
        (void)hipGetLastError();
        grid = cus;
    }
    if (grid < 0) return;
    (void)hipMemsetAsync((char*)d_ws + WS_CTL, 0, CTL_ZERO_BYTES, stream);
    Args a{};
    for (int i = 0; i < 15; ++i) a.in[i] = d_in[i];
    a.out = (float*)d_out; a.ws = (unsigned char*)d_ws;
#if MK_PER_PHASE
    for (int p = 0; p < NPHASE; ++p) { a.ph_lo = p; a.ph_hi = p + 1; hipLaunchKernelGGL(mk_fwd, dim3(grid), dim3(NWAVES * 64), LDS_BYTES, stream, a); }
#else
    a.ph_lo = 0; a.ph_hi = NPHASE;
    hipLaunchKernelGGL(mk_fwd, dim3(grid), dim3(NWAVES * 64), LDS_BYTES, stream, a);
#endif
}
```

```cpp
#include <hip/hip_runtime.h>
#include <cstdio>
#include <cstdint>

#ifndef MK_PER_PHASE
#define MK_PER_PHASE 0
#endif

#ifndef MK_ABL
#define MK_ABL 0
#endif
#ifndef MK_TA
#define MK_TA -1
#endif
#ifndef MK_TB
#define MK_TB -1
#endif
#define MK_STAMP(ldsbase, n) do { if (((n) == MK_TA || (n) == MK_TB) && blockIdx.x == 0 && threadIdx.x == 0) { \
    *(volatile __attribute__((address_space(3))) unsigned long long*)((ldsbase) + 147200 + ((n) == MK_TB ? 16 : 8)) = __builtin_amdgcn_s_memrealtime(); } } while (0)
namespace pg8 {
#define PG8_LAS __attribute__((address_space(3)))
typedef unsigned short bf16_t;
typedef short bf16x8 __attribute__((ext_vector_type(8)));
typedef float f32x4 __attribute__((ext_vector_type(4)));
typedef unsigned u32x4 __attribute__((ext_vector_type(4)));
constexpr int BM = 256, BK = 64, HALF = 128, HTB = HALF * BK * 2, STAGE_BYTES = 8 * HTB, NXCD = 8, WGM = 8;

__host__ __device__ __forceinline__ int lds_byte(int r, int c) { const int st = (r >> 4) * 2 + (c >> 5), rr = r & 15, cc = c & 31, ob = rr * 64 + cc * 2; return st * 1024 + (ob ^ (((ob >> 9) & 1) << 5)); }
__host__ __device__ __forceinline__ void stage_rc(int b, int& R, int& C) { const int st = b / 1024, sb = b % 1024, swz = sb ^ (((sb >> 9) & 1) << 5); R = (st >> 1) * 16 + swz / 64; C = (st & 1) * 32 + (swz % 64) / 2; }
__host__ __device__ __forceinline__ int perm32(int rho) { const int n = rho >> 4, i = rho & 15; return 8 * (i >> 2) + 4 * n + (i & 3); }

struct Unit { int pm, pn; };
struct Gemm { const bf16_t* A; const bf16_t* Bt; int M, N, K; };

struct StaticOrder {
    int nM, nN, nwg, G, c;
    __host__ __device__ void init(int M, int N, int G_, int c_) { nM = M / BM; nN = N / BM; nwg = nM * nN; G = G_; c = c_; }
    __host__ __device__ bool next(int i, Unit& u) const {
        const long L = (long)i * G + c; if (L >= nwg) return false;
        int wgid = (int)L; { const int q = nwg / NXCD, r = nwg % NXCD, xcd = wgid % NXCD, off = wgid / NXCD; wgid = (xcd < r ? xcd * (q + 1) : r * (q + 1) + (xcd - r) * q) + off; }
        const int nig = WGM * nN, gid = wgid / nig, fm = gid * WGM, gsz = (nM - fm) < WGM ? (nM - fm) : WGM;
        u.pm = fm + ((wgid % nig) % gsz); u.pn = (wgid % nig) / gsz; return true;
    }
    __device__ __forceinline__ void a_ready(const Unit&) const {}
    __device__ __forceinline__ void done(const Unit&) const {}
};

template <class Epi, class Sched, bool ALIGN_EPI = false, bool SP2 = false>
__device__ __forceinline__ void gemm_phase(PG8_LAS unsigned char* lds, const Gemm g, const Sched& S, const Epi& E, const int tid, const int sb = -100) {
    const int wid = __builtin_amdgcn_readfirstlane(tid >> 6), lane = tid & 63, wr = wid >> 2, wc = wid & 3, fr = lane & 15, fq = lane >> 4;
    const int K = g.K, nt = K / BK;
    unsigned voffA[2], voffB[2];
#pragma unroll
    for (int i = 0; i < 2; ++i) { int R, C; stage_rc(tid * 16 + i * 8192, R, C); const int Rb = Epi::PERM ? ((R & ~31) + perm32(R & 31)) : R;
        voffA[i] = (unsigned)(R * K + C) * 2u; voffB[i] = (unsigned)(Rb * K + C) * 2u; }
    const size_t kstep = (size_t)(BK * 2);
    const size_t hstep = (size_t)HALF * K * 2;
    const size_t tstep = 2 * hstep;
    const unsigned ldsw = (unsigned)wid * 1024u;
    const int aoff = lds_byte(wr * 64 + fr, fq * 8), boff = lds_byte(wc * 32 + fr, fq * 8);
#define PG8_SA(b, h) (((b) * 2 + (h)) * HTB)
#define PG8_SB(b, h) ((4 + (b) * 2 + (h)) * HTB)
#define PG8_STAGE(bufoff, gbase, voff) do { _Pragma("unroll") for (int _i = 0; _i < 2; ++_i) \
        __builtin_amdgcn_global_load_lds((const unsigned*)((const char*)(gbase) + (voff)[_i]), (PG8_LAS unsigned*)(lds + (bufoff) + ldsw + _i * 8192), 16, 0, 0); } while (0)
#define PG8_LDA(dst, b, h) do { _Pragma("unroll") for (int m = 0; m < 4; ++m) _Pragma("unroll") for (int k = 0; k < 2; ++k) dst[m][k] = *(const PG8_LAS bf16x8*)(lds + PG8_SA(b, h) + aoff + m * 2048 + k * 1024); } while (0)
#define PG8_LDB(dst, b, h) do { _Pragma("unroll") for (int n = 0; n < 2; ++n) _Pragma("unroll") for (int k = 0; k < 2; ++k) dst[n][k] = *(const PG8_LAS bf16x8*)(lds + PG8_SB(b, h) + boff + n * 2048 + k * 1024); } while (0)
#define PG8_MMA(ai, bj, At, Bt) do { __builtin_amdgcn_s_setprio(1); _Pragma("unroll") for (int m = 0; m < 4; ++m) _Pragma("unroll") for (int n = 0; n < 2; ++n) _Pragma("unroll") for (int k = 0; k < 2; ++k) \
        acc[ai][bj][m][n] = __builtin_amdgcn_mfma_f32_16x16x32_bf16(Bt[n][k], At[m][k], acc[ai][bj][m][n], 0, 0, 0); __builtin_amdgcn_s_setprio(0); } while (0)
#define PG8_WAIT_V(n) asm volatile("s_waitcnt vmcnt(" #n ")" ::: "memory")
#define PG8_WAIT_L(n) asm volatile("s_waitcnt lgkmcnt(" #n ")" ::: "memory")
#define PG8_BAR __builtin_amdgcn_s_barrier()
#define PG8_SCHED __builtin_amdgcn_sched_barrier(0)
    Unit cur, nxt; int ui = 0;
    if (!S.next(0, cur)) return;
    f32x4 acc[2][2][4][2];
#pragma unroll
    for (int a = 0; a < 2; ++a)
#pragma unroll
        for (int b = 0; b < 2; ++b)
#pragma unroll
            for (int m = 0; m < 4; ++m)
#pragma unroll
                for (int n = 0; n < 2; ++n) acc[a][b][m][n] = (f32x4){0.f, 0.f, 0.f, 0.f};
    bf16x8 At[4][2], B0[2][2], B1[2][2];
    const char* cA = (const char*)g.A + (size_t)cur.pm * tstep; const char* cB = (const char*)g.Bt + (size_t)cur.pn * tstep;
    S.a_ready(cur);
    if constexpr (SP2) {
        PG8_STAGE(PG8_SB(0, 0), cB, voffB); PG8_STAGE(PG8_SB(0, 1), cB + hstep, voffB); PG8_STAGE(PG8_SA(0, 0), cA, voffA); PG8_STAGE(PG8_SA(0, 1), cA + hstep, voffA);
        if (wr == 1) PG8_BAR;
        PG8_WAIT_V(2); PG8_BAR;
        PG8_STAGE(PG8_SB(1, 0), cB + kstep, voffB); PG8_STAGE(PG8_SA(1, 0), cA + kstep, voffA); PG8_STAGE(PG8_SB(1, 1), cB + hstep + kstep, voffB);
        PG8_WAIT_V(6); PG8_BAR;
    } else {
        PG8_STAGE(PG8_SB(0, 0), cB, voffB); PG8_STAGE(PG8_SA(0, 0), cA, voffA); PG8_STAGE(PG8_SB(0, 1), cB + hstep, voffB); PG8_STAGE(PG8_SA(0, 1), cA + hstep, voffA);
        if (wr == 1) PG8_BAR;
        PG8_WAIT_V(4); PG8_BAR;
        PG8_STAGE(PG8_SB(1, 0), cB + kstep, voffB); PG8_STAGE(PG8_SA(1, 0), cA + kstep, voffA); PG8_STAGE(PG8_SB(1, 1), cB + hstep + kstep, voffB);
        PG8_WAIT_V(6); PG8_BAR;
    }
    MK_STAMP(lds, sb + 0);
    for (;;) {
        const bool has_next = S.next(ui + 1, nxt);
        const char* nA = has_next ? (const char*)g.A + (size_t)nxt.pm * tstep : cA; const char* nB = has_next ? (const char*)g.Bt + (size_t)nxt.pn * tstep : cB;
        for (int t = 0; t < nt; t += 2) {
            const bool last = (t == nt - 2);
            const char* a1 = cA + (size_t)(t + 1) * kstep;
            const char* a2 = last ? nA : cA + (size_t)(t + 2) * kstep; const char* b2 = last ? nB : cB + (size_t)(t + 2) * kstep;
            const char* a3 = a2 + kstep; const char* b3 = b2 + kstep;
            if (last && has_next) S.a_ready(nxt);
            if constexpr (SP2) {
            PG8_LDB(B0, 0, 0); PG8_LDB(B1, 0, 1); PG8_SCHED; PG8_LDA(At, 0, 0); PG8_STAGE(PG8_SA(1, 1), a1 + hstep, voffA);
            PG8_WAIT_V(8); PG8_WAIT_L(0); PG8_BAR; PG8_MMA(0, 0, At, B0); PG8_MMA(0, 1, At, B1); PG8_BAR; PG8_SCHED;
            PG8_LDA(At, 0, 1); PG8_STAGE(PG8_SB(0, 0), b2, voffB); PG8_STAGE(PG8_SB(0, 1), b2 + hstep, voffB); PG8_STAGE(PG8_SA(0, 0), a2, voffA);
            PG8_WAIT_V(8); PG8_WAIT_L(0); PG8_BAR; PG8_MMA(1, 0, At, B0); PG8_MMA(1, 1, At, B1); PG8_BAR; PG8_SCHED;
            PG8_LDB(B0, 1, 0); PG8_LDB(B1, 1, 1); PG8_SCHED; PG8_LDA(At, 1, 0); PG8_STAGE(PG8_SA(0, 1), a2 + hstep, voffA);
            PG8_WAIT_V(8); PG8_WAIT_L(0); PG8_BAR; PG8_MMA(0, 0, At, B0); PG8_MMA(0, 1, At, B1); PG8_BAR; PG8_SCHED;
            PG8_LDA(At, 1, 1); PG8_STAGE(PG8_SB(1, 0), b3, voffB); PG8_STAGE(PG8_SB(1, 1), b3 + hstep, voffB); PG8_STAGE(PG8_SA(1, 0), a3, voffA);
            PG8_WAIT_V(8); PG8_WAIT_L(0); PG8_BAR; PG8_MMA(1, 0, At, B0); PG8_MMA(1, 1, At, B1); PG8_BAR; PG8_SCHED;
            } else {
            PG8_LDB(B0, 0, 0); PG8_SCHED; PG8_LDA(At, 0, 0); PG8_STAGE(PG8_SA(1, 1), a1 + hstep, voffA);
            PG8_WAIT_L(8); PG8_BAR; PG8_WAIT_L(0); PG8_MMA(0, 0, At, B0); PG8_BAR; PG8_SCHED;
            PG8_LDB(B1, 0, 1); PG8_STAGE(PG8_SB(0, 0), b2, voffB);
            PG8_BAR; PG8_WAIT_L(0); PG8_MMA(0, 1, At, B1); PG8_BAR;
            PG8_LDA(At, 0, 1); PG8_STAGE(PG8_SA(0, 0), a2, voffA);
            PG8_BAR; PG8_WAIT_L(0); PG8_MMA(1, 0, At, B0); PG8_BAR; PG8_SCHED;
            PG8_STAGE(PG8_SB(0, 1), b2 + hstep, voffB);
            PG8_WAIT_V(6); PG8_BAR; PG8_MMA(1, 1, At, B1); PG8_BAR;
            PG8_LDB(B0, 1, 0); PG8_SCHED; PG8_LDA(At, 1, 0); PG8_STAGE(PG8_SA(0, 1), a2 + hstep, voffA);
            PG8_WAIT_L(8); PG8_BAR; PG8_WAIT_L(0); PG8_MMA(0, 0, At, B0); PG8_BAR; PG8_SCHED;
            PG8_LDB(B1, 1, 1); PG8_STAGE(PG8_SB(1, 0), b3, voffB);
            PG8_BAR; PG8_WAIT_L(0); PG8_MMA(0, 1, At, B1); PG8_BAR;
            PG8_LDA(At, 1, 1); PG8_STAGE(PG8_SA(1, 0), a3, voffA);
            PG8_BAR; PG8_WAIT_L(0); PG8_MMA(1, 0, At, B0); PG8_BAR; PG8_SCHED;
            PG8_STAGE(PG8_SB(1, 1), b3 + hstep, voffB);
            PG8_WAIT_V(6); PG8_BAR; PG8_MMA(1, 1, At, B1); PG8_BAR;
            }
        }
        if constexpr (ALIGN_EPI) { if (wr == 0) PG8_BAR; }
        if (ui == 0) MK_STAMP(lds, sb + 1);
        E(acc, cur, ui, wr, wc, fr, fq); S.done(cur);
        if (ui == 0) MK_STAMP(lds, sb + 2);
        if (!has_next) break;
#pragma unroll
        for (int a = 0; a < 2; ++a)
#pragma unroll
            for (int b = 0; b < 2; ++b)
#pragma unroll
                for (int m = 0; m < 4; ++m)
#pragma unroll
                    for (int n = 0; n < 2; ++n) acc[a][b][m][n] = (f32x4){0.f, 0.f, 0.f, 0.f};
        cur = nxt; cA = nA; cB = nB; ++ui;
        if constexpr (ALIGN_EPI) { if (wr == 1) PG8_BAR; }
    }
    MK_STAMP(lds, sb + 3);
    PG8_WAIT_V(0);
    if constexpr (!ALIGN_EPI) { if (wr == 0) PG8_BAR; }
    PG8_BAR;
    MK_STAMP(lds, sb + 4);
#undef PG8_SA
#undef PG8_SB
#undef PG8_STAGE
#undef PG8_LDA
#undef PG8_LDB
#undef PG8_MMA
#undef PG8_WAIT_V
#undef PG8_WAIT_L
#undef PG8_BAR
#undef PG8_SCHED
}
}

constexpr int NWAVES = 8;
constexpr int BATCH = 2, T = 4096, D = 2048, M = BATCH * T;
constexpr int HRET = 8, HKV = 2, FF = 5632;
constexpr int NPB = 5632;
constexpr int NIDXP = 1280;
constexpr int NIN = 6736, NINP = 6912;
constexpr int C_RQ = 0, C_RK = 1024, C_RV = 2048, C_RG = 3072, C_AQ = 4096, C_AK = 5120, C_AV = 5376;
constexpr float NORM_EPS = 1e-6f;

constexpr size_t MiB = 1u << 20;
constexpr size_t WS_CTL = 0, CTL_ZERO_BYTES = 65536;
constexpr size_t WS_TAB = 1 * MiB;
constexpr size_t WS_WGU = 5 * MiB;
constexpr size_t WS_WD = 49 * MiB;
constexpr size_t WS_WIN = 71 * MiB;
constexpr size_t WS_WOUT = 98 * MiB;
constexpr size_t WS_A = 106 * MiB;
constexpr size_t WS_PROJ = 138 * MiB;
constexpr size_t WS_PIDX = 226 * MiB;
constexpr size_t WS_RKT = 266 * MiB;
constexpr size_t WS_RVT = 282 * MiB;
constexpr size_t WS_AVT = 298 * MiB;
constexpr size_t WS_IQ = 302 * MiB;
constexpr size_t WS_IK = 318 * MiB;
constexpr size_t WS_IW = 319 * MiB;
constexpr size_t WS_KV = 320 * MiB;
constexpr size_t WS_ST = 352 * MiB;
constexpr size_t WS_MASK = 368 * MiB;
constexpr size_t WS_SSQ = 372 * MiB;
constexpr size_t WS_TAB2 = 373 * MiB;
constexpr size_t WS_END = 375 * MiB;
constexpr int CW_BAR = 4096;

constexpr int RING_BYTES = 131072;
constexpr int LDS_BYTES = 147456;
constexpr int LDSCTL_OFF = LDS_BYTES - 512, MISC_OFF = LDSCTL_OFF + 320;

#define GAS __attribute__((address_space(1)))
#define LAS __attribute__((address_space(3)))
typedef unsigned short bf16;
typedef _Float16 f16;
typedef _Float16 half8 __attribute__((ext_vector_type(8)));
typedef _Float16 half2v __attribute__((ext_vector_type(2)));
typedef float float2v __attribute__((ext_vector_type(2)));
typedef unsigned v4u __attribute__((ext_vector_type(4)));
typedef unsigned v2u __attribute__((ext_vector_type(2)));
typedef float f32x2 __attribute__((ext_vector_type(2)));
typedef float f32x4 __attribute__((ext_vector_type(4)));
typedef float f32x16 __attribute__((ext_vector_type(16)));
typedef short bf16x8 __attribute__((ext_vector_type(8)));
typedef __bf16 bf16x2_t __attribute__((ext_vector_type(2)));
typedef GAS unsigned gu32;
#define LDS_WAIT() asm volatile("s_waitcnt lgkmcnt(0)" ::: "memory")
__device__ __forceinline__ unsigned pk2(float lo, float hi) { f32x2 v = {lo, hi}; bf16x2_t b = __builtin_convertvector(v, bf16x2_t); return __builtin_bit_cast(unsigned, b); }
__device__ __forceinline__ float bflo(unsigned w) { return __uint_as_float(w << 16); }
__device__ __forceinline__ float bfhi(unsigned w) { return __uint_as_float(w & 0xffff0000u); }
__device__ __forceinline__ float silu_f(float g) { return g * __builtin_amdgcn_rcpf(1.f + __builtin_amdgcn_exp2f(-1.4426950408889634f * g)); }

#define XB_TMO      128
#define XB_XCNT(j)  (256  + 64 * (j))
#define XB_XSUB(j)  (1280 + 64 * (j))
#define XB_XGEN(j)  (2304 + 64 * (j))
#define XB_TOP      3328
#define XB_TOPGEN   3392
#define XCD_BAR_WORDS 3456
#define XB_SPIN_CAP (1u << 22)
__device__ __forceinline__ unsigned xb_ld(unsigned* p)              { return __hip_atomic_load(p, __ATOMIC_RELAXED, __HIP_MEMORY_SCOPE_AGENT); }
__device__ __forceinline__ unsigned xb_add(unsigned* p, unsigned v) { return __hip_atomic_fetch_add(p, v, __ATOMIC_RELAXED, __HIP_MEMORY_SCOPE_AGENT); }
__device__ __forceinline__ unsigned xb_xcc_id() { return (unsigned)__builtin_amdgcn_s_getreg((3 << 11) | 20) & 0xFu; }
#define XB_SPIN(cond, bar) do { unsigned _sp = 0; while (cond) { __builtin_amdgcn_s_sleep(1); \
    if ((++_sp & 255u) == 0u) { if (xb_ld(&(bar)[XB_TMO])) break; if (_sp > XB_SPIN_CAP) { atomicAdd(&(bar)[XB_TMO], 1u); break; } } } } while (0)
struct XcdBarrier { unsigned* bar; unsigned x; volatile LAS unsigned* st; };
__device__ __forceinline__ XcdBarrier xcd_barrier_post(unsigned* bar, volatile LAS unsigned* st) {
    XcdBarrier b; b.bar = bar; b.x = xb_xcc_id(); b.st = st;
    if (threadIdx.x == 0) (void)xb_add(&bar[XB_XCNT(b.x)], 1u);
    return b;
}
__device__ __forceinline__ void xcd_barrier_complete(unsigned* bar, unsigned x, unsigned& nloc, unsigned& nx) {
    const unsigned G = gridDim.x * gridDim.y * gridDim.z;
    unsigned sum, cnt, mine, sp = 0u;
    for (;;) {
        sum = 0u; cnt = 0u; mine = 0u;
#pragma unroll
        for (unsigned j = 0; j < 16; ++j) { const unsigned c = xb_ld(&bar[XB_XCNT(j)]); sum += c; cnt += (c > 0u) ? 1u : 0u; mine = (j == x) ? c : mine; }
        if (sum == G) break;
        __builtin_amdgcn_s_sleep(1);
        if ((++sp & 255u) == 0u) { if (xb_ld(&bar[XB_TMO])) break; if (sp > XB_SPIN_CAP) { atomicAdd(&bar[XB_TMO], 1u); break; } }
    }
    nloc = mine > 0u ? mine : 1u; nx = cnt > 0u ? cnt : 1u;
}
__device__ __forceinline__ void xcd_barrier(const XcdBarrier& b) {
    asm volatile("s_waitcnt vmcnt(0)" ::: "memory");
    __syncthreads();
    if (threadIdx.x == 0) {
        unsigned* bar = b.bar;
        __builtin_amdgcn_s_waitcnt(0);
        unsigned nloc = b.st[0], nx = b.st[1];
        if (nloc == 0u) { xcd_barrier_complete(bar, b.x, nloc, nx); b.st[0] = nloc; b.st[1] = nx; }
        const unsigned old = xb_add(&bar[XB_XSUB(b.x)], 1u);
        const unsigned gen = old / nloc;
        if (old + 1u == (gen + 1u) * nloc) {
            __builtin_amdgcn_fence(__ATOMIC_RELEASE, "agent");
            asm volatile("s_waitcnt vmcnt(0)" ::: "memory");
            const unsigned og = xb_add(&bar[XB_TOP], 1u);
            const unsigned tg = og / nx;
            if (og + 1u == (tg + 1u) * nx) xb_add(&bar[XB_TOPGEN], 1u);
            else XB_SPIN(xb_ld(&bar[XB_TOPGEN]) == tg, bar);
            __builtin_amdgcn_fence(__ATOMIC_ACQUIRE, "agent");
            xb_add(&bar[XB_XGEN(b.x)], 1u);
            asm volatile("s_waitcnt vmcnt(0)" ::: "memory");
        } else {
            XB_SPIN(xb_ld(&bar[XB_XGEN(b.x)]) == gen, bar);
            __builtin_amdgcn_fence(__ATOMIC_ACQUIRE, "agent");
            asm volatile("s_waitcnt vmcnt(0)" ::: "memory");
        }
    }
    __syncthreads();
}

struct Frame {
    LAS unsigned char* lds;
    int tid, lane, wave;
    int bid, G;
    const float* x; const int* pos;
    const float *n1, *wg1, *wu1, *wd1, *nmix, *win, *nret, *wout, *n2, *wg2, *wu2, *wd2, *nfin;
    float* X;
    unsigned char* ws;
};

__device__ __forceinline__ float wave_sum(float v) {
#pragma unroll
    for (int o = 1; o < 64; o <<= 1) v += __shfl_xor(v, o);
    return v;
}

__device__ __forceinline__ float xor16_sum(float m);
__device__ __forceinline__ float xor32_sum(float m);
constexpr int RS_OFF = RING_BYTES, RS_MAXU = 6;
__device__ __forceinline__ void load_rstd_panels(Frame& F, const pg8::StaticOrder& S, const float* ssq) {
    LAS float* rs = (LAS float*)(F.lds + RS_OFF);
    const int r = F.tid >> 1, hf = F.tid & 1;
    f32x4 p[RS_MAXU][4]; bool ok[RS_MAXU];
#pragma unroll
    for (int i = 0; i < RS_MAXU; ++i) { pg8::Unit u; ok[i] = S.next(i, u);
        if (ok[i]) { const f32x4* q = (const f32x4*)(ssq + (size_t)(u.pm * 256 + r) * 32 + 16 * hf);
#pragma unroll
            for (int k = 0; k < 4; ++k) p[i][k] = q[k]; } }
#pragma unroll
    for (int i = 0; i < RS_MAXU; ++i) if (ok[i]) {
        const f32x4 s4 = (p[i][0] + p[i][1]) + (p[i][2] + p[i][3]);
        float s = (s4.x + s4.y) + (s4.z + s4.w);
        s += __shfl_xor(s, 1);
        if (hf == 0) rs[i * 256 + r] = 1.0f / sqrtf(s * (1.f / D) + NORM_EPS);
    }
    __syncthreads();
}
struct EpiSwiGLU {
    static constexpr bool PERM = true;
    bf16* H; const LAS float* rs;
    __device__ __forceinline__ void operator()(const f32x4 (&acc)[2][2][4][2], const pg8::Unit& u, int ui, int wr, int wc, int fr, int fq) const {
        const int row0 = u.pm * 256 + wr * 64 + fr, col0 = u.pn * 128 + wc * 32 + 8 * fq;
#pragma unroll
        for (int ai = 0; ai < 2; ++ai)
#pragma unroll
            for (int m = 0; m < 4; ++m) {
                const int row = row0 + ai * 128 + m * 16;
                const float r = rs[ui * 256 + ai * 128 + wr * 64 + m * 16 + fr];
                bf16* rowp = H + (size_t)row * FF + col0;
                const f32x4 g0 = acc[ai][0][m][0] * r, g1 = acc[ai][0][m][1] * r, u0 = acc[ai][1][m][0] * r, u1 = acc[ai][1][m][1] * r;
                v4u w;
                w.x = pk2(silu_f(g0[0]) * u0[0], silu_f(g0[1]) * u0[1]); w.y = pk2(silu_f(g0[2]) * u0[2], silu_f(g0[3]) * u0[3]);
                w.z = pk2(silu_f(g1[0]) * u1[0], silu_f(g1[1]) * u1[1]); w.w = pk2(silu_f(g1[2]) * u1[2], silu_f(g1[3]) * u1[3]);
                *(v4u*)rowp = w;
            }
    }
};
template <bool BASEF> struct EpiResid {
    static constexpr bool PERM = true;
    const float* basef; bf16* Ab; float alpha; float* ssq;
    __device__ __forceinline__ void operator()(const f32x4 (&acc)[2][2][4][2], const pg8::Unit& u, int ui, int wr, int wc, int fr, int fq) const {
        const int row0 = u.pm * 256 + wr * 64 + fr, col0 = u.pn * 256 + wc * 32 + 8 * fq;
#pragma unroll
        for (int ai = 0; ai < 2; ++ai) {
            f32x4 bf0[4][2], bf1[4][2]; v4u bw[4][2];
#pragma unroll
            for (int m = 0; m < 4; ++m)
#pragma unroll
                for (int bj = 0; bj < 2; ++bj) {
                    const size_t off = (size_t)(row0 + ai * 128 + m * 16) * D + col0 + bj * 128;
                    if constexpr (BASEF) { bf0[m][bj] = __builtin_nontemporal_load((const f32x4*)(basef + off)); bf1[m][bj] = __builtin_nontemporal_load((const f32x4*)(basef + off + 4)); }
                    else bw[m][bj] = *(const v4u*)(Ab + off);
                }
            asm volatile("" ::: "memory");
#pragma unroll
            for (int m = 0; m < 4; ++m) {
                const int row = row0 + ai * 128 + m * 16;
                float sq = 0.f;
#pragma unroll
                for (int bj = 0; bj < 2; ++bj) {
                    const size_t off = (size_t)row * D + col0 + bj * 128;
                    f32x4 b0, b1;
                    if constexpr (BASEF) { b0 = bf0[m][bj]; b1 = bf1[m][bj]; }
                    else { const v4u w = bw[m][bj]; b0 = (f32x4){bflo(w.x), bfhi(w.x), bflo(w.y), bfhi(w.y)}; b1 = (f32x4){bflo(w.z), bfhi(w.z), bflo(w.w), bfhi(w.w)}; }
                    const f32x4 v0 = b0 + acc[ai][bj][m][0] * alpha, v1 = b1 + acc[ai][bj][m][1] * alpha;
                    sq += (v0.x * v0.x + v0.y * v0.y) + (v0.z * v0.z + v0.w * v0.w) + (v1.x * v1.x + v1.y * v1.y) + (v1.z * v1.z + v1.w * v1.w);
                    v4u w; w.x = pk2(v0.x, v0.y); w.y = pk2(v0.z, v0.w); w.z = pk2(v1.x, v1.y); w.w = pk2(v1.z, v1.w);
                    *(v4u*)(Ab + off) = w;
                }
                sq = xor16_sum(sq); sq = xor32_sum(sq);
                if (fq == 0) ssq[(size_t)row * 32 + u.pn * 4 + wc] = sq;
            }
        }
    }
};
__device__ __forceinline__ float lg2_gamma(int h);
typedef _Float16 half4 __attribute__((ext_vector_type(4)));
struct EpiProj {
    static constexpr bool PERM = true;
    unsigned char* ws; const LAS float* rs;
    __device__ __forceinline__ void operator()(const f32x4 (&acc)[2][2][4][2], const pg8::Unit& u, int ui, int wr, int wc, int fr, int fq) const {
        const int row0 = u.pm * 256 + wr * 64 + fr, t = u.pn;
        bf16* PROJ = (bf16*)(ws + WS_PROJ);
        if (t < 8 || (t >= 16 && t <= 20)) {
            const int typ = t < 4 ? 0 : t < 8 ? 1 : t < 20 ? 2 : 3;
            const int tb = typ == 0 ? 0 : typ == 1 ? 4 : typ == 2 ? 16 : 20, cb = typ == 0 ? C_RQ : typ == 1 ? C_RK : typ == 2 ? C_AQ : C_AK;
            const int hd = 2 * (t - tb) + (wc >> 1), i0 = 32 * (wc & 1) + 8 * fq;
            const float lg = lg2_gamma(hd);
            const float2* TAB = (const float2*)(ws + WS_TAB);
#pragma unroll
            for (int ai = 0; ai < 2; ++ai) {
#pragma unroll
              for (int mp = 0; mp < 2; ++mp) {
                f32x4 cst[2][4];
#pragma unroll
                for (int mm = 0; mm < 2; ++mm) { const f32x4* tp = (const f32x4*)(TAB + (size_t)(row0 + ai * 128 + (2 * mp + mm) * 16) * 64 + i0);
#pragma unroll
                    for (int k = 0; k < 4; ++k) cst[mm][k] = tp[k]; }
                asm volatile("" ::: "memory");
#pragma unroll
                for (int mm = 0; mm < 2; ++mm) {
                    const int m = 2 * mp + mm;
                    const int row = row0 + ai * 128 + m * 16;
                    const float r = rs[ui * 256 + ai * 128 + wr * 64 + m * 16 + fr];
                    const f32x4 c01 = cst[mm][0], c23 = cst[mm][1], c45 = cst[mm][2], c67 = cst[mm][3];
                    const float pcf = (float)((row & 127) + 1);
                    const float sc = r * (typ == 0 ? __builtin_amdgcn_exp2f(lg * pcf) : typ == 1 ? 0.08838834764831845f * __builtin_amdgcn_exp2f(-lg * pcf) : typ == 2 ? 0.08838834764831845f * 1.4426950408889634f : 1.f);
                    const f32x4 a0 = acc[ai][0][m][0], a1 = acc[ai][0][m][1], b0 = acc[ai][1][m][0], b1 = acc[ai][1][m][1];
                    v4u o1, o2;
                    o1.x = pk2((a0.x * c01.x - b0.x * c01.y) * sc, (a0.y * c01.z - b0.y * c01.w) * sc); o1.y = pk2((a0.z * c23.x - b0.z * c23.y) * sc, (a0.w * c23.z - b0.w * c23.w) * sc);
                    o1.z = pk2((a1.x * c45.x - b1.x * c45.y) * sc, (a1.y * c45.z - b1.y * c45.w) * sc); o1.w = pk2((a1.z * c67.x - b1.z * c67.y) * sc, (a1.w * c67.z - b1.w * c67.w) * sc);
                    o2.x = pk2((b0.x * c01.x + a0.x * c01.y) * sc, (b0.y * c01.z + a0.y * c01.w) * sc); o2.y = pk2((b0.z * c23.x + a0.z * c23.y) * sc, (b0.w * c23.z + a0.w * c23.w) * sc);
                    o2.z = pk2((b1.x * c45.x + a1.x * c45.y) * sc, (b1.y * c45.z + a1.y * c45.w) * sc); o2.w = pk2((b1.z * c67.x + a1.z * c67.y) * sc, (b1.w * c67.z + a1.w * c67.w) * sc);
                    bf16* rowp = PROJ + (size_t)row * NPB + cb + hd * 128 + i0;
                    *(v4u*)rowp = o1; *(v4u*)(rowp + 64) = o2;
                }
              }
            }
        } else if (t < 22) {
            const bool gate = (t >= 12 && t < 16);
            const int col0 = t * 256 + wc * 32 + 8 * fq;
#pragma unroll
            for (int ai = 0; ai < 2; ++ai)
#pragma unroll
                for (int m = 0; m < 4; ++m) {
                    const int row = row0 + ai * 128 + m * 16;
                    const float r = rs[ui * 256 + ai * 128 + wr * 64 + m * 16 + fr];
                    bf16* rowp = PROJ + (size_t)row * NPB + col0;
#pragma unroll
                    for (int bj = 0; bj < 2; ++bj) {
                        f32x4 v0 = acc[ai][bj][m][0] * r, v1 = acc[ai][bj][m][1] * r;
                        if (gate) { v0 = (f32x4){silu_f(v0.x), silu_f(v0.y), silu_f(v0.z), silu_f(v0.w)}; v1 = (f32x4){silu_f(v1.x), silu_f(v1.y), silu_f(v1.z), silu_f(v1.w)}; }
                        v4u w; w.x = pk2(v0[0], v0[1]); w.y = pk2(v0[2], v0[3]); w.z = pk2(v1[0], v1[1]); w.w = pk2(v1[2], v1[3]);
                        *(v4u*)(rowp + bj * 128) = w;
                    }
                }
        } else if (t < 26 || wc == 0) {
            const bool isq = t < 26;
            const int hd = 4 * (t - 22) + wc, i0 = 8 * fq;
            const float2* TAB2 = (const float2*)(ws + WS_TAB2);
            f16* OUT = isq ? (f16*)(ws + WS_IQ) : (f16*)(ws + WS_IK);
            const int ld = isq ? 1024 : 64, cb = isq ? hd * 64 : 0;
            const float s8 = isq ? 0.125f : 1.f;
#pragma unroll
            for (int ai = 0; ai < 2; ++ai) {
#pragma unroll
              for (int mp = 0; mp < 2; ++mp) {
                f32x4 cst[2][4];
#pragma unroll
                for (int mm = 0; mm < 2; ++mm) { const f32x4* tp = (const f32x4*)(TAB2 + (size_t)(row0 + ai * 128 + (2 * mp + mm) * 16) * 32 + i0);
#pragma unroll
                    for (int k = 0; k < 4; ++k) cst[mm][k] = tp[k]; }
                asm volatile("" ::: "memory");
#pragma unroll
                for (int mm = 0; mm < 2; ++mm) {
                    const int m = 2 * mp + mm;
                    const int row = row0 + ai * 128 + m * 16;
                    const float sc = rs[ui * 256 + ai * 128 + wr * 64 + m * 16 + fr] * s8;
                    const f32x4 c01 = cst[mm][0], c23 = cst[mm][1], c45 = cst[mm][2], c67 = cst[mm][3];
                    const f32x4 a0 = acc[ai][0][m][0], a1 = acc[ai][0][m][1], b0 = acc[ai][1][m][0], b1 = acc[ai][1][m][1];
                    half8 h1, h2;
                    h1[0] = (f16)((a0.x * c01.x - b0.x * c01.y) * sc); h1[1] = (f16)((a0.y * c01.z - b0.y * c01.w) * sc); h1[2] = (f16)((a0.z * c23.x - b0.z * c23.y) * sc); h1[3] = (f16)((a0.w * c23.z - b0.w * c23.w) * sc);
                    h1[4] = (f16)((a1.x * c45.x - b1.x * c45.y) * sc); h1[5] = (f16)((a1.y * c45.z - b1.y * c45.w) * sc); h1[6] = (f16)((a1.z * c67.x - b1.z * c67.y) * sc); h1[7] = (f16)((a1.w * c67.z - b1.w * c67.w) * sc);
                    h2[0] = (f16)((b0.x * c01.x + a0.x * c01.y) * sc); h2[1] = (f16)((b0.y * c01.z + a0.y * c01.w) * sc); h2[2] = (f16)((b0.z * c23.x + a0.z * c23.y) * sc); h2[3] = (f16)((b0.w * c23.z + a0.w * c23.w) * sc);
                    h2[4] = (f16)((b1.x * c45.x + a1.x * c45.y) * sc); h2[5] = (f16)((b1.y * c45.z + a1.y * c45.w) * sc); h2[6] = (f16)((b1.z * c67.x + a1.z * c67.y) * sc); h2[7] = (f16)((b1.w * c67.z + a1.w * c67.w) * sc);
                    f16* rowp = OUT + (size_t)row * ld + cb + i0;
                    *(half8*)rowp = h1; *(half8*)(rowp + 32) = h2;
                }
              }
            }
        } else if (wc == 1 && fq < 2) {
#pragma unroll
            for (int ai = 0; ai < 2; ++ai)
#pragma unroll
                for (int m = 0; m < 4; ++m) {
                    const int row = row0 + ai * 128 + m * 16;
                    const float sc = rs[ui * 256 + ai * 128 + wr * 64 + m * 16 + fr] * 0.25f;
                    float* rowp = (float*)(ws + WS_IW) + (size_t)row * 16 + 8 * fq;
                    *(f32x4*)rowp = acc[ai][0][m][0] * sc; *(f32x4*)(rowp + 4) = acc[ai][0][m][1] * sc;
                }
        }
    }
};

__device__ __forceinline__ int win_row(int n) {
    if (n < 2048 || (n >= 4096 && n < 5376)) { const int base = n < 1024 ? 0 : n < 2048 ? 1024 : n < 5120 ? 4096 : 5120; const int rel = n - base, head = rel >> 7, half = (rel >> 6) & 1, i = rel & 63;
        return base + 256 * (head >> 1) + 128 * half + 64 * (head & 1) + i; }
    if (n < 5632) return n;
    if (n < 6656) { const int rel = n - 5632, head = rel >> 6, half = (rel >> 5) & 1, i = rel & 31; return 5632 + 256 * (head >> 2) + 128 * half + 32 * (head & 3) + i; }
    if (n < 6720) { const int rel = n - 6656; return 6656 + 128 * (rel >> 5) + (rel & 31); }
    return 6656 + 32 + (n - 6720);
}
struct CvItem { const float* W; const float* g; bf16* WT; int K, N, k0, n0, gu, up; };
constexpr int CV_G = (D / 64) * (FF / 256), CV_D = (FF / 64) * (D / 256), CV_I = (D / 64) * ((NIN + 255) / 256), CV_O = (D / 64) * (D / 256);
constexpr int CV_TILE = 64 * 257 * 4;
template <int JOB> __device__ __forceinline__ constexpr int cv_total() { return JOB == 0 ? 2 * CV_G : JOB == 1 ? CV_D + CV_I : JOB == 2 ? 2 * CV_G + CV_O : CV_D; }
template <int JOB> __device__ __forceinline__ void cv_decode(const Frame& F, int it, CvItem& x) {
    x.gu = 0; x.up = 0; x.g = nullptr;
    if (JOB == 0 || JOB == 2) {
        const float* wg = JOB == 0 ? F.wg1 : F.wg2; const float* wu = JOB == 0 ? F.wu1 : F.wu2;
        if (it < 2 * CV_G) { const int up = it >= CV_G, r = up ? it - CV_G : it, kb = r / (FF / 256), nb = r % (FF / 256);
            x.W = up ? wu : wg; x.g = JOB == 0 ? F.n1 : F.n2; x.WT = ((bf16*)(F.ws + WS_WGU)); x.K = D; x.N = FF; x.k0 = 64 * kb; x.n0 = 256 * nb; x.gu = 1; x.up = up; return; }
        it -= 2 * CV_G;
        { const int kb = it / (D / 256), nb = it % (D / 256); x.W = F.wout; x.WT = ((bf16*)(F.ws + WS_WOUT)); x.K = D; x.N = D; x.k0 = 64 * kb; x.n0 = 256 * nb; }
    } else {
        if (it < CV_D) { const int kb = it / (D / 256), nb = it % (D / 256); x.W = JOB == 1 ? F.wd1 : F.wd2; x.WT = ((bf16*)(F.ws + WS_WD)); x.K = FF; x.N = D; x.k0 = 64 * kb; x.n0 = 256 * nb; return; }
        it -= CV_D;
        constexpr int NBI = (NIN + 255) / 256;
        { const int kb = it / NBI, nb = it % NBI; x.W = F.win; x.g = F.nmix; x.WT = ((bf16*)(F.ws + WS_WIN)); x.K = D; x.N = NIN; x.k0 = 64 * kb; x.n0 = 256 * nb; x.gu = 2; }
    }
}
__device__ __forceinline__ void cv_load(const CvItem& x, f32x4 (&v)[8], int wave, int lane) {
    const bool okc = (x.n0 + 4 * lane) < x.N;
    const float* p = x.W + (size_t)(x.k0 + 8 * wave) * x.N + x.n0 + 4 * lane;
#pragma unroll
    for (int i = 0; i < 8; ++i) v[i] = okc ? __builtin_nontemporal_load((const f32x4*)(p + (size_t)i * x.N)) : (f32x4){0.f, 0.f, 0.f, 0.f};
}
__device__ __forceinline__ void cv_gain(const CvItem& x, f32x4 (&gq)[2], int wave) {
    if (x.g) { const f32x4* q = (const f32x4*)(x.g + x.k0 + 8 * wave); gq[0] = q[0]; gq[1] = q[1]; }
    else { gq[0] = (f32x4){1.f, 1.f, 1.f, 1.f}; gq[1] = gq[0]; }
}
template <int JOB> __device__ __forceinline__ void convert_job(Frame& F, int w, int nw) {
    const int lane = F.lane, wave = F.wave, c = lane & 7, nn = lane >> 3;
    constexpr int total = cv_total<JOB>();
    CvItem x0, x1, x2; f32x4 v0[8], v1[8], v2[8], g0[2], g1[2], g2[2];
    if (w < total) { cv_decode<JOB>(F, w, x0); cv_load(x0, v0, wave, lane); cv_gain(x0, g0, wave); }
    if (w + nw < total) { cv_decode<JOB>(F, w + nw, x1); cv_load(x1, v1, wave, lane); cv_gain(x1, g1, wave); }
    int par = 0;
    for (int it = w; it < total; it += nw) {
        LAS float* tile = (LAS float*)(F.lds + par * CV_TILE);
#pragma unroll
        for (int i = 0; i < 8; ++i) { LAS float* s = tile + (8 * wave + i) * 257 + 4 * lane; const float gs = g0[i >> 2][i & 3]; s[0] = v0[i].x * gs; s[1] = v0[i].y * gs; s[2] = v0[i].z * gs; s[3] = v0[i].w * gs; }
        if (it + 2 * nw < total) { cv_decode<JOB>(F, it + 2 * nw, x2); cv_load(x2, v2, wave, lane); cv_gain(x2, g2, wave); }
        __syncthreads();
#pragma unroll
        for (int q = 0; q < 4; ++q) {
            const int n = 32 * wave + nn + 8 * q, ncol = x0.n0 + n;
            const LAS float* s = tile + (8 * c) * 257 + n;
            v4u o; o.x = pk2(s[0 * 257], s[1 * 257]); o.y = pk2(s[2 * 257], s[3 * 257]); o.z = pk2(s[4 * 257], s[5 * 257]); o.w = pk2(s[6 * 257], s[7 * 257]);
            const int drow = x0.gu == 1 ? (((ncol >> 7) << 8) + (ncol & 127) + (x0.up ? 128 : 0)) : x0.gu == 2 ? win_row(ncol) : ncol;
            if (ncol < x0.N) __builtin_nontemporal_store(o, (v4u*)(x0.WT + (size_t)drow * x0.K + x0.k0 + 8 * c));
        }
        x0 = x1; x1 = x2;
#pragma unroll
        for (int i = 0; i < 8; ++i) { v0[i] = v1[i]; v1[i] = v2[i]; }
        g0[0] = g1[0]; g0[1] = g1[1]; g1[0] = g2[0]; g1[1] = g2[1];
        par ^= 1;
    }
    __syncthreads();
    if (JOB == 1) {
        v4u* z0 = (v4u*)(((bf16*)(F.ws + WS_WIN)) + (size_t)6704 * D); v4u* z1 = (v4u*)(((bf16*)(F.ws + WS_WIN)) + (size_t)6816 * D);
        for (int i = w * 512 + F.tid; i < 80 * D / 8; i += nw * 512) z0[i] = (v4u){0u, 0u, 0u, 0u};
        for (int i = w * 512 + F.tid; i < 96 * D / 8; i += nw * 512) z1[i] = (v4u){0u, 0u, 0u, 0u};
    }
}
__device__ __forceinline__ void prep_rows(Frame& F, const float* src, bf16* dst) {
    const int gw = F.bid * NWAVES + F.wave, NGW = F.G * NWAVES, lane = F.lane;
    f32x4 v[8], vn[8];
    if (gw < M) {
#pragma unroll
        for (int j = 0; j < 8; ++j) v[j] = __builtin_nontemporal_load((const f32x4*)(src + (size_t)gw * D) + lane + 64 * j);
    }
    for (int m = gw; m < M; m += NGW) {
        if (m + NGW < M) {
#pragma unroll
            for (int j = 0; j < 8; ++j) vn[j] = __builtin_nontemporal_load((const f32x4*)(src + (size_t)(m + NGW) * D) + lane + 64 * j);
        }
        float s = 0.f;
#pragma unroll
        for (int j = 0; j < 8; ++j) s += (v[j].x * v[j].x + v[j].y * v[j].y) + (v[j].z * v[j].z + v[j].w * v[j].w);
        s = wave_sum(s);
        v2u* o8 = (v2u*)(dst + (size_t)m * D) + lane;
#pragma unroll
        for (int j = 0; j < 8; ++j) { v2u w; w.x = pk2(v[j].x, v[j].y); w.y = pk2(v[j].z, v[j].w); o8[64 * j] = w; }
        if (lane < 32) ((float*)(F.ws + WS_SSQ))[(size_t)m * 32 + lane] = (lane == 0) ? s : 0.f;
#pragma unroll
        for (int j = 0; j < 8; ++j) v[j] = vn[j];
    }
}
__device__ __forceinline__ void rms_final(Frame& F) {
    const int gw = F.bid * NWAVES + F.wave, NGW = F.G * NWAVES, lane = F.lane;
    const f32x4* gr = (const f32x4*)F.nfin + lane;
    f32x4 gg[8];
#pragma unroll
    for (int j = 0; j < 8; ++j) gg[j] = gr[64 * j];
    v2u w[8], wn[8]; float sp = 0.f, spn = 0.f;
    if (gw < M) {
#pragma unroll
        for (int j = 0; j < 8; ++j) w[j] = ((const v2u*)(((bf16*)(F.ws + WS_A)) + (size_t)gw * D) + lane)[64 * j];
        sp = lane < 32 ? ((float*)(F.ws + WS_SSQ))[(size_t)gw * 32 + lane] : 0.f;
    }
    for (int m = gw; m < M; m += NGW) {
        if (m + NGW < M) {
#pragma unroll
            for (int j = 0; j < 8; ++j) wn[j] = ((const v2u*)(((bf16*)(F.ws + WS_A)) + (size_t)(m + NGW) * D) + lane)[64 * j];
            spn = lane < 32 ? ((float*)(F.ws + WS_SSQ))[(size_t)(m + NGW) * 32 + lane] : 0.f;
        }
        const float s = wave_sum(sp);
        const float rstd = 1.0f / sqrtf(s * (1.f / D) + NORM_EPS);
        f32x4* xr = (f32x4*)(F.X + (size_t)m * D) + lane;
#pragma unroll
        for (int j = 0; j < 8; ++j) __builtin_nontemporal_store((f32x4){bflo(w[j].x), bfhi(w[j].x), bflo(w[j].y), bfhi(w[j].y)} * rstd * gg[j], xr + 64 * j);
#pragma unroll
        for (int j = 0; j < 8; ++j) w[j] = wn[j];
        sp = spn;
    }
}
__device__ __forceinline__ void rope_table(Frame& F) {
    const int gt = F.bid * (NWAVES * 64) + F.tid, NT = F.G * NWAVES * 64;
    for (int e = gt; e < M * 64; e += NT) {
        const int m = e >> 6, i = e & 63;
        double inv = 1.0; const double rr = 8.65964323360065346691e-01;
        for (int k = 0; k < i; ++k) inv *= rr;
        const float invf = (float)inv;
        const float angf = (float)F.pos[m] * invf;
        const double ang = (double)angf;
        const double kq = __builtin_rint(ang * 0.63661977236758134308);
        double y = __builtin_fma(-kq, 1.57079632679489655800e+00, ang);
        y = __builtin_fma(-kq, 6.12323399573676603587e-17, y);
        const double y2 = y * y;
        double sn = 1.0 / 6227020800.0; sn = sn * y2 - 1.0 / 39916800.0; sn = sn * y2 + 1.0 / 362880.0; sn = sn * y2 - 1.0 / 5040.0; sn = sn * y2 + 1.0 / 120.0; sn = sn * y2 - 1.0 / 6.0; sn = sn * y2 * y + y;
        double cs = 1.0 / 479001600.0; cs = cs * y2 - 1.0 / 3628800.0; cs = cs * y2 + 1.0 / 40320.0; cs = cs * y2 - 1.0 / 720.0; cs = cs * y2 + 1.0 / 24.0; cs = cs * y2 - 0.5; cs = cs * y2 + 1.0;
        const int q = ((int)kq) & 3;
        const double c = (q == 0) ? cs : (q == 1) ? -sn : (q == 2) ? -cs : sn;
        const double s = (q == 0) ? sn : (q == 1) ? cs : (q == 2) ? -sn : -cs;
        ((float2*)(F.ws + WS_TAB))[e] = make_float2((float)c, (float)s);
        if ((i & 1) == 0) ((float2*)(F.ws + WS_TAB2))[(size_t)m * 32 + (i >> 1)] = make_float2((float)c, (float)s);
    }
}
__device__ __forceinline__ float lg2_gamma(int h) {
    const double x = __builtin_amdgcn_exp2f((float)(-5 - h));
    double s = 1.0 / 8.0; s = s * x + 1.0 / 7.0; s = s * x + 1.0 / 6.0; s = s * x + 0.2; s = s * x + 0.25; s = s * x + 1.0 / 3.0; s = s * x + 0.5; s = s * x + 1.0; s = -s * x;
    return (float)(s * 1.44269504088896338700);
}

constexpr int PT_IMG = 32 * 132 * 4;
__device__ __forceinline__ void post_tile(Frame& F, int tt) {
    const int tid = F.tid;
    const int m0 = tt * 32, b = m0 / T, tp0 = m0 % T;
    const int ltok = tid >> 4, lc8 = (tid & 15) * 8;
    const bf16* gp0 = ((bf16*)(F.ws + WS_PROJ)) + (size_t)(m0 + ltok) * NPB + lc8;
#define PT_COL(s_) ((s_) < 8 ? C_RK + (s_) * 128 : (s_) < 16 ? C_RV + ((s_) - 8) * 128 : C_AV + ((s_) - 16) * 128)
    v4u cur[2], nxt[2];
    cur[0] = *(const v4u*)(gp0 + PT_COL(0)); cur[1] = *(const v4u*)(gp0 + PT_COL(1)); nxt[0] = cur[0]; nxt[1] = cur[1];
    for (int sp = 0; sp < 9; ++sp) {
        if (sp + 1 < 9) { nxt[0] = *(const v4u*)(gp0 + PT_COL(2 * sp + 2)); nxt[1] = *(const v4u*)(gp0 + PT_COL(2 * sp + 3)); }
#pragma unroll
        for (int k = 0; k < 2; ++k) {
            LAS float* lp = (LAS float*)(F.lds + ((sp & 1) * 2 + k) * PT_IMG) + ltok * 132 + lc8; const v4u w = cur[k];
            lp[0] = bflo(w.x); lp[1] = bfhi(w.x); lp[2] = bflo(w.y); lp[3] = bfhi(w.y); lp[4] = bflo(w.z); lp[5] = bfhi(w.z); lp[6] = bflo(w.w); lp[7] = bfhi(w.w);
        }
        __syncthreads();
#pragma unroll
        for (int k = 0; k < 2; ++k) {
            const int s = 2 * sp + k;
            const int typ = s < 8 ? 1 : s < 16 ? 2 : 6, h = s < 16 ? (s & 7) : (s & 1);
            const int d = tid >> 2, t8 = (tid & 3) * 8;
            bf16* tb = (typ == 1) ? ((bf16*)(F.ws + WS_RKT)) + ((size_t)(b * 8 + h) * 128 + d) * T : (typ == 2) ? ((bf16*)(F.ws + WS_RVT)) + ((size_t)(b * 8 + h) * 128 + d) * T : ((bf16*)(F.ws + WS_AVT)) + ((size_t)(b * 2 + h) * 128 + d) * T;
            const LAS float* lp = (const LAS float*)(F.lds + ((sp & 1) * 2 + k) * PT_IMG) + t8 * 132 + d;
            v4u w; w.x = pk2(lp[0], lp[132]); w.y = pk2(lp[264], lp[396]); w.z = pk2(lp[528], lp[660]); w.w = pk2(lp[792], lp[924]);
            if (typ != 6) *(v4u*)(tb + tp0 + t8) = w;
            else {
                const int p0 = 8 * ((t8 >> 2) & 3) + 4 * (t8 >> 4);
                *(v2u*)(tb + tp0 + p0) = (v2u){w.x, w.y}; *(v2u*)(tb + tp0 + p0 + 8) = (v2u){w.z, w.w};
            }
        }
        cur[0] = nxt[0]; cur[1] = nxt[1];
    }
#undef PT_COL
    __syncthreads();
}

#define MFMA32(a, b, c) __builtin_amdgcn_mfma_f32_32x32x16_bf16((a), (b), (c), 0, 0, 0)
#define MFMA16(a, b, c) __builtin_amdgcn_mfma_f32_16x16x32_bf16((a), (b), (c), 0, 0, 0)
__device__ __forceinline__ f32x16 zero16() { f32x16 z;
#pragma unroll
    for (int i = 0; i < 16; ++i) z[i] = 0.f; return z; }
constexpr int KV_PITCH = 272, KV_TB = 128 * KV_PITCH;
__device__ __forceinline__ void ret_kv_stage(Frame& F, int u2) {
    const int tid = F.tid, row0 = tid >> 4, c = tid & 15;
#pragma unroll 1
    for (int us = 0; us < 2; ++us) {
        const int unit = 2 * u2 + us, bh = unit >> 5, t0 = (unit & 31) * 128;
        v4u kr[4], vr[4];
#pragma unroll
        for (int j = 0; j < 4; ++j) {
            const int row = row0 + 32 * j;
            kr[j] = *(const v4u*)(((bf16*)(F.ws + WS_RKT)) + ((size_t)bh * 128 + row) * T + t0 + 8 * c);
            vr[j] = *(const v4u*)(((bf16*)(F.ws + WS_RVT)) + ((size_t)bh * 128 + row) * T + t0 + 8 * c);
        }
#pragma unroll
        for (int j = 0; j < 4; ++j) {
            const int row = row0 + 32 * j;
            *(LAS v4u*)(F.lds + us * 2 * KV_TB + row * KV_PITCH + 16 * c) = kr[j];
            *(LAS v4u*)(F.lds + us * 2 * KV_TB + KV_TB + row * KV_PITCH + 16 * c) = vr[j];
        }
    }
    __syncthreads();
}
__device__ __forceinline__ void ret_kv_unit(Frame& F, int unit, int w4, int lane) {
    const int r = lane & 31, hi = lane >> 5, lb = (unit & 1) * 2 * KV_TB;
    f32x16 acc[4];
#pragma unroll
    for (int k = 0; k < 4; ++k) acc[k] = zero16();
#pragma unroll
    for (int s = 0; s < 8; ++s) {
        const bf16x8 bfr = *(const LAS bf16x8*)(F.lds + lb + KV_TB + (32 * w4 + r) * KV_PITCH + (16 * s + 8 * hi) * 2);
#pragma unroll
        for (int blk = 0; blk < 4; ++blk) { const bf16x8 af = *(const LAS bf16x8*)(F.lds + lb + (32 * blk + r) * KV_PITCH + (16 * s + 8 * hi) * 2); acc[blk] = MFMA32(af, bfr, acc[blk]); }
    }
    float* kvp = ((float*)(F.ws + WS_KV)) + ((size_t)unit * 128 + 32 * w4 + r) * 128;
#pragma unroll
    for (int blk = 0; blk < 4; ++blk)
#pragma unroll
        for (int g = 0; g < 4; ++g) *(f32x4*)(kvp + 32 * blk + 8 * g + 4 * hi) = (f32x4){acc[blk][4 * g], acc[blk][4 * g + 1], acc[blk][4 * g + 2], acc[blk][4 * g + 3]};
}
__device__ __forceinline__ void ret_scan(Frame& F) {
    const int gt = F.bid * (NWAVES * 64) + F.tid, NT = F.G * NWAVES * 64;
    for (int idx = gt; idx < 16 * 4096; idx += NT) {
        const int bh = idx >> 12, rem = idx & 4095, h = bh & 7;
        const float gC = __builtin_amdgcn_exp2f(128.f * lg2_gamma(h));
        f32x4 S = {0.f, 0.f, 0.f, 0.f};
        const size_t off0 = ((size_t)(bh * 32) * 16384) + (size_t)rem * 4;
#pragma unroll 1
        for (int n0 = 0; n0 < 32; n0 += 8) {
            f32x4 kv[8];
#pragma unroll
            for (int k = 0; k < 8; ++k) kv[k] = *(const f32x4*)(((float*)(F.ws + WS_KV)) + off0 + (size_t)(n0 + k) * 16384);
#pragma unroll
            for (int k = 0; k < 8; ++k) {
                v2u w; w.x = pk2(S.x, S.y); w.y = pk2(S.z, S.w);
                *(v2u*)(((bf16*)(F.ws + WS_ST)) + off0 + (size_t)(n0 + k) * 16384) = w;
                S = (S + kv[k]) * gC;
            }
        }
    }
}
constexpr int RO_PITCH = 272, RO_KB = 128 * RO_PITCH, RO_UNIT = 2 * RO_KB;
__device__ __forceinline__ void ret_out_stage(Frame& F, int u2) {
    const int tid = F.tid, row0 = tid >> 4, c = tid & 15;
    const int vpos = 32 * (c >> 2) + 16 * ((c & 3) >> 1) + 4 * (c & 1);
#pragma unroll 1
    for (int us = 0; us < 2; ++us) {
        const int unit = 2 * u2 + us, bh = unit >> 5, n = unit & 31, b = bh >> 3, h = bh & 7, t0 = n * 128;
        v4u kr[4], vr[4];
#pragma unroll
        for (int j = 0; j < 4; ++j) {
            const int row = row0 + 32 * j;
            kr[j] = *(const v4u*)(((bf16*)(F.ws + WS_PROJ)) + ((size_t)b * T + t0 + row) * NPB + C_RK + h * 128 + 8 * c);
            vr[j] = *(const v4u*)(((bf16*)(F.ws + WS_RVT)) + ((size_t)bh * 128 + row) * T + t0 + 8 * c);
        }
#pragma unroll
        for (int j = 0; j < 4; ++j) {
            const int row = row0 + 32 * j;
            *(LAS v4u*)(F.lds + us * RO_UNIT + row * RO_PITCH + 16 * c) = kr[j];
            *(LAS v2u*)(F.lds + us * RO_UNIT + RO_KB + row * RO_PITCH + 2 * vpos) = (v2u){vr[j].x, vr[j].y};
            *(LAS v2u*)(F.lds + us * RO_UNIT + RO_KB + row * RO_PITCH + 2 * vpos + 16) = (v2u){vr[j].z, vr[j].w};
        }
    }
    __syncthreads();
}
__device__ __forceinline__ void ret_out_unit(Frame& F, int unit, int I, int lane) {
    const int lb = ((unit & 1) * RO_UNIT);
    const int bh = unit >> 5, n = unit & 31, b = bh >> 3, h = bh & 7, t0 = n * 128, r = lane & 31, hi = lane >> 5;
    const size_t tokI = (size_t)b * T + t0 + 32 * I + r;
    bf16x8 qf[8];
    { const bf16* qp = ((bf16*)(F.ws + WS_PROJ)) + tokI * NPB + C_RQ + h * 128 + 8 * hi;
#pragma unroll
      for (int s = 0; s < 8; ++s) qf[s] = *(const bf16x8*)(qp + 16 * s); }
    f32x16 out[4];
#pragma unroll
    for (int k = 0; k < 4; ++k) out[k] = zero16();
    { const bf16* sp = ((bf16*)(F.ws + WS_ST)) + ((size_t)unit * 128 + r) * 128 + 8 * hi;
#pragma unroll
      for (int blk = 0; blk < 4; ++blk) {
          bf16x8 af[8];
#pragma unroll
          for (int s = 0; s < 8; ++s) af[s] = *(const bf16x8*)(sp + (size_t)blk * 32 * 128 + 16 * s);
          asm volatile("" ::: "memory");
#pragma unroll
          for (int s = 0; s < 8; ++s) out[blk] = MFMA32(af[s], qf[s], out[blk]);
      } }
#pragma unroll 1
    for (int J = 0; J <= I; ++J) {
        asm volatile("" ::: "memory");
        f32x16 X = zero16();
#pragma unroll
        for (int s = 0; s < 8; ++s) { const bf16x8 kf = *(const LAS bf16x8*)(F.lds + lb + (32 * J + r) * RO_PITCH + (16 * s + 8 * hi) * 2); X = MFMA32(kf, qf[s], X); }
        if (J == I) {
            int rr = r; asm volatile("" : "+v"(rr));
#pragma unroll
            for (int g = 0; g < 16; ++g) { const int jrow = (g & 3) + 8 * (g >> 2) + 4 * hi; if (jrow > rr) X[g] = 0.f; }
        }
#pragma unroll
        for (int s2 = 0; s2 < 2; ++s2) {
            v4u xp; xp.x = pk2(X[8 * s2], X[8 * s2 + 1]); xp.y = pk2(X[8 * s2 + 2], X[8 * s2 + 3]); xp.z = pk2(X[8 * s2 + 4], X[8 * s2 + 5]); xp.w = pk2(X[8 * s2 + 6], X[8 * s2 + 7]);
            const bf16x8 xb = __builtin_bit_cast(bf16x8, xp);
#pragma unroll
            for (int blk = 0; blk < 4; ++blk) {
                const bf16x8 av = *(const LAS bf16x8*)(F.lds + lb + RO_KB + (32 * blk + r) * RO_PITCH + (32 * J + 8 * (2 * s2 + hi)) * 2);
                out[blk] = MFMA32(av, xb, out[blk]);
            }
        }
    }
    float s1 = 0.f, s2 = 0.f;
#pragma unroll
    for (int blk = 0; blk < 4; ++blk) {
#pragma unroll
        for (int g = 0; g < 16; ++g) { const float v = out[blk][g]; s1 += v; s2 = __builtin_fmaf(v, v, s2); }
        asm volatile("" : "+v"(s1), "+v"(s2));
    }
    s1 = xor32_sum(s1); s2 = xor32_sum(s2);
    const float mu = s1 * (1.f / 128.f);
    const float rstd = 1.0f / sqrtf(__builtin_fmaxf(s2 * (1.f / 128.f) - mu * mu, 0.f) + NORM_EPS);
    const bf16* gp = ((bf16*)(F.ws + WS_PROJ)) + tokI * NPB + C_RG + h * 128;
    bf16* op = ((bf16*)(F.ws + WS_PIDX)) + tokI * D + h * 128;
    const float* nw = F.nret + h * 128;
    v2u ov[4][4];
#pragma unroll
    for (int blk = 0; blk < 4; ++blk)
#pragma unroll
        for (int g = 0; g < 4; ++g) {
            const int e = 32 * blk + 8 * g + 4 * hi;
            const v2u gg = *(const v2u*)(gp + e); const f32x4 w4 = *(const f32x4*)(nw + e);
            const float y0 = (out[blk][4 * g] - mu) * rstd * w4.x * bflo(gg.x), y1 = (out[blk][4 * g + 1] - mu) * rstd * w4.y * bfhi(gg.x);
            const float y2 = (out[blk][4 * g + 2] - mu) * rstd * w4.z * bflo(gg.y), y3 = (out[blk][4 * g + 3] - mu) * rstd * w4.w * bfhi(gg.y);
            ov[blk][g].x = pk2(y0, y1); ov[blk][g].y = pk2(y2, y3);
            if (g == 3) asm volatile("" ::: "memory");
        }
    asm volatile("" ::: "memory");
#pragma unroll
    for (int blk = 0; blk < 4; ++blk)
#pragma unroll
        for (int g = 0; g < 4; ++g) *(v2u*)(op + 32 * blk + 8 * g + 4 * hi) = ov[blk][g];
}

__device__ __forceinline__ unsigned fkey(float f) { unsigned b = __float_as_uint(f); if (b == 0x80000000u) b = 0u; return (b & 0x80000000u) ? ~b : (b | 0x80000000u); }
__device__ __forceinline__ int row16_sum_i(int c) {
    c += __builtin_amdgcn_update_dpp(0, c, 0xB1, 0xF, 0xF, true);
    c += __builtin_amdgcn_update_dpp(0, c, 0x4E, 0xF, 0xF, true);
    c += __builtin_amdgcn_update_dpp(0, c, 0x141, 0xF, 0xF, true);
    c += __builtin_amdgcn_update_dpp(0, c, 0x140, 0xF, 0xF, true);
    return c;
}
__device__ __forceinline__ int half_sum(int c) {
    c = row16_sum_i(c);
    auto rr = __builtin_amdgcn_permlane16_swap((unsigned)c, (unsigned)c, false, false);
    return (int)rr[0] + (int)rr[1];
}
__device__ __forceinline__ unsigned half_max_u(unsigned c) {
    unsigned t;
    t = (unsigned)__builtin_amdgcn_update_dpp(0, (int)c, 0xB1, 0xF, 0xF, true); c = c > t ? c : t;
    t = (unsigned)__builtin_amdgcn_update_dpp(0, (int)c, 0x4E, 0xF, 0xF, true); c = c > t ? c : t;
    t = (unsigned)__builtin_amdgcn_update_dpp(0, (int)c, 0x141, 0xF, 0xF, true); c = c > t ? c : t;
    t = (unsigned)__builtin_amdgcn_update_dpp(0, (int)c, 0x140, 0xF, 0xF, true); c = c > t ? c : t;
    auto rr = __builtin_amdgcn_permlane16_swap(c, c, false, false);
    return rr[0] > rr[1] ? rr[0] : rr[1];
}
__device__ __forceinline__ float xor16_max(float m) { auto rr = __builtin_amdgcn_permlane16_swap(__float_as_uint(m), __float_as_uint(m), false, false); return __builtin_fmaxf(__uint_as_float(rr[0]), __uint_as_float(rr[1])); }
__device__ __forceinline__ float xor32_max(float m) { auto rr = __builtin_amdgcn_permlane32_swap(__float_as_uint(m), __float_as_uint(m), false, false); return __builtin_fmaxf(__uint_as_float(rr[0]), __uint_as_float(rr[1])); }
__device__ __forceinline__ float xor16_sum(float m) { auto rr = __builtin_amdgcn_permlane16_swap(__float_as_uint(m), __float_as_uint(m), false, false); return __uint_as_float(rr[0]) + __uint_as_float(rr[1]); }
__device__ __forceinline__ float xor32_sum(float m) { auto rr = __builtin_amdgcn_permlane32_swap(__float_as_uint(m), __float_as_uint(m), false, false); return __uint_as_float(rr[0]) + __uint_as_float(rr[1]); }
#define CNT4(c, u0, u1, u2, u3, cand) do { unsigned long long _t0, _t1, _t2, _t3; \
    asm volatile("v_cmp_ge_u32_e64 %1, %5, %9\n\tv_cmp_ge_u32_e64 %2, %6, %9\n\tv_cmp_ge_u32_e64 %3, %7, %9\n\tv_cmp_ge_u32_e64 %4, %8, %9\n\t" \
                 "v_addc_co_u32_e64 %0, vcc, 0, %0, %1\n\tv_addc_co_u32_e64 %0, vcc, 0, %0, %2\n\tv_addc_co_u32_e64 %0, vcc, 0, %0, %3\n\tv_addc_co_u32_e64 %0, vcc, 0, %0, %4" \
                 : "+v"(c), "=&s"(_t0), "=&s"(_t1), "=&s"(_t2), "=&s"(_t3) : "v"(u0), "v"(u1), "v"(u2), "v"(u3), "v"(cand) : "vcc"); } while (0)
constexpr int IX_KOFF = 32768, IX_KBUF = 32768;
__device__ __forceinline__ unsigned idx_key(float s, bool valid) {
    const unsigned sb = __float_as_uint(s);
    const unsigned ky = sb ^ ((unsigned)((int)sb >> 31) | 0x80000000u);
    return valid ? ky : 0u;
}
__device__ __forceinline__ void idx_pack_half(const f32x16& acc, const int h0, half8& p) {
#pragma unroll
    for (int j = 0; j < 4; ++j) {
        half2v h = __builtin_convertvector(((float2v){acc[h0 + 2 * j], acc[h0 + 2 * j + 1]}), half2v);
        h = __builtin_elementwise_max(h, ((half2v){(f16)0, (f16)0}));
        p[2 * j] = h.x; p[2 * j + 1] = h.y;
    }
}
__device__ __forceinline__ void idx_unit(Frame& F, int b, int qb, int wave, int lane) {
    const int q0 = qb * 16, hi = lane >> 5, r = lane & 31;
    const int myq = q0 + 2 * wave + hi;
    const int arow_q = (r >> 2) & 1, arow_h = (r & 3) | ((r >> 3) << 2);
    half8 a[4];
    { const f16* ap = ((f16*)(F.ws + WS_IQ)) + ((size_t)b * T + q0 + 2 * wave + arow_q) * 1024 + arow_h * 64 + 8 * hi;
#pragma unroll
      for (int s = 0; s < 4; ++s) a[s] = *(const half8*)(ap + 16 * s); }
    half8 w2[2];
    { const f32x4* wp = (const f32x4*)(((float*)(F.ws + WS_IW)) + ((size_t)b * T + myq) * 16);
      const bool on = ((lane & 15) == 4 * (lane >> 4));
#pragma unroll
      for (int k = 0; k < 4; ++k) { f32x4 t = wp[k]; if (!on) t = (f32x4){0.f, 0.f, 0.f, 0.f};
          w2[k >> 1][4 * (k & 1)] = (f16)t.x; w2[k >> 1][4 * (k & 1) + 1] = (f16)t.y; w2[k >> 1][4 * (k & 1) + 2] = (f16)t.z; w2[k >> 1][4 * (k & 1) + 3] = (f16)t.w; } }
    LAS unsigned* sl = (LAS unsigned*)(F.lds + wave * 4096) + lane;
    unsigned u[128];
    const int last = (q0 + 15) >> 5, nstage = (last >> 3) + 1;
#define IX_STAGE(sidx_, buf_) do { int lv = lane; asm volatile("" : "+v"(lv)); \
        const char* sgb = (const char*)(((f16*)(F.ws + WS_IK)) + (size_t)b * T * 64) + (32 * wave + (lv >> 3)) * 128 + (size_t)(sidx_) * 32768; \
        const int gA = 16 * ((lv & 7) ^ (lv >> 4)), gB = gA ^ 64; \
        const unsigned lb = (unsigned)(__SIZE_TYPE__)(F.lds + IX_KOFF + (buf_) * IX_KBUF + wave * 4096); \
        _Pragma("unroll") for (int j = 0; j < 4; ++j) { const char* gp = sgb + j * 1024 + ((j & 1) ? gB : gA); \
            asm volatile("s_mov_b32 m0, %0\n\ts_nop 0\n\tglobal_load_lds_dwordx4 %1, off" :: "s"(lb + j * 1024), "v"(gp) : "memory", "m0"); } } while (0)
    IX_STAGE(0, 0);
    asm volatile("s_waitcnt vmcnt(0)" ::: "memory");
    __syncthreads();
    asm volatile("" : "+v"(a[0]), "+v"(a[1]), "+v"(a[2]), "+v"(a[3]), "+v"(w2[0]), "+v"(w2[1]));
#define IX_RD(s_, off_) (*(const LAS half8*)(F.lds + ra[s_] + (off_)))
#pragma unroll
    for (int c = 0; c < 8; ++c) {
        if (16 * c <= last) {
#pragma unroll 1
            for (int st = 0; st < 2; ++st) {
                const int sidx = 2 * c + st;
                if (sidx < nstage) {
                    if (sidx + 1 < nstage) IX_STAGE(sidx + 1, (sidx + 1) & 1);
                    const int nt = (last - 8 * sidx + 1) < 8 ? (last - 8 * sidx + 1) : 8;
                    const int npair = (nt + 1) >> 1;
                    int ra[4];
                    { int lv = lane; asm volatile("" : "+v"(lv));
                      const int r_ = lv & 31, hi_ = lv >> 5;
#pragma unroll
                      for (int s = 0; s < 4; ++s) ra[s] = IX_KOFF + (sidx & 1) * IX_KBUF + r_ * 128 + 16 * ((2 * s + hi_) ^ ((r_ >> 1) & 7)); }
                    half8 bfA[4], bfB[4];
#pragma unroll
                    for (int s = 0; s < 4; ++s) { bfA[s] = IX_RD(s, 0); bfB[s] = IX_RD(s, 4096); }
                    int kq = myq - r - 256 * sidx;
                    LAS unsigned* slp = sl + 8 * st * 64;
#pragma unroll 1
                    for (int pp = 0; pp < npair; ++pp) {
                        f32x16 accA, accB; half8 p[2];
#define IX_SB __builtin_amdgcn_sched_barrier(0)
#define IX_MM(acc_, bf_, s_, off_, c_) do { acc_ = __builtin_amdgcn_mfma_f32_32x32x16_f16(a[s_], bf_[s_], c_, 0, 0, 0); bf_[s_] = IX_RD(s_, off_); IX_SB; } while (0)
                        IX_MM(accA, bfA, 0, 8192, zero16()); IX_MM(accB, bfB, 0, 12288, zero16());
                        IX_MM(accA, bfA, 1, 8192, accA); IX_MM(accB, bfB, 1, 12288, accB);
                        IX_MM(accA, bfA, 2, 8192, accA); IX_MM(accB, bfB, 2, 12288, accB);
                        IX_MM(accA, bfA, 3, 8192, accA); IX_MM(accB, bfB, 3, 12288, accB);
                        idx_pack_half(accA, 0, p[0]); idx_pack_half(accA, 8, p[1]); IX_SB;
                        f32x4 sA = __builtin_amdgcn_mfma_f32_16x16x32_f16(w2[0], p[0], ((f32x4){0.f, 0.f, 0.f, 0.f}), 0, 0, 0);
                        sA = __builtin_amdgcn_mfma_f32_16x16x32_f16(w2[1], p[1], sA, 0, 0, 0); IX_SB;
                        idx_pack_half(accB, 0, p[0]); idx_pack_half(accB, 8, p[1]);
                        asm volatile("" :: "v"(sA));
                        IX_SB;
                        f32x4 sB = __builtin_amdgcn_mfma_f32_16x16x32_f16(w2[0], p[0], ((f32x4){0.f, 0.f, 0.f, 0.f}), 0, 0, 0);
                        sB = __builtin_amdgcn_mfma_f32_16x16x32_f16(w2[1], p[1], sB, 0, 0, 0);
                        slp[0] = idx_key(sA[0], 0 <= kq);
                        slp[64] = idx_key(sB[0], 32 <= kq);
#pragma unroll
                        for (int s = 0; s < 4; ++s) ra[s] += 8192;
                        kq -= 64; slp += 128;
                    }
#pragma unroll 1
                    for (int ii = 2 * npair; ii < 8; ++ii) sl[(8 * st + ii) * 64] = 0u;
                    asm volatile("s_waitcnt vmcnt(0)" ::: "memory");
                    __syncthreads();
                } else {
#pragma unroll 1
                    for (int ii = 0; ii < 8; ++ii) sl[(8 * st + ii) * 64] = 0u;
                }
            }
#pragma unroll
            for (int ii = 0; ii < 16; ++ii) u[16 * c + ii] = sl[ii * 64];
        } else {
#pragma unroll
            for (int ii = 0; ii < 16; ++ii) u[16 * c + ii] = 0u;
        }
    }
#undef IX_RD
#undef IX_STAGE
#define IDX_COUNT(c, cand) do { c = 0; _Pragma("unroll") for (int g = 0; g < 16; ++g) { if (8 * g <= last) { \
        _Pragma("unroll") for (int i = 0; i < 8; i += 4) CNT4(c, u[8 * g + i], u[8 * g + i + 1], u[8 * g + i + 2], u[8 * g + i + 3], cand); } } \
        asm volatile("s_nop 2" : "+v"(c)); c = half_sum(c); } while (0)
    unsigned Tk = 0u; bool done = false, found = false;
    {
        unsigned um = 0u;
#pragma unroll
        for (int g = 0; g < 8; ++g) { if (16 * g <= last) {
#pragma unroll
            for (int i = 0; i < 16; ++i) um = um > u[16 * g + i] ? um : u[16 * g + i]; } }
        um = half_max_u(um);
        const int Eb = (um >> 31) ? (int)((um >> 23) & 0xFFu) : 0;
#pragma unroll 1
        for (int k = 0; k < 4; ++k) {
            const int e = Eb - k;
            const unsigned cand = (e >= 1) ? (0x80000000u | ((unsigned)e << 23)) : 0xFFFFFFFFu;
            int c; IDX_COUNT(c, cand);
            if (!found && e >= 1 && c >= 256) { found = true; Tk = cand; done = (c == 256); }
            if (__all(found)) break;
        }
    }
    int startbit = 22;
    if (!__all(found)) { Tk = 0u; done = false; startbit = 31; }
#pragma unroll 1
    for (int bit = startbit; bit >= 0; --bit) {
        if (__all(done)) break;
        const unsigned cand = Tk | (1u << bit);
        int c; IDX_COUNT(c, cand);
        if (!done && c >= 256) { Tk = cand; done = (c == 256); }
    }
#undef IDX_COUNT
    unsigned Tk2 = Tk - 1u; int Jthr = -1;
    if (!__all(done)) {
        int cgt = 0, ceq = 0;
#pragma unroll
        for (int i = 0; i < 128; ++i) { cgt += (u[i] > Tk) ? 1 : 0; ceq += (u[i] == Tk) ? 1 : 0; }
        cgt = half_sum(cgt); ceq = half_sum(ceq);
        Jthr = (Tk == 0u) ? -1 : 4095;
        const int need = 256 - cgt;
        const bool trim = (Tk != 0u) && (ceq > need);
        if (__any(trim)) {
            int J = 0;
#pragma unroll 1
            for (int bit = 11; bit >= 0; --bit) {
                const int cand = J | (1 << bit);
                unsigned Tk1 = Tk; asm volatile("" : "+v"(Tk1));
                const int cr = cand - r;
                int c = 0;
#pragma unroll
                for (int i = 0; i < 128; ++i) c += ((u[i] == Tk1) && (32 * i < cr)) ? 1 : 0;
                c = half_sum(c);
                if (c < need) J = cand;
            }
            if (trim) Jthr = J;
        }
        Tk2 = Tk;
    }
    const int jt = Jthr - r;
    asm volatile("" : "+v"(Tk2));
    unsigned mlo0 = 0u, mhi0 = 0u, mlo1 = 0u, mhi1 = 0u;
#define IDX_MASKGEN(SEL) do { _Pragma("unroll") for (int g = 0; g < 8; ++g) { if (16 * g <= last) { _Pragma("unroll") for (int ii = 0; ii < 16; ++ii) { \
        const int i = 16 * g + ii; const bool sel = SEL; const unsigned long long bal = __ballot(sel); const unsigned lo = (unsigned)bal, hi_ = (unsigned)(bal >> 32); \
        int lv = lane; asm volatile("" : "+v"(lv));             \
        const bool me = (lv == (i & 63)); \
        if (i < 64) { mlo0 = me ? lo : mlo0; mhi0 = me ? hi_ : mhi0; } else { mlo1 = me ? lo : mlo1; mhi1 = me ? hi_ : mhi1; } } } } } while (0)
    if (__all(done)) IDX_MASKGEN((u[i] > Tk2));
    else IDX_MASKGEN(((u[i] > Tk2) || ((u[i] == Tk2) && (32 * i <= jt))));
#undef IDX_MASKGEN
    unsigned* mp = ((unsigned*)(F.ws + WS_MASK)) + ((size_t)b * T + q0 + 2 * wave) * 128;
    mp[lane] = mlo0; mp[64 + lane] = mlo1; mp[128 + lane] = mhi0; mp[192 + lane] = mhi1;
}

constexpr float AT_TAU = 10.f;
constexpr int AT_PITCH = 272, AT_KBYTES = 128 * AT_PITCH, AT_BUF = 2 * AT_KBYTES;
__device__ __forceinline__ void attn_unit(Frame& F, int b, int kvh, int qb) {
    const int tid = F.tid, lane = F.lane, wave = F.wave, fr = lane & 15, fq = lane >> 4;
    const int q = qb * 32 + 4 * wave + (fr >> 2), head = 4 * kvh + (fr & 3);
    const size_t tok = (size_t)b * T + q;
    bf16x8 qf[4];
    { const bf16* qp = ((bf16*)(F.ws + WS_PROJ)) + tok * NPB + C_AQ + head * 128 + 8 * fq;
#pragma unroll
      for (int s = 0; s < 4; ++s) qf[s] = *(const bf16x8*)(qp + 32 * s); }
    const v4u* mrow = (const v4u*)(((unsigned*)(F.ws + WS_MASK)) + tok * 128);
    f32x4 O[8];
#pragma unroll
    for (int k = 0; k < 8; ++k) O[k] = (f32x4){0.f, 0.f, 0.f, 0.f};
    float mref = 0.f; bool has = false;
    const unsigned onew = (fr == 0) ? 0x3F803F80u : 0u;
    const bf16x8 vones = __builtin_bit_cast(bf16x8, ((v4u){onew, onew, onew, onew}));
    f32x4 Osum = {0.f, 0.f, 0.f, 0.f};
    const int nst = (qb + 4) >> 2;
    const int srow = tid >> 4, sc8 = (tid & 15) * 8;
    const bf16* kg = ((bf16*)(F.ws + WS_PROJ)) + ((size_t)b * T + srow) * NPB + C_AK + kvh * 128 + sc8;
    const bf16* vg = ((bf16*)(F.ws + WS_AVT)) + ((size_t)(b * 2 + kvh) * 128 + srow) * T + sc8;
    LAS unsigned char* lds = F.lds;
    const int kst = srow * AT_PITCH + sc8 * 2, vst = AT_KBYTES + kst;
    v4u kr[4], vr[4];
#pragma unroll
    for (int j = 0; j < 4; ++j) { kr[j] = *(const v4u*)(kg + (size_t)(32 * j) * NPB); vr[j] = *(const v4u*)(vg + (size_t)(32 * j) * T); }
#define AT_VWRITE(base) do { _Pragma("unroll") for (int j = 0; j < 4; ++j) *(LAS v4u*)(lds + (base) + vst + 32 * j * AT_PITCH) = vr[j]; } while (0)
#pragma unroll
    for (int j = 0; j < 4; ++j) *(LAS v4u*)(lds + kst + 32 * j * AT_PITCH) = kr[j];
    AT_VWRITE(0);
    v4u W4 = mrow[0], W4n = W4;
    __syncthreads();
    asm volatile("" : "+v"(qf[0]), "+v"(qf[1]), "+v"(qf[2]), "+v"(qf[3]), "+v"(W4));
    if (wave >= 4) __builtin_amdgcn_s_setprio(1);
    for (int st = 0; st < nst; ++st) {
        const int bo = (st & 1) * AT_BUF;
        const bool more = (st + 1 < nst);
        if (more) {
#pragma unroll
            for (int j = 0; j < 4; ++j) { kr[j] = *(const v4u*)(kg + (size_t)((st + 1) * 128 + 32 * j) * NPB); vr[j] = *(const v4u*)(vg + (size_t)(32 * j) * T + (st + 1) * 128); }
            W4n = mrow[st + 1];
        }
        {
            f32x4 sa[4], sb[4];
#pragma unroll
            for (int g = 0; g < 4; ++g) { sa[g] = (f32x4){-mref, -mref, -mref, -mref}; sb[g] = sa[g]; }
#pragma unroll
            for (int s = 0; s < 4; ++s)
#pragma unroll
                for (int g = 0; g < 4; ++g) { const bf16x8 kf = *(const LAS bf16x8*)(lds + bo + (16 * g + fr) * AT_PITCH + (32 * s + 8 * fq) * 2); sa[g] = MFMA16(kf, qf[s], sa[g]); }
#pragma unroll
            for (int s = 0; s < 4; ++s)
#pragma unroll
                for (int g = 0; g < 4; ++g) { const bf16x8 kf = *(const LAS bf16x8*)(lds + bo + (64 + 16 * g + fr) * AT_PITCH + (32 * s + 8 * fq) * 2); sb[g] = MFMA16(kf, qf[s], sb[g]); }
            float mxa = -INFINITY;
#pragma unroll
            for (int g = 0; g < 4; ++g)
#pragma unroll
                for (int j = 0; j < 4; ++j) mxa = __builtin_fmaxf(mxa, __builtin_fmaxf(sa[g][j], sb[g][j]));
            mxa = xor16_max(mxa); mxa = xor32_max(mxa);
            {
                const bool need = (mxa > -INFINITY) && (!has || mxa > AT_TAU);
                if (__any(need)) {
                    const float delta = need ? mxa : 0.f;
                    const float scale = (need && has) ? __builtin_amdgcn_exp2f(-delta) : 1.f;
#pragma unroll
                    for (int g = 0; g < 4; ++g) { sa[g] = sa[g] - delta; sb[g] = sb[g] - delta; }
#pragma unroll
                    for (int blk = 0; blk < 8; ++blk) O[blk] = O[blk] * scale;
                    Osum = Osum * scale;
                    mref += delta; has = has || need;
                }
            }
            bf16x8 pa[2];
#pragma unroll
            for (int h = 0; h < 2; ++h) {
                float p[8];
#pragma unroll
                for (int j = 0; j < 8; ++j) {
                    const unsigned keep = (unsigned)__builtin_amdgcn_sbfe((int)W4[h], 4 * fq + 16 * (j >> 2) + (j & 3), 1);
                    p[j] = __uint_as_float(__float_as_uint(__builtin_amdgcn_exp2f(sa[2 * h + (j >> 2)][j & 3])) & keep);
                }
                v4u pp; pp.x = pk2(p[0], p[1]); pp.y = pk2(p[2], p[3]); pp.z = pk2(p[4], p[5]); pp.w = pk2(p[6], p[7]);
                pa[h] = __builtin_bit_cast(bf16x8, pp);
            }
            Osum = MFMA16(vones, pa[0], Osum); Osum = MFMA16(vones, pa[1], Osum);
#pragma unroll
            for (int blk = 0; blk < 8; ++blk) {
                const LAS unsigned char* vp = lds + bo + AT_KBYTES + (16 * blk + fr) * AT_PITCH + (8 * fq) * 2;
#pragma unroll
                for (int h = 0; h < 2; ++h) { const bf16x8 av = *(const LAS bf16x8*)(vp + 64 * h); O[blk] = MFMA16(av, pa[h], O[blk]); }
            }
            bf16x8 pbb[2];
#pragma unroll
            for (int h = 0; h < 2; ++h) {
                float p[8];
#pragma unroll
                for (int j = 0; j < 8; ++j) {
                    const unsigned keep = (unsigned)__builtin_amdgcn_sbfe((int)W4[2 + h], 4 * fq + 16 * (j >> 2) + (j & 3), 1);
                    p[j] = __uint_as_float(__float_as_uint(__builtin_amdgcn_exp2f(sb[2 * h + (j >> 2)][j & 3])) & keep);
                }
                v4u pp; pp.x = pk2(p[0], p[1]); pp.y = pk2(p[2], p[3]); pp.z = pk2(p[4], p[5]); pp.w = pk2(p[6], p[7]);
                pbb[h] = __builtin_bit_cast(bf16x8, pp);
            }
            Osum = MFMA16(vones, pbb[0], Osum); Osum = MFMA16(vones, pbb[1], Osum);
#pragma unroll
            for (int blk = 0; blk < 8; ++blk) {
                const LAS unsigned char* vp = lds + bo + AT_KBYTES + (16 * blk + fr) * AT_PITCH + (8 * fq) * 2 + 128;
#pragma unroll
                for (int h = 0; h < 2; ++h) { const bf16x8 av = *(const LAS bf16x8*)(vp + 64 * h); O[blk] = MFMA16(av, pbb[h], O[blk]); }
            }
        }
        if (more) { const int bn = ((st + 1) & 1) * AT_BUF;
#pragma unroll
            for (int j = 0; j < 4; ++j) *(LAS v4u*)(lds + bn + kst + 32 * j * AT_PITCH) = kr[j];
            AT_VWRITE(bn); }
        __syncthreads();
        W4 = W4n;
    }
#undef AT_VWRITE
    __builtin_amdgcn_s_setprio(0);
    float lsum = Osum[0];
    lsum = xor16_sum(lsum); lsum = xor32_sum(lsum);
    const float inv = 1.0f / lsum;
    bf16* op = ((bf16*)(F.ws + WS_PIDX)) + tok * D + 1024 + head * 128 + 4 * fq;
#pragma unroll
    for (int blk = 0; blk < 8; ++blk) { v2u o; o.x = pk2(O[blk][0] * inv, O[blk][1] * inv); o.y = pk2(O[blk][2] * inv, O[blk][3] * inv); *(v2u*)(op + 16 * blk) = o; }
}

struct Args { const void* in[15]; float* out; unsigned char* ws; int ph_lo, ph_hi; };
constexpr int NPHASE = 12;
__global__ void __launch_bounds__(NWAVES * 64, 2) mk_fwd(Args args) {
    extern __shared__ __attribute__((aligned(16))) unsigned char lds[];
    Frame F;
    F.lds = (LAS unsigned char*)lds;
    F.tid = threadIdx.x; F.lane = F.tid & 63; F.wave = __builtin_amdgcn_readfirstlane(F.tid >> 6);
    F.G = gridDim.x; F.bid = blockIdx.x;
    unsigned char* ws = args.ws;
    F.x = (const float*)args.in[0]; F.pos = (const int*)args.in[1];
    F.n1 = (const float*)args.in[2]; F.wg1 = (const float*)args.in[3]; F.wu1 = (const float*)args.in[4]; F.wd1 = (const float*)args.in[5];
    F.nmix = (const float*)args.in[6]; F.win = (const float*)args.in[7]; F.nret = (const float*)args.in[8]; F.wout = (const float*)args.in[9];
    F.n2 = (const float*)args.in[10]; F.wg2 = (const float*)args.in[11]; F.wu2 = (const float*)args.in[12]; F.wd2 = (const float*)args.in[13]; F.nfin = (const float*)args.in[14];
    F.X = args.out;
    F.ws = ws;
    volatile LAS unsigned* MISC = (volatile LAS unsigned*)(F.lds + MISC_OFF);
    for (int u = F.tid; u < (LDS_BYTES - LDSCTL_OFF) / 4; u += NWAVES * 64) ((LAS unsigned*)(F.lds + LDSCTL_OFF))[u] = 0u;
    __syncthreads();
    const int lo = args.ph_lo, hi = args.ph_hi;
    XcdBarrier bar; bar.bar = (unsigned*)(ws + WS_CTL) + CW_BAR; bar.x = 0; bar.st = nullptr;
    if (hi - lo > 1) bar = xcd_barrier_post((unsigned*)(ws + WS_CTL) + CW_BAR, MISC + 8);
#ifndef MK_PHMASK
#define MK_PHMASK 0xFFFF
#endif
#define IN(k) (((MK_PHMASK >> (k)) & 1) && lo <= (k) && (k) < hi)
#define SEAM(k) do { if (IN(k) && IN((k) + 1)) xcd_barrier(bar); } while (0)
    bf16* H = ((bf16*)(F.ws + WS_PROJ));

#ifndef MK_REPEAT
#define MK_REPEAT 0
#endif
#ifndef MK_TIMEPH
#define MK_TIMEPH -1
#endif
    unsigned long long tp0 = 0, tp1 = 0;
#define PHASE(k, ...) do { MK_STAMP(F.lds, 2 * (k)); if ((k) == MK_TIMEPH) tp0 = __builtin_amdgcn_s_memrealtime(); if (IN(k)) { { int t_ = threadIdx.x; asm volatile("" : "+v"(t_)); F.tid = t_; F.lane = t_ & 63; F.wave = __builtin_amdgcn_readfirstlane(t_ >> 6); } __VA_ARGS__ if ((MK_REPEAT >> (k)) & 1) { xcd_barrier(bar); __VA_ARGS__ } } MK_STAMP(F.lds, 1000 + (k)); SEAM(k); MK_STAMP(F.lds, 2 * (k) + 1); if ((k) == MK_TIMEPH) tp1 = __builtin_amdgcn_s_memrealtime(); } while (0)
    PHASE(0, { convert_job<0>(F, F.bid, F.G); if (MK_ABL == 1) convert_job<0>(F, F.bid, F.G); rope_table(F); if (MK_ABL == 2) rope_table(F); prep_rows(F, F.x, ((bf16*)(F.ws + WS_A))); if (MK_ABL == 3) prep_rows(F, F.x, ((bf16*)(F.ws + WS_A))); });
    PHASE(1, { pg8::Gemm g{((bf16*)(F.ws + WS_A)), ((bf16*)(F.ws + WS_WGU)), M, 2 * FF, D}; pg8::StaticOrder S; S.init(M, 2 * FF, F.G, F.bid); load_rstd_panels(F, S, ((float*)(F.ws + WS_SSQ))); EpiSwiGLU E{H, (const LAS float*)(F.lds + RS_OFF)};
        pg8::gemm_phase<EpiSwiGLU, pg8::StaticOrder, true, true>(F.lds, g, S, E, F.tid, 110);
        { const int nfull = (M / 256) * (2 * FF / 256) % F.G; if (nfull > 0 && F.bid >= nfull) { convert_job<1>(F, F.bid - nfull, F.G - nfull); }
          else if (nfull == 0) { convert_job<1>(F, F.bid, F.G); } } });
    PHASE(2, { pg8::Gemm g{H, ((bf16*)(F.ws + WS_WD)), M, D, FF}; pg8::StaticOrder S; S.init(M, D, F.G, F.bid); EpiResid<false> E{nullptr, ((bf16*)(F.ws + WS_A)), 0.5f, ((float*)(F.ws + WS_SSQ))};
        pg8::gemm_phase<EpiResid<false>, pg8::StaticOrder, true, true>(F.lds, g, S, E, F.tid, 120); });
    PHASE(3, { pg8::Gemm g{((bf16*)(F.ws + WS_A)), ((bf16*)(F.ws + WS_WIN)), M, NINP, D}; pg8::StaticOrder S; S.init(M, NINP, F.G, F.bid); load_rstd_panels(F, S, ((float*)(F.ws + WS_SSQ))); EpiProj E{F.ws, (const LAS float*)(F.lds + RS_OFF)};
        pg8::gemm_phase<EpiProj, pg8::StaticOrder, true, true>(F.lds, g, S, E, F.tid, 130);
        { const int nfull = (M / 256) * (NINP / 256) % F.G; if (nfull > 0 && F.bid >= nfull) { convert_job<2>(F, F.bid - nfull, F.G - nfull); }
          else if (nfull == 0) { convert_job<2>(F, F.bid, F.G); } } });
    PHASE(4, { for (int tt = F.bid; tt < M / 32; tt += F.G) post_tile(F, tt); });
    PHASE(5, {
        for (int rep = 0; rep < (MK_ABL == 5 ? 2 : 1); ++rep) for (int u2 = F.bid; u2 < 256; u2 += F.G) { ret_kv_stage(F, u2); ret_kv_unit(F, 2 * u2 + (F.wave >> 2), F.wave & 3, F.lane); __syncthreads(); }
        for (int c = F.bid; c < 256; c += F.G) {
            _Pragma("unroll 1") for (int k = 0; k < 2; ++k) { const int b = c & 1, i = c >> 1; idx_unit(F, b, k ? 255 - i : i, F.wave, F.lane); } }
    });
    PHASE(6, { ret_scan(F); });
    PHASE(7, {
        for (int rep = 0; rep < (MK_ABL == 6 ? 2 : 1); ++rep) for (int u2 = F.bid; u2 < 256; u2 += F.G) { ret_out_stage(F, u2); ret_out_unit(F, 2 * u2 + (F.wave >> 2), F.wave & 3, F.lane); __syncthreads(); }
        MK_STAMP(F.lds, 210);
        for (int p = F.bid; p < 256; p += F.G) { const int grp = (p & 7) >> 1, b = grp >> 1, kvh = grp & 1, i = ((p >> 3) << 1) | (p & 1);
            _Pragma("unroll 1") for (int k = 0; k < 2; ++k) attn_unit(F, b, kvh, k ? 127 - i : i); }
    });
    PHASE(8, { pg8::Gemm g{((bf16*)(F.ws + WS_PIDX)), ((bf16*)(F.ws + WS_WOUT)), M, D, D}; pg8::StaticOrder S; S.init(M, D, F.G, F.bid); EpiResid<false> E{nullptr, ((bf16*)(F.ws + WS_A)), 1.0f, ((float*)(F.ws + WS_SSQ))};
        pg8::gemm_phase<EpiResid<false>, pg8::StaticOrder, true, true>(F.lds, g, S, E, F.tid, 180); });
    PHASE(9, { pg8::Gemm g{((bf16*)(F.ws + WS_A)), ((bf16*)(F.ws + WS_WGU)), M, 2 * FF, D}; pg8::StaticOrder S; S.init(M, 2 * FF, F.G, F.bid); load_rstd_panels(F, S, ((float*)(F.ws + WS_SSQ))); EpiSwiGLU E{H, (const LAS float*)(F.lds + RS_OFF)};
        pg8::gemm_phase<EpiSwiGLU, pg8::StaticOrder, true, true>(F.lds, g, S, E, F.tid, 190);
        { const int nfull = (M / 256) * (2 * FF / 256) % F.G; if (nfull > 0 && F.bid >= nfull) { convert_job<3>(F, F.bid - nfull, F.G - nfull); }
          else if (nfull == 0) { convert_job<3>(F, F.bid, F.G); } } });
    PHASE(10, { pg8::Gemm g{H, ((bf16*)(F.ws + WS_WD)), M, D, FF}; pg8::StaticOrder S; S.init(M, D, F.G, F.bid); EpiResid<false> E{nullptr, ((bf16*)(F.ws + WS_A)), 0.5f, ((float*)(F.ws + WS_SSQ))};
        pg8::gemm_phase<EpiResid<false>, pg8::StaticOrder, true, true>(F.lds, g, S, E, F.tid, 200); });
    PHASE(11, { rms_final(F); });
#undef PHASE
    if (MK_TA >= 0 && blockIdx.x == 0) { __syncthreads(); const unsigned long long ta = *(volatile LAS unsigned long long*)(F.lds + 147200 + 8), tb = *(volatile LAS unsigned long long*)(F.lds + 147200 + 16);
        const unsigned long long tgt = __builtin_amdgcn_s_memrealtime() + 4ull * (tb - ta); while (__builtin_amdgcn_s_memrealtime() < tgt) __builtin_amdgcn_s_sleep(8); }
    if (MK_TIMEPH >= 0 && blockIdx.x == 0) { const unsigned long long tgt = __builtin_amdgcn_s_memrealtime() + 4ull * (tp1 - tp0); while (__builtin_amdgcn_s_memrealtime() < tgt) __builtin_amdgcn_s_sleep(8); }
#undef IN
#undef SEAM
}

extern "C" void kernel_launch(void* const* d_in, const int* in_sizes, int n_in, void* d_out, int out_size, void* d_ws, size_t ws_size, hipStream_t stream) {
    static int grid = 0;
    if (grid == 0) {
        if (n_in != 15 || in_sizes[0] != M * D || out_size != M * D || ws_size < WS_END) { fprintf(stderr, "kernel_launch: unexpected shapes (n_in %d, in0 %d, out %d, ws %zu < %zu)\n", n_in, n_in > 0 ? in_sizes[0] : -1, out_size, ws_size, (size_t)WS_END); grid = -1; return; }
        int dev = 0, cus = 0;
        if (hipGetDevice(&dev) != hipSuccess || hipDeviceGetAttribute(&cus, hipDeviceAttributeMultiprocessorCount, dev) != hipSuccess) { grid = -1; return; }
        if (hipFuncSetAttribute((const void*)mk_fwd, hipFuncAttributeMaxDynamicSharedMemorySize, LDS_BYTES) != hipSuccess) { fprintf(stderr, "kernel_launch: hipFuncSetAttribute failed\n"); grid = -1; return; }
        int per_cu = 0;
        if (hipOccupancyMaxActiveBlocksPerMultiprocessor(&per_cu, (const void*)mk_fwd, NWAVES * 64, LDS_BYTES) != hipSuccess || per_cu < 1) fprintf(stderr, "kernel_launch: occupancy query reports %d\n", per_cu);
        (void)hipGetLastError();
        grid = cus;
    }
    if (grid < 0) return;
    (void)hipMemsetAsync((char*)d_ws + WS_CTL, 0, CTL_ZERO_BYTES, stream);
    Args a{};
    for (int i = 0; i < 15; ++i) a.in[i] = d_in[i];
    a.out = (float*)d_out; a.ws = (unsigned char*)d_ws;
#if MK_PER_PHASE
    for (int p = 0; p < NPHASE; ++p) { a.ph_lo = p; a.ph_hi = p + 1; hipLaunchKernelGGL(mk_fwd, dim3(grid), dim3(NWAVES * 64), LDS_BYTES, stream, a); }
#else
    a.ph_lo = 0; a.ph_hi = NPHASE;
    hipLaunchKernelGGL(mk_fwd, dim3(grid), dim3(NWAVES * 64), LDS_BYTES, stream, a);
#endif
}
```
